# Optimizing an MI355X kernel written in HIP

```python
import math
import jax, jax.numpy as jnp
from jax import lax
import numpy as np

D_MODEL = 2048
BATCH = 4
SEQ = 8192
DEPTH = 2
DEC_BATCH = 8
DEC_SEQ = 64
PAST_LEN = 2048

CHUNK = 64
N_META = 16
D_CONV_BR = 1024
CONV_A_W = 3
N_HEADS = 8
HEAD_DIM = 128
D_DELTA = N_HEADS * HEAD_DIM
D_QKV = 3 * D_DELTA
CONV_QKV_W = 4
D_MIX = D_CONV_BR + D_DELTA
PROJ_SIZES = (D_CONV_BR, D_CONV_BR, D_CONV_BR, D_CONV_BR, D_QKV, D_DELTA, N_HEADS, N_HEADS)
D_PROJ = sum(PROJ_SIZES)
PROJ_CUTS = [int(c) for c in np.cumsum(PROJ_SIZES)[:-1]]
EPS = 1e-6

kernel_name = "hymba_conv_gdn_stream_step"


def _rmsnorm(x, w):
    xf = x.astype(jnp.float32)
    y = xf * lax.rsqrt(jnp.mean(xf * xf, axis=-1, keepdims=True) + EPS) * w.astype(jnp.float32)
    return y.astype(x.dtype)


def _l2norm(x):
    return x * lax.rsqrt(jnp.sum(x * x, axis=-1, keepdims=True) + EPS)


def _causal_conv(u_full, w):
    width = w.shape[0]
    l = u_full.shape[1] - width + 1
    out = u_full[:, 0:l] * w[0]
    for j in range(1, width):
        out = out + u_full[:, j:j + l] * w[j]
    return out


def _gdn_chunked(q, k, v, g, beta, s0, chunk):
    b, l, h, _ = q.shape
    n = l // chunk

    def blk(t):
        t = t.reshape((b, n, chunk, h) + t.shape[3:])
        return jnp.moveaxis(t, (1, 3), (0, 2))

    qc, kc, vc, bc = blk(q), blk(k), blk(v), blk(beta)
    gc = jnp.cumsum(blk(g), axis=-1)
    idx = jnp.arange(chunk)
    causal = idx[:, None] >= idx[None, :]
    strict = idx[:, None] > idx[None, :]
    decay = jnp.exp(jnp.where(causal, gc[..., :, None] - gc[..., None, :], -jnp.inf))
    kk = jnp.einsum('nbhid,nbhjd->nbhij', kc * bc[..., None], kc) * decay
    eye = jnp.eye(chunk, dtype=kk.dtype)
    a_mat = jnp.where(strict, kk, 0.0) + eye
    t_mat = lax.linalg.triangular_solve(a_mat, jnp.broadcast_to(eye, a_mat.shape),
                                        left_side=True, lower=True, unit_diagonal=True)
    u = jnp.einsum('nbhij,nbhjd->nbhid', t_mat, vc * bc[..., None])
    w = jnp.einsum('nbhij,nbhjd->nbhid', t_mat, kc * (bc * jnp.exp(gc))[..., None])
    qk = jnp.einsum('nbhid,nbhjd->nbhij', qc, kc) * decay

    def step(s, inp):
        q_i, k_i, u_i, w_i, g_i, qk_i = inp
        v_new = u_i - jnp.einsum('bhcd,bhde->bhce', w_i, s)
        o = (jnp.einsum('bhcd,bhde->bhce', q_i * jnp.exp(g_i)[..., None], s)
             + jnp.einsum('bhij,bhje->bhie', qk_i, v_new))
        g_last = g_i[..., -1]
        s = (s * jnp.exp(g_last)[..., None, None]
             + jnp.einsum('bhcd,bhce->bhde', k_i * jnp.exp(g_last[..., None] - g_i)[..., None], v_new))
        return s, o

    s_fin, o = lax.scan(step, s0, (qc, kc, u, w, gc, qk))
    o = jnp.moveaxis(o, (0, 2), (1, 3)).reshape(b, l, h, v.shape[-1])
    return s_fin, o


def _layer(h, conv_a_prev, conv_qkv_prev, s_prev, n_meta,
           norm_w, w_in, conv_a_w, conv_qkv_w, a_log, dt_bias, o_norm_w, w_out):
    dt = h.dtype
    f32 = jnp.float32
    b, l, _ = h.shape
    xn = _rmsnorm(h, norm_w)
    proj = jnp.einsum('bld,dp->blp', xn, w_in)
    a_b, a_c, a_x, a_z, qkv, z_b, b_logit, a_logit = jnp.split(proj, PROJ_CUTS, axis=-1)

    u_full = jnp.concatenate([conv_a_prev.astype(dt), a_c * a_x], axis=1)
    y_a = a_b * _causal_conv(u_full, conv_a_w) * jax.nn.silu(a_z)
    new_conv_a = u_full[:, -(CONV_A_W - 1):]

    qkv_full = jnp.concatenate([conv_qkv_prev.astype(dt), qkv], axis=1)
    new_conv_qkv = qkv_full[:, -(CONV_QKV_W - 1):]
    qkv_c = jax.nn.silu(_causal_conv(qkv_full, conv_qkv_w)).astype(f32)
    q, k, v = jnp.split(qkv_c, 3, axis=-1)
    q = _l2norm(q.reshape(b, l, N_HEADS, HEAD_DIM)) * (HEAD_DIM ** -0.5)
    k = _l2norm(k.reshape(b, l, N_HEADS, HEAD_DIM))
    v = v.reshape(b, l, N_HEADS, HEAD_DIM)
    beta = jax.nn.sigmoid(b_logit.astype(f32))
    g = -jnp.exp(a_log.astype(f32)) * jax.nn.softplus(a_logit.astype(f32) + dt_bias.astype(f32))
    s = s_prev.astype(f32)
    if n_meta > 0:
        s, o_meta = _gdn_chunked(q[:, :n_meta], k[:, :n_meta], v[:, :n_meta],
                                 g[:, :n_meta], beta[:, :n_meta], s, n_meta)
        s, o_rest = _gdn_chunked(q[:, n_meta:], k[:, n_meta:], v[:, n_meta:],
                                 g[:, n_meta:], beta[:, n_meta:], s, CHUNK)
        o = jnp.concatenate([o_meta, o_rest], axis=1)
    else:
        s, o = _gdn_chunked(q, k, v, g, beta, s, min(l, CHUNK))
    o = _rmsnorm(o, o_norm_w) * jax.nn.silu(z_b.astype(f32).reshape(b, l, N_HEADS, HEAD_DIM))
    y_b = o.reshape(b, l, D_DELTA).astype(dt)

    y = jnp.einsum('blm,md->bld', jnp.concatenate([y_a, y_b], axis=-1), w_out)
    return h + y, new_conv_a, new_conv_qkv, s.astype(dt)


def setup_inputs(seed: int = 0) -> dict:
    key = jax.random.key(seed)
    ks = jax.random.split(key, 16)
    f32 = jnp.float32
    nrm = jax.random.normal
    x_prompt = nrm(ks[0], (BATCH, SEQ, D_MODEL), f32)
    x_sample = nrm(ks[1], (DEC_BATCH, DEC_SEQ, D_MODEL), f32)
    state_conv_a = nrm(ks[2], (DEPTH, DEC_BATCH, CONV_A_W - 1, D_CONV_BR), f32)
    state_conv_qkv = nrm(ks[3], (DEPTH, DEC_BATCH, CONV_QKV_W - 1, D_QKV), f32)
    state_delta = 0.1 * nrm(ks[4], (DEPTH, DEC_BATCH, N_HEADS, HEAD_DIM, HEAD_DIM), f32)
    meta_tokens = nrm(ks[5], (N_META, D_MODEL), f32)
    norm_w = 1.0 + 0.02 * nrm(ks[6], (DEPTH, D_MODEL), f32)
    w_in = nrm(ks[7], (DEPTH, D_MODEL, D_PROJ), f32) * (D_MODEL ** -0.5)
    conv_a_w = nrm(ks[8], (DEPTH, CONV_A_W, D_CONV_BR), f32) * (CONV_A_W ** -0.5)
    conv_qkv_w = nrm(ks[9], (DEPTH, CONV_QKV_W, D_QKV), f32) * (CONV_QKV_W ** -0.5)
    a_log = jnp.log(jax.random.uniform(ks[10], (DEPTH, N_HEADS), f32, 1.0, 16.0))
    dt0 = jnp.exp(jax.random.uniform(ks[11], (DEPTH, N_HEADS), f32, math.log(1e-3), math.log(1e-1)))
    dt_bias = dt0 + jnp.log(-jnp.expm1(-dt0))
    o_norm_w = 1.0 + 0.02 * nrm(ks[12], (DEPTH, HEAD_DIM), f32)
    w_out = nrm(ks[13], (DEPTH, D_MIX, D_MODEL), f32) * (D_MIX ** -0.5)
    final_norm_w = 1.0 + 0.02 * nrm(ks[14], (D_MODEL,), f32)
    return {"x_prompt": x_prompt, "x_sample": x_sample,
            "state_conv_a": state_conv_a, "state_conv_qkv": state_conv_qkv, "state_delta": state_delta,
            "meta_tokens": meta_tokens, "norm_w": norm_w, "w_in": w_in, "conv_a_w": conv_a_w,
            "conv_qkv_w": conv_qkv_w, "a_log": a_log, "dt_bias": dt_bias, "o_norm_w": o_norm_w,
            "w_out": w_out, "final_norm_w": final_norm_w}


def reference(x_prompt, x_sample, state_conv_a, state_conv_qkv, state_delta,
              meta_tokens, norm_w, w_in, conv_a_w, conv_qkv_w, a_log, dt_bias, o_norm_w,
              w_out, final_norm_w):
    dt = x_prompt.dtype
    b = x_prompt.shape[0]
    meta = jnp.broadcast_to(meta_tokens.astype(dt)[None], (b, N_META, D_MODEL))
    hp = jnp.concatenate([meta, x_prompt], axis=1)
    hs = x_sample
    zero_a = jnp.zeros((b, CONV_A_W - 1, D_CONV_BR), dt)
    zero_qkv = jnp.zeros((b, CONV_QKV_W - 1, D_QKV), dt)
    zero_s = jnp.zeros((b, N_HEADS, HEAD_DIM, HEAD_DIM), jnp.float32)
    p_a, p_qkv, p_s, s_a, s_qkv, s_s = [], [], [], [], [], []
    for layer in range(DEPTH):
        wts = (norm_w[layer], w_in[layer], conv_a_w[layer], conv_qkv_w[layer],
               a_log[layer], dt_bias[layer], o_norm_w[layer], w_out[layer])
        hp, ca, cq, st = _layer(hp, zero_a, zero_qkv, zero_s, N_META, *wts)
        p_a.append(ca); p_qkv.append(cq); p_s.append(st)
        hs, ca, cq, st = _layer(hs, state_conv_a[layer], state_conv_qkv[layer], state_delta[layer], 0, *wts)
        s_a.append(ca); s_qkv.append(cq); s_s.append(st)
    y_prompt = _rmsnorm(hp[:, N_META:], final_norm_w)
    y_sample = _rmsnorm(hs, final_norm_w)
    return (y_prompt, y_sample, jnp.stack(p_a), jnp.stack(p_qkv), jnp.stack(p_s),
            jnp.stack(s_a), jnp.stack(s_qkv), jnp.stack(s_s))
```

```cpp
#include <hip/hip_runtime.h>
#include <hip/hip_bf16.h>
#include <hip/hip_cooperative_groups.h>
#include <cstdio>
namespace cg = cooperative_groups;

typedef unsigned short u16;
using bf16x8 = __attribute__((ext_vector_type(8))) short;
using f32x4 = __attribute__((ext_vector_type(4))) float;

constexpr int DM = 2048;
constexpr int NP = 8208;
constexpr int NPP = 8448;
constexpr int TP = 8208;
constexpr int ROWS_P = 4 * TP;
constexpr int ROWS = ROWS_P + 512;
constexpr int ROWSP = 33536;
constexpr int NCHUNK = 524;
constexpr int NITEM = NCHUNK * 8;
constexpr float EPS = 1e-6f;

constexpr long OFF_WTIN = 0;
constexpr long OFF_WTOUT = OFF_WTIN + 2L * NPP * DM * 2;
constexpr long OFF_HB = OFF_WTOUT + 2L * DM * DM * 2;
constexpr long OFF_PROJ = OFF_HB + (long)ROWSP * DM * 2;
constexpr long OFF_YMIX = OFF_PROJ + (long)ROWS * NP * 2;
constexpr long OFF_SUMSQ = OFF_YMIX + (long)ROWSP * DM * 2;
constexpr long OFF_EGL = OFF_SUMSQ + 3L * ROWSP * 4;
constexpr long OFF_QK = OFF_EGL + 16896;
constexpr long OFF_UT = OFF_QK + (long)NITEM * 4096 * 2;
constexpr long WS_END = OFF_UT + (long)NITEM * 8192 * 2;
constexpr long OOFF_W = 0;
constexpr long OOFF_QG = OOFF_W + (long)NITEM * 8192 * 2;
constexpr long OOFF_KPT = OOFF_QG + (long)NITEM * 8192 * 2;
constexpr long YS_OFF = 67108864L;
constexpr long PCA_OFF = YS_OFF + 1048576L;
constexpr long PCQ_OFF = PCA_OFF + 16384L;
constexpr long PD_OFF = PCQ_OFF + 73728L;
constexpr long SCA_OFF = PD_OFF + 1048576L;
constexpr long SCQ_OFF = SCA_OFF + 32768L;
constexpr long SD_OFF = SCQ_OFF + 147456L;

struct Params {
  const float *xp, *xs, *sca, *scq, *sdel, *meta, *normw, *win, *cvaw, *cvqw, *alog, *dtb, *onw, *wout, *fnw;
  float* out;
  unsigned char* ws;
};

__device__ __forceinline__ u16 f2bf(float f) {
  unsigned u = __float_as_uint(f);
  u += 0x7fffu + ((u >> 16) & 1u);
  return (u16)(u >> 16);
}
__device__ __forceinline__ int opaque_tid() { int t; asm volatile("v_mov_b32 %0, %1" : "=v"(t) : "v"((int)threadIdx.x)); return t; }
__device__ __forceinline__ float bf2f(u16 h) { return __uint_as_float(((unsigned)h) << 16); }
__device__ __forceinline__ unsigned pack2(float a, float b) { return (unsigned)f2bf(a) | ((unsigned)f2bf(b) << 16); }
__device__ __forceinline__ uint2 pack4(float a, float b, float c, float d) { return make_uint2(pack2(a, b), pack2(c, d)); }
__device__ __forceinline__ void unpack4(uint2 v, float* o) {
  o[0] = __uint_as_float(v.x << 16); o[1] = __uint_as_float(v.x & 0xffff0000u);
  o[2] = __uint_as_float(v.y << 16); o[3] = __uint_as_float(v.y & 0xffff0000u);
}
__device__ __forceinline__ void unpack8(uint4 v, float* o) {
  o[0] = __uint_as_float(v.x << 16); o[1] = __uint_as_float(v.x & 0xffff0000u);
  o[2] = __uint_as_float(v.y << 16); o[3] = __uint_as_float(v.y & 0xffff0000u);
  o[4] = __uint_as_float(v.z << 16); o[5] = __uint_as_float(v.z & 0xffff0000u);
  o[6] = __uint_as_float(v.w << 16); o[7] = __uint_as_float(v.w & 0xffff0000u);
}
__device__ __forceinline__ float silu_f(float x) { return x / (1.f + __expf(-x)); }
__device__ __forceinline__ f32x4 mfma16(bf16x8 a, bf16x8 b, f32x4 c) {
  return __builtin_amdgcn_mfma_f32_16x16x32_bf16(a, b, c, 0, 0, 0);
}
__device__ __forceinline__ bf16x8 ldfrag(const u16* base, int stride, int row, int k) {
  return *reinterpret_cast<const bf16x8*>(base + row * stride + k);
}

__device__ __forceinline__ f32x4 mm16(const float* X, int xr, int xc, const float* Y, int yr, int yc, int kn, int fr, int fq) {
  f32x4 c = {0.f, 0.f, 0.f, 0.f};
  for (int k0 = 0; k0 < kn; k0 += 4) {
    const float a = X[(xr + fr) * 68 + xc + k0 + fq];
    const float b = Y[(yr + k0 + fq) * 68 + yc + fr];
    c = __builtin_amdgcn_mfma_f32_16x16x4f32(a, b, c, 0, 0, 0);
  }
  return c;
}

__device__ __forceinline__ void transpose_tiles(const float* __restrict__ src, u16* __restrict__ dst, const float* __restrict__ scale,
                                                int nsrc, int ntile_n, unsigned char* smem) {
  float* tile = (float*)smem;
  const int tid = opaque_tid();
  const int ntiles = 32 * ntile_n;
  for (int t = blockIdx.x; t < ntiles; t += gridDim.x) {
    const int kt = t & 31, nt = t >> 5;
    const int k0 = kt * 64, n0 = nt * 64;
    {
      const int nl = tid & 63, kb = tid >> 6;
#pragma unroll
      for (int it = 0; it < 8; ++it) {
        const int kl = kb + it * 8;
        const int n = n0 + nl;
        float v = 0.f;
        if (n < nsrc) v = src[(long)(k0 + kl) * nsrc + n] * (scale ? scale[k0 + kl] : 1.f);
        tile[kl * 65 + nl] = v;
      }
    }
    __syncthreads();
    {
      const int nl = tid >> 3, kg = tid & 7;
      float v[8];
#pragma unroll
      for (int e = 0; e < 8; ++e) v[e] = tile[(kg * 8 + e) * 65 + nl];
      uint4 o;
      o.x = pack2(v[0], v[1]); o.y = pack2(v[2], v[3]); o.z = pack2(v[4], v[5]); o.w = pack2(v[6], v[7]);
      *reinterpret_cast<uint4*>(dst + (long)(n0 + nl) * DM + k0 + kg * 8) = o;
    }
    __syncthreads();
  }
}

__device__ __forceinline__ void phase_prep(const Params& p, unsigned char* smem) {
  const int tid = opaque_tid(), wv = tid >> 6, lane = tid & 63;
  u16* hb = (u16*)(p.ws + OFF_HB);
  float* sumsq = (float*)(p.ws + OFF_SUMSQ);
  for (int r = blockIdx.x * 8 + wv; r < ROWSP; r += gridDim.x * 8) {
    const float* src = nullptr;
    if (r < ROWS_P) {
      const int b = r / TP, t = r - b * TP;
      src = (t < 16) ? (p.meta + (long)t * DM) : (p.xp + ((long)b * 8192 + (t - 16)) * DM);
    } else if (r < ROWS) {
      src = p.xs + (long)(r - ROWS_P) * DM;
    }
    float ss = 0.f;
#pragma unroll
    for (int i = 0; i < 8; ++i) {
      const int c = (i * 64 + lane) * 4;
      float4 v = make_float4(0.f, 0.f, 0.f, 0.f);
      if (src) v = *reinterpret_cast<const float4*>(src + c);
      ss += v.x * v.x + v.y * v.y + v.z * v.z + v.w * v.w;
      *reinterpret_cast<uint2*>(hb + (long)r * DM + c) = pack4(v.x, v.y, v.z, v.w);
    }
#pragma unroll
    for (int o = 32; o > 0; o >>= 1) ss += __shfl_xor(ss, o);
    if (lane == 0) sumsq[r] = ss;
  }
  for (long i = (long)blockIdx.x * 512 + tid; i < 2L * ROWSP; i += (long)gridDim.x * 512) sumsq[ROWSP + i] = 0.f;
  for (int l = 0; l < 2; ++l) {
    transpose_tiles(p.win + (long)l * DM * NP, (u16*)(p.ws + OFF_WTIN) + (long)l * NPP * DM, p.normw + l * DM, NP, NPP / 64, smem);
    transpose_tiles(p.wout + (long)l * DM * DM, (u16*)(p.ws + OFF_WTOUT) + (long)l * DM * DM, nullptr, DM, DM / 64, smem);
  }
}

constexpr int BM = 256, BK = 64, HALF = 128, HT = HALF * BK;

__device__ __forceinline__ int lds_byte(int r, int c) {
  int st = (r >> 4) * 2 + (c >> 5), rr = r & 15, cc = c & 31, ob = rr * 64 + cc * 2;
  return st * 1024 + (ob ^ (((ob >> 9) & 1) << 5));
}
__device__ __forceinline__ void stage_rc(int b, int& R, int& C) {
  int st = b / 1024, sb = b % 1024, swz = sb ^ (((sb >> 9) & 1) << 5);
  R = (st >> 1) * 16 + swz / 64; C = (st & 1) * 32 + (swz % 64) / 2;
}

template <int EPI>
__device__ __forceinline__ void gemm_phase(const Params& p, int layer, unsigned char* smem) {
  typedef __hip_bfloat16 bf16;
  bf16* shm = (bf16*)smem;
  const bf16* A = (const bf16*)(p.ws + (EPI == 1 ? OFF_HB : OFF_YMIX));
  const bf16* Bt = (EPI == 1) ? (const bf16*)(p.ws + OFF_WTIN) + (long)layer * NPP * DM
                              : (const bf16*)(p.ws + OFF_WTOUT) + (long)layer * DM * DM;
  constexpr int K = DM;
  constexpr int nM = ROWSP / BM;
  constexpr int nN = (EPI == 1) ? NPP / BM : DM / BM;
  constexpr int WGM = 8;
  constexpr int nwg = nM * nN;
#define SA(b, h) (shm + ((b) * 2 + (h)) * HT)
#define SB(b, h) (shm + (4 + (b) * 2 + (h)) * HT)
#define OA(b, h) ((((b) * 2 + (h)) * HT) * 2)
#define OB(b, h) (((4 + (b) * 2 + (h)) * HT) * 2)
#define STAGE(PO, BASE, br, kt) do { const char* _ub = (const char*)(BASE) + ((long)(br) * K + (long)(kt) * BK) * 2; \
      const unsigned _l = ldsw + (PO); \
      asm volatile("s_mov_b32 m0, %0\n\ts_nop 0\n\tglobal_load_lds_dwordx4 %1, %2" :: "s"(_l), "v"(soff0), "s"(_ub) : "memory"); \
      asm volatile("s_mov_b32 m0, %0\n\ts_nop 0\n\tglobal_load_lds_dwordx4 %1, %2" :: "s"(_l + 8192u), "v"(soff1), "s"(_ub) : "memory"); } while (0)
#define LDA(dst, b, h) for (int m = 0; m < 4; ++m) for (int k = 0; k < 2; ++k) \
    dst[m][k] = *reinterpret_cast<const bf16x8*>((char*)SA(b, h) + lds_byte(wr * 64 + m * 16 + fr, k * 32 + fq * 8))
#define LDB(dst, b, h) for (int n = 0; n < 2; ++n) for (int k = 0; k < 2; ++k) \
    dst[n][k] = *reinterpret_cast<const bf16x8*>((char*)SB(b, h) + lds_byte(wc * 32 + n * 16 + fr, k * 32 + fq * 8))
#define MMA(ai, bj, At, Bt_) do { __builtin_amdgcn_s_setprio(1); \
    for (int m = 0; m < 4; ++m) for (int n = 0; n < 2; ++n) for (int k = 0; k < 2; ++k) \
      acc[ai][bj][m][n] = __builtin_amdgcn_mfma_f32_16x16x32_bf16(At[m][k], Bt_[n][k], acc[ai][bj][m][n], 0, 0, 0); \
    __builtin_amdgcn_s_setprio(0); } while (0)
#define WAIT_V(n) asm volatile("s_waitcnt vmcnt(" #n ")" ::: "memory")
#define WAIT_L(n) asm volatile("s_waitcnt lgkmcnt(" #n ")" ::: "memory")
#define BAR __builtin_amdgcn_s_barrier()
#define SCHED __builtin_amdgcn_sched_barrier(0)

  const int gtid = opaque_tid() & 511;
  const int wid = __builtin_amdgcn_readfirstlane(gtid >> 6), lane = gtid & 63, wr = wid >> 2, wc = wid & 3, fr = lane & 15, fq = lane >> 4;
  unsigned soff0, soff1;
  { int _r, _c; stage_rc(gtid * 16, _r, _c); soff0 = (unsigned)(_r * K + _c) * 2u;
    stage_rc(gtid * 16 + 8192, _r, _c); soff1 = (unsigned)(_r * K + _c) * 2u; }
  const unsigned ldsw = (unsigned)(size_t)((__attribute__((address_space(3))) unsigned char*)smem) + (unsigned)wid * 1024u;
  int vb = blockIdx.x;
  if ((gridDim.x & 7) == 0) vb = (blockIdx.x & 7) * (gridDim.x >> 3) + (blockIdx.x >> 3);
  constexpr int nig = WGM * nN;
  for (int wgid = vb; wgid < nwg; wgid += gridDim.x) {
    const int gid = wgid / nig, fm = gid * WGM, gsz = min(nM - fm, WGM);
    const int pm = fm + ((wgid % nig) % gsz), pn = (wgid % nig) / gsz, brow = pm * BM, bcol = pn * BM;
    f32x4 acc[2][2][4][2] = {};
    bf16x8 At[4][2], B0[2][2], B1[2][2];
    constexpr int nt = K / BK;
    STAGE(OB(0, 0), Bt, bcol, 0); STAGE(OA(0, 0), A, brow, 0);
    STAGE(OB(0, 1), Bt, bcol + HALF, 0); STAGE(OA(0, 1), A, brow + HALF, 0);
    if (wr == 1) BAR;
    WAIT_V(4); BAR;
    STAGE(OB(1, 0), Bt, bcol, 1); STAGE(OA(1, 0), A, brow, 1); STAGE(OB(1, 1), Bt, bcol + HALF, 1);
    WAIT_V(6); BAR;
    for (int t = 0; t < nt - 2; t += 2) {
      LDB(B0, 0, 0); SCHED; LDA(At, 0, 0); STAGE(OA(1, 1), A, brow + HALF, t + 1);
      WAIT_L(8); BAR; WAIT_L(0); MMA(0, 0, At, B0); BAR; SCHED;
      LDB(B1, 0, 1); STAGE(OB(0, 0), Bt, bcol, t + 2);
      BAR; WAIT_L(0); MMA(0, 1, At, B1); BAR;
      LDA(At, 0, 1); STAGE(OA(0, 0), A, brow, t + 2);
      BAR; WAIT_L(0); MMA(1, 0, At, B0); BAR; SCHED;
      STAGE(OB(0, 1), Bt, bcol + HALF, t + 2);
      WAIT_V(6); BAR; MMA(1, 1, At, B1); BAR;
      LDB(B0, 1, 0); SCHED; LDA(At, 1, 0); STAGE(OA(0, 1), A, brow + HALF, t + 2);
      WAIT_L(8); BAR; WAIT_L(0); MMA(0, 0, At, B0); BAR; SCHED;
      LDB(B1, 1, 1); STAGE(OB(1, 0), Bt, bcol, t + 3);
      BAR; WAIT_L(0); MMA(0, 1, At, B1); BAR;
      LDA(At, 1, 1); STAGE(OA(1, 0), A, brow, t + 3);
      BAR; WAIT_L(0); MMA(1, 0, At, B0); BAR; SCHED;
      STAGE(OB(1, 1), Bt, bcol + HALF, t + 3);
      WAIT_V(6); BAR; MMA(1, 1, At, B1); BAR;
    }
    { LDB(B0, 0, 0); LDA(At, 0, 0); STAGE(OA(1, 1), A, brow + HALF, nt - 1);
      BAR; WAIT_L(0); MMA(0, 0, At, B0); BAR;
      LDB(B1, 0, 1); BAR; WAIT_L(0); MMA(0, 1, At, B1); BAR;
      LDA(At, 0, 1); WAIT_V(4); BAR; WAIT_L(0); MMA(1, 0, At, B0); MMA(1, 1, At, B1); BAR; }
    { LDB(B0, 1, 0); LDA(At, 1, 0); WAIT_V(2); BAR; WAIT_L(0); MMA(0, 0, At, B0); BAR;
      LDB(B1, 1, 1); WAIT_V(0); BAR; WAIT_L(0); MMA(0, 1, At, B1); BAR;
      LDA(At, 1, 1); BAR; WAIT_L(0); MMA(1, 0, At, B0); MMA(1, 1, At, B1); BAR; }
    if (wr == 0) BAR;
    if (EPI == 1) {
      u16* proj = (u16*)(p.ws + OFF_PROJ);
      const float* sumsq = (const float*)(p.ws + OFF_SUMSQ) + (long)layer * ROWSP;
#pragma unroll
      for (int ai = 0; ai < 2; ++ai)
#pragma unroll
        for (int m = 0; m < 4; ++m)
#pragma unroll
          for (int j = 0; j < 4; ++j) {
            const int row = brow + ai * HALF + wr * 64 + m * 16 + fq * 4 + j;
            if (row < ROWS) {
              const float rs = rsqrtf(sumsq[row] * (1.f / DM) + EPS);
#pragma unroll
              for (int bj = 0; bj < 2; ++bj)
#pragma unroll
                for (int n = 0; n < 2; ++n) {
                  const int col = bcol + bj * HALF + wc * 32 + n * 16 + fr;
                  if (col < NP) proj[(long)row * NP + col] = f2bf(acc[ai][bj][m][n][j] * rs);
                }
            }
          }
    } else {
      u16* hb = (u16*)(p.ws + OFF_HB);
      float* sumsq = (float*)(p.ws + OFF_SUMSQ) + (long)(EPI == 2 ? 1 : 2) * ROWSP;
#pragma unroll
      for (int ai = 0; ai < 2; ++ai)
#pragma unroll
        for (int m = 0; m < 4; ++m)
#pragma unroll
          for (int j = 0; j < 4; ++j) {
            const int row = brow + ai * HALF + wr * 64 + m * 16 + fq * 4 + j;
            float* dst = nullptr;
            if (EPI == 3) {
              if (row < ROWS_P) {
                const int b = row / TP, t = row - b * TP;
                if (t >= 16) dst = p.out + ((long)b * 8192 + (t - 16)) * DM;
              } else if (row < ROWS) {
                dst = p.out + YS_OFF + (long)(row - ROWS_P) * DM;
              }
            }
            float rsum = 0.f;
#pragma unroll
            for (int bj = 0; bj < 2; ++bj)
#pragma unroll
              for (int n = 0; n < 2; ++n) {
                const int col = bcol + bj * HALF + wc * 32 + n * 16 + fr;
                const float v = acc[ai][bj][m][n][j] + bf2f(hb[(long)row * DM + col]);
                rsum += v * v;
                if (EPI == 2) hb[(long)row * DM + col] = f2bf(v);
                else if (dst) dst[col] = v;
              }
            rsum += __shfl_xor(rsum, 1); rsum += __shfl_xor(rsum, 2);
            rsum += __shfl_xor(rsum, 4); rsum += __shfl_xor(rsum, 8);
            if (fr == 0) atomicAdd(&sumsq[row], rsum);
          }
    }
    __syncthreads();
  }
#undef SA
#undef SB
#undef OA
#undef OB
#undef STAGE
#undef LDA
#undef LDB
#undef MMA
}

__device__ __forceinline__ void chunk_geom(int cid, int& row0, int& nvalid, int& prevmode, int& sidx, bool& lastc) {
  if (cid < 516) {
    const int s = cid / 129, c = cid - s * 129;
    sidx = s; lastc = (c == 128);
    if (c == 0) { row0 = s * TP; nvalid = 16; prevmode = 0; }
    else { row0 = s * TP + 16 + (c - 1) * 64; nvalid = 64; prevmode = 1; }
  } else {
    sidx = cid - 516; row0 = ROWS_P + sidx * 64; nvalid = 64; prevmode = 2; lastc = true;
  }
}

__device__ __forceinline__ void chunk_prep(const Params& p, int layer, int item, unsigned char* smem) {
  const int tid = opaque_tid() & 511, wv = __builtin_amdgcn_readfirstlane(tid >> 6), lane = tid & 63, fr = lane & 15, fq = lane >> 4;
  const int cid = item >> 3, h = item & 7;
  int row0, nvalid, prevmode, sidx; bool lastc;
  chunk_geom(cid, row0, nvalid, prevmode, sidx, lastc);
  u16* sKB = (u16*)smem;
  u16* sK = sKB + 64 * 136;
  u16* sQ = sK + 64 * 136;
  u16* sVBT = sQ + 64 * 136;
  u16* sKBGT = sVBT + 128 * 72;
  u16* sT = sKBGT + 128 * 72;
  float* sA = (float*)(sT + 64 * 72);
  float* sBeta = sA + 64 * 68;
  float* sGc = sBeta + 64;
  float* sTf = (float*)smem;
  float* sY = sTf + 64 * 68;
  int zoff;
  asm volatile("v_mov_b32 %0, 0" : "=v"(zoff));
  const u16* proj = (const u16*)(p.ws + OFF_PROJ);
  u16* QG = (u16*)((unsigned char*)p.out + OOFF_QG) + (long)item * 8192;
  u16* KPT = (u16*)((unsigned char*)p.out + OOFF_KPT) + (long)item * 8192;
  u16* Wd = (u16*)((unsigned char*)p.out + OOFF_W) + (long)item * 8192;
  u16* QKd = (u16*)(p.ws + OFF_QK) + (long)item * 4096;
  u16* UTd = (u16*)(p.ws + OFF_UT) + (long)item * 8192;
  float* EGL = (float*)(p.ws + OFF_EGL);

  if (wv == 0) {
    float beta = 0.f, g = 0.f;
    if (lane < nvalid) {
      const long rb = (long)(row0 + lane) * NP;
      const float bl = bf2f(proj[rb + 8192 + h]);
      const float al = bf2f(proj[rb + 8200 + h]) + p.dtb[layer * 8 + h];
      beta = 1.f / (1.f + expf(-bl));
      const float sp = (al > 20.f) ? al : log1pf(expf(al));
      g = -expf(p.alog[layer * 8 + h]) * sp;
    }
    float gc = g;
#pragma unroll
    for (int o = 1; o < 64; o <<= 1) { const float t = __shfl_up(gc, o); if (lane >= o) gc += t; }
    sBeta[lane] = beta; sGc[lane] = gc;
  }

  const int rg = tid >> 5, cg = tid & 31, i0 = rg * 4, d0 = cg * 4;
  float qv[4][4], kv[4][4], vv[4][4];
#pragma unroll
  for (int mat = 0; mat < 3; ++mat) {
    const int ch = mat * 1024 + h * 128 + d0;
    const int colbase = 4096 + ch;
    float xr[7][4];
#pragma unroll
    for (int a = 0; a < 7; ++a) {
      const int ri = i0 - 3 + a;
      if (ri >= 0 || prevmode == 1) {
        uint2 raw = *reinterpret_cast<const uint2*>(proj + (long)(row0 + ri) * NP + colbase);
        unpack4(raw, xr[a]);
      } else if (prevmode == 2) {
        const float4 v = *reinterpret_cast<const float4*>(p.scq + ((long)(layer * 8 + sidx) * 3 + (3 + ri)) * 3072 + ch);
        xr[a][0] = v.x; xr[a][1] = v.y; xr[a][2] = v.z; xr[a][3] = v.w;
      } else {
        xr[a][0] = xr[a][1] = xr[a][2] = xr[a][3] = 0.f;
      }
    }
    if (lastc && rg == 15) {
      float* dst = p.out + (prevmode == 2 ? SCQ_OFF + (long)(layer * 8 + sidx) * 3 * 3072 : PCQ_OFF + (long)(layer * 4 + sidx) * 3 * 3072) + ch;
#pragma unroll
      for (int a = 4; a < 7; ++a)
        *reinterpret_cast<float4*>(dst + (a - 4) * 3072) = make_float4(xr[a][0], xr[a][1], xr[a][2], xr[a][3]);
    }
    float cw[4][4];
#pragma unroll
    for (int j = 0; j < 4; ++j) {
      const float4 v = *reinterpret_cast<const float4*>(p.cvqw + (long)(layer * 4 + j) * 3072 + ch);
      cw[j][0] = v.x; cw[j][1] = v.y; cw[j][2] = v.z; cw[j][3] = v.w;
    }
#pragma unroll
    for (int ii = 0; ii < 4; ++ii)
#pragma unroll
      for (int e = 0; e < 4; ++e) {
        float o = 0.f;
#pragma unroll
        for (int j = 0; j < 4; ++j) o += cw[j][e] * xr[ii + j][e];
        o = silu_f(o);
        if (mat == 0) qv[ii][e] = o; else if (mat == 1) kv[ii][e] = o; else vv[ii][e] = o;
      }
  }
#pragma unroll
  for (int ii = 0; ii < 4; ++ii) {
    float sq = 0.f, sk = 0.f;
#pragma unroll
    for (int e = 0; e < 4; ++e) { sq += qv[ii][e] * qv[ii][e]; sk += kv[ii][e] * kv[ii][e]; }
#pragma unroll
    for (int o = 1; o < 32; o <<= 1) { sq += __shfl_xor(sq, o); sk += __shfl_xor(sk, o); }
    const float rq = rsqrtf(sq + EPS) * 0.08838834764831845f, rk = rsqrtf(sk + EPS);
    const bool valid = (i0 + ii) < nvalid;
#pragma unroll
    for (int e = 0; e < 4; ++e) {
      qv[ii][e] = valid ? qv[ii][e] * rq : 0.f;
      kv[ii][e] = valid ? kv[ii][e] * rk : 0.f;
      vv[ii][e] = valid ? vv[ii][e] : 0.f;
    }
  }
  __syncthreads();
  float beta[4], gcv[4];
#pragma unroll
  for (int ii = 0; ii < 4; ++ii) { beta[ii] = sBeta[i0 + ii]; gcv[ii] = sGc[i0 + ii]; }
  const float glast = sGc[63];
  if (tid == 0) EGL[item] = expf(glast);

#pragma unroll
  for (int ii = 0; ii < 4; ++ii) {
    const int i = i0 + ii;
    const float b = beta[ii], eg = expf(gcv[ii]);
    *reinterpret_cast<uint2*>(sKB + i * 136 + d0) = pack4(kv[ii][0] * b, kv[ii][1] * b, kv[ii][2] * b, kv[ii][3] * b);
    *reinterpret_cast<uint2*>(sK + i * 136 + d0) = pack4(kv[ii][0], kv[ii][1], kv[ii][2], kv[ii][3]);
    *reinterpret_cast<uint2*>(sQ + i * 136 + d0) = pack4(qv[ii][0], qv[ii][1], qv[ii][2], qv[ii][3]);
    *reinterpret_cast<uint2*>(QG + i * 128 + d0) = pack4(qv[ii][0] * eg, qv[ii][1] * eg, qv[ii][2] * eg, qv[ii][3] * eg);
  }
  {
    float bg[4], kd[4];
#pragma unroll
    for (int ii = 0; ii < 4; ++ii) { bg[ii] = beta[ii] * expf(gcv[ii]); kd[ii] = expf(glast - gcv[ii]); }
#pragma unroll
    for (int e = 0; e < 4; ++e) {
      const int d = d0 + e;
      *reinterpret_cast<uint2*>(sVBT + d * 72 + i0) = pack4(vv[0][e] * beta[0], vv[1][e] * beta[1], vv[2][e] * beta[2], vv[3][e] * beta[3]);
      *reinterpret_cast<uint2*>(sKBGT + d * 72 + i0) = pack4(kv[0][e] * bg[0], kv[1][e] * bg[1], kv[2][e] * bg[2], kv[3][e] * bg[3]);
      *reinterpret_cast<uint2*>(KPT + d * 64 + i0) = pack4(kv[0][e] * kd[0], kv[1][e] * kd[1], kv[2][e] * kd[2], kv[3][e] * kd[3]);
    }
  }
  __syncthreads();
  {
    const int ib = wv >> 1;
#pragma unroll
    for (int jj = 0; jj < 2; ++jj) {
      const int jb = (wv & 1) * 2 + jj;
      f32x4 c = {0.f, 0.f, 0.f, 0.f}, c2 = {0.f, 0.f, 0.f, 0.f};
#pragma unroll
      for (int kk = 0; kk < 4; ++kk) {
        const bf16x8 a = ldfrag(sKB, 136, ib * 16 + fr, kk * 32 + fq * 8);
        const bf16x8 b = ldfrag(sK, 136, jb * 16 + fr, kk * 32 + fq * 8);
        c = mfma16(a, b, c);
        const bf16x8 b2 = ldfrag(sQ, 136, ib * 16 + fr, kk * 32 + fq * 8);
        c2 = mfma16(b, b2, c2);
      }
      {
        const int j = jb * 16 + fr;
        const float gj = sGc[j];
#pragma unroll
        for (int r = 0; r < 4; ++r) {
          const int i = ib * 16 + fq * 4 + r;
          sA[i * 68 + j] = (i > j) ? c[r] * expf(sGc[i] - gj) : 0.f;
        }
      }
      {
        const int i = ib * 16 + fr;
        const float gi = sGc[i];
        float o[4];
#pragma unroll
        for (int r = 0; r < 4; ++r) {
          const int j = jb * 16 + fq * 4 + r;
          o[r] = (i >= j) ? c2[r] * expf(gi - sGc[j]) : 0.f;
        }
        *reinterpret_cast<uint2*>(QKd + i * 64 + jb * 16 + fq * 4) = pack4(o[0], o[1], o[2], o[3]);
      }
    }
  }
  __syncthreads();
  {
    for (int e = tid; e < 64 * 68; e += 512) sTf[e] = 0.f;
    __syncthreads();
    if (wv < 4 && lane < 16) {
      const float* Ab = sA + (wv * 16) * 68 + wv * 16 + zoff;
      float t[16], ac[16], an[16];
      t[0] = (lane == 0) ? 1.f : 0.f;
      sTf[(wv * 16) * 68 + wv * 16 + lane] = t[0];
      ac[0] = Ab[68];
#pragma unroll
      for (int i = 1; i < 16; ++i) {
        if (i + 1 < 16) {
#pragma unroll
          for (int j = 0; j <= i; ++j) an[j] = Ab[(i + 1) * 68 + j];
        }
        float a = (lane == i) ? 1.f : 0.f;
#pragma unroll
        for (int j = 0; j < i; ++j) a -= ac[j] * t[j];
        t[i] = a;
        sTf[(wv * 16 + i) * 68 + wv * 16 + lane] = a;
        if (i + 1 < 16) {
#pragma unroll
          for (int j = 0; j <= i; ++j) ac[j] = an[j];
        }
        __builtin_amdgcn_sched_barrier(0);
      }
    }
    __syncthreads();
    if (wv < 2) {
      const int o = wv * 32;
      const f32x4 c = mm16(sA, o + 16, o, sTf, o, o, 16, fr, fq);
#pragma unroll
      for (int r = 0; r < 4; ++r) sY[(o + 16 + fq * 4 + r) * 68 + o + fr] = c[r];
    }
    __syncthreads();
    if (wv < 2) {
      const int o = wv * 32;
      const f32x4 c = mm16(sTf, o + 16, o + 16, sY, o + 16, o, 16, fr, fq);
#pragma unroll
      for (int r = 0; r < 4; ++r) sTf[(o + 16 + fq * 4 + r) * 68 + o + fr] = -c[r];
    }
    __syncthreads();
    if (wv < 4) {
      const int bi = wv >> 1, bj = wv & 1;
      const f32x4 c = mm16(sA, 32 + bi * 16, 0, sTf, 0, bj * 16, 32, fr, fq);
#pragma unroll
      for (int r = 0; r < 4; ++r) sY[(32 + bi * 16 + fq * 4 + r) * 68 + bj * 16 + fr] = c[r];
    }
    __syncthreads();
    if (wv < 4) {
      const int bi = wv >> 1, bj = wv & 1;
      const f32x4 c = mm16(sTf, 32 + bi * 16, 32, sY, 32, bj * 16, 32, fr, fq);
#pragma unroll
      for (int r = 0; r < 4; ++r) sTf[(32 + bi * 16 + fq * 4 + r) * 68 + bj * 16 + fr] = -c[r];
    }
    __syncthreads();
    {
      const int i = tid >> 3, j0 = (tid & 7) * 8;
      float v[8];
#pragma unroll
      for (int e = 0; e < 8; ++e) v[e] = sTf[i * 68 + j0 + e];
      uint4 o;
      o.x = pack2(v[0], v[1]); o.y = pack2(v[2], v[3]); o.z = pack2(v[4], v[5]); o.w = pack2(v[6], v[7]);
      *reinterpret_cast<uint4*>(sT + i * 72 + j0) = o;
    }
  }
  __syncthreads();
  {
    const int ib = wv >> 1;
#pragma unroll
    for (int x = 0; x < 4; ++x) {
      const int dvb = (wv & 1) * 4 + x;
      f32x4 c = {0.f, 0.f, 0.f, 0.f};
#pragma unroll
      for (int kk = 0; kk < 2; ++kk)
        c = mfma16(ldfrag(sT, 72, ib * 16 + fr, kk * 32 + fq * 8), ldfrag(sVBT, 72, dvb * 16 + fr, kk * 32 + fq * 8), c);
      *reinterpret_cast<uint2*>(UTd + (dvb * 16 + fr) * 64 + ib * 16 + fq * 4) = pack4(c[0], c[1], c[2], c[3]);
    }
#pragma unroll
    for (int ib2 = 0; ib2 < 4; ++ib2) {
      f32x4 c = {0.f, 0.f, 0.f, 0.f};
#pragma unroll
      for (int kk = 0; kk < 2; ++kk)
        c = mfma16(ldfrag(sKBGT, 72, wv * 16 + fr, kk * 32 + fq * 8), ldfrag(sT, 72, ib2 * 16 + fr, kk * 32 + fq * 8), c);
      *reinterpret_cast<uint2*>(Wd + (ib2 * 16 + fr) * 128 + wv * 16 + fq * 4) = pack4(c[0], c[1], c[2], c[3]);
    }
  }
  __syncthreads();
}

__device__ __forceinline__ void gdn_scan(const Params& p, int layer, int widx, unsigned char* smem) {
  const int tid = opaque_tid() & 511, wv = __builtin_amdgcn_readfirstlane(tid >> 6), lane = tid & 63, fr = lane & 15, fq = lane >> 4;
  const bool is_prompt = widx < 128;
  int s, h, sl, nsteps, cid0;
  if (is_prompt) { s = widx >> 5; h = (widx >> 2) & 7; sl = widx & 3; nsteps = 129; cid0 = s * 129; }
  else { const int j = widx - 128; s = j >> 5; h = (j >> 2) & 7; sl = j & 3; nsteps = 1; cid0 = 516 + s; }
  const int dv0 = sl * 32;
  u16* sST = (u16*)smem;
  u16* sVT = sST + 32 * 136;
  const u16* Wg = (const u16*)((const unsigned char*)p.out + OOFF_W);
  const u16* QGg = (const u16*)((const unsigned char*)p.out + OOFF_QG);
  const u16* KPTg = (const u16*)((const unsigned char*)p.out + OOFF_KPT);
  const u16* QKg = (const u16*)(p.ws + OFF_QK);
  const u16* UTg = (const u16*)(p.ws + OFF_UT);
  const float* EGL = (const float*)(p.ws + OFF_EGL);
  u16* ymix = (u16*)(p.ws + OFF_YMIX);

  f32x4 accS[2];
#pragma unroll
  for (int nb = 0; nb < 2; ++nb) {
    if (is_prompt) { accS[nb][0] = 0.f; accS[nb][1] = 0.f; accS[nb][2] = 0.f; accS[nb][3] = 0.f; }
    else {
      const float4 v = *reinterpret_cast<const float4*>(p.sdel + ((long)(layer * 8 + s) * 8 + h) * 16384 + (wv * 16 + fr) * 128 + dv0 + nb * 16 + fq * 4);
      accS[nb][0] = v.x; accS[nb][1] = v.y; accS[nb][2] = v.z; accS[nb][3] = v.w;
    }
#pragma unroll
    for (int r = 0; r < 4; ++r) sST[(nb * 16 + fq * 4 + r) * 136 + wv * 16 + fr] = f2bf(accS[nb][r]);
  }
  __syncthreads();
  const int ib = wv >> 1, nbv = wv & 1;
  for (int step = 0; step < nsteps; ++step) {
    const int cid = cid0 + step;
    const long item = (long)cid * 8 + h;
    int row0, nvalid, prevmode, sidx; bool lastc;
    chunk_geom(cid, row0, nvalid, prevmode, sidx, lastc);
    const u16* Wp = Wg + item * 8192;
    const u16* QGp = QGg + item * 8192;
    const u16* QKp = QKg + item * 4096;
    const u16* KPTp = KPTg + item * 8192;
    const u16* UTp = UTg + item * 8192;
    bf16x8 wf[4], qf[4], qkf[2], kpf[2];
#pragma unroll
    for (int kk = 0; kk < 4; ++kk) {
      wf[kk] = *reinterpret_cast<const bf16x8*>(Wp + (ib * 16 + fr) * 128 + kk * 32 + fq * 8);
      qf[kk] = *reinterpret_cast<const bf16x8*>(QGp + (ib * 16 + fr) * 128 + kk * 32 + fq * 8);
    }
#pragma unroll
    for (int kk = 0; kk < 2; ++kk) {
      qkf[kk] = *reinterpret_cast<const bf16x8*>(QKp + (ib * 16 + fr) * 64 + kk * 32 + fq * 8);
      kpf[kk] = *reinterpret_cast<const bf16x8*>(KPTp + (wv * 16 + fr) * 64 + kk * 32 + fq * 8);
    }
    float uu[4];
    unpack4(*reinterpret_cast<const uint2*>(UTp + (dv0 + nbv * 16 + fr) * 64 + ib * 16 + fq * 4), uu);
    const float egl = EGL[item];
    f32x4 cw = {0.f, 0.f, 0.f, 0.f}, co = {0.f, 0.f, 0.f, 0.f};
#pragma unroll
    for (int kk = 0; kk < 4; ++kk) {
      const bf16x8 sf = ldfrag(sST, 136, nbv * 16 + fr, kk * 32 + fq * 8);
      cw = mfma16(wf[kk], sf, cw);
      co = mfma16(qf[kk], sf, co);
    }
    *reinterpret_cast<uint2*>(sVT + (nbv * 16 + fr) * 72 + ib * 16 + fq * 4) = pack4(uu[0] - cw[0], uu[1] - cw[1], uu[2] - cw[2], uu[3] - cw[3]);
    __syncthreads();
#pragma unroll
    for (int kk = 0; kk < 2; ++kk)
      co = mfma16(qkf[kk], ldfrag(sVT, 72, nbv * 16 + fr, kk * 32 + fq * 8), co);
#pragma unroll
    for (int r = 0; r < 4; ++r) {
      const int i = ib * 16 + fq * 4 + r;
      if (i < nvalid) ymix[(long)(row0 + i) * DM + 1024 + h * 128 + dv0 + nbv * 16 + fr] = f2bf(co[r]);
    }
#pragma unroll
    for (int nb = 0; nb < 2; ++nb) {
      f32x4 c = accS[nb];
      c[0] *= egl; c[1] *= egl; c[2] *= egl; c[3] *= egl;
#pragma unroll
      for (int kk = 0; kk < 2; ++kk)
        c = mfma16(ldfrag(sVT, 72, nb * 16 + fr, kk * 32 + fq * 8), kpf[kk], c);
      accS[nb] = c;
#pragma unroll
      for (int r = 0; r < 4; ++r) sST[(nb * 16 + fq * 4 + r) * 136 + wv * 16 + fr] = f2bf(c[r]);
    }
    __syncthreads();
  }
  float* dst = p.out + (is_prompt ? PD_OFF + ((long)(layer * 4 + s) * 8 + h) * 16384 : SD_OFF + ((long)(layer * 8 + s) * 8 + h) * 16384);
#pragma unroll
  for (int nb = 0; nb < 2; ++nb)
    *reinterpret_cast<float4*>(dst + (wv * 16 + fr) * 128 + dv0 + nb * 16 + fq * 4) = make_float4(accS[nb][0], accS[nb][1], accS[nb][2], accS[nb][3]);
}

constexpr int NUNIT = 4 * 513 + 32;
__device__ __forceinline__ void mixer_a_group(const Params& p, int layer, int ug) {
  const int tid = opaque_tid() & 511;
  const int uid = ug * 4 + (tid >> 7);
  if (uid >= NUNIT) return;
  const int c0 = (tid & 127) * 8;
  int row0, sidx; bool first, last, samp;
  if (uid < 2052) { sidx = uid / 513; const int k = uid - sidx * 513; row0 = sidx * TP + 16 * k; first = (k == 0); last = (k == 512); samp = false; }
  else { const int v = uid - 2052; sidx = v >> 2; const int k = v & 3; row0 = ROWS_P + sidx * 64 + 16 * k; first = (k == 0); last = (k == 3); samp = true; }
  const u16* proj = (const u16*)(p.ws + OFF_PROJ);
  u16* ymix = (u16*)(p.ws + OFF_YMIX);
  float w0[8], w1[8], w2[8], um2[8], um1[8];
  {
    const float* cw = p.cvaw + (long)layer * 3 * 1024 + c0;
#pragma unroll
    for (int e = 0; e < 8; ++e) { w0[e] = cw[e]; w1[e] = cw[1024 + e]; w2[e] = cw[2048 + e]; }
  }
  if (first) {
    if (samp) {
      const float* st = p.sca + (long)(layer * 8 + sidx) * 2 * 1024 + c0;
#pragma unroll
      for (int e = 0; e < 8; ++e) { um2[e] = st[e]; um1[e] = st[1024 + e]; }
    } else {
#pragma unroll
      for (int e = 0; e < 8; ++e) { um2[e] = 0.f; um1[e] = 0.f; }
    }
  } else {
    float c[8], x[8];
    unpack8(*reinterpret_cast<const uint4*>(proj + (long)(row0 - 2) * NP + 1024 + c0), c);
    unpack8(*reinterpret_cast<const uint4*>(proj + (long)(row0 - 2) * NP + 2048 + c0), x);
#pragma unroll
    for (int e = 0; e < 8; ++e) um2[e] = c[e] * x[e];
    unpack8(*reinterpret_cast<const uint4*>(proj + (long)(row0 - 1) * NP + 1024 + c0), c);
    unpack8(*reinterpret_cast<const uint4*>(proj + (long)(row0 - 1) * NP + 2048 + c0), x);
#pragma unroll
    for (int e = 0; e < 8; ++e) um1[e] = c[e] * x[e];
  }
  for (int t = 0; t < 16; ++t) {
    const long rb = (long)(row0 + t) * NP + c0;
    float b[8], c[8], x[8], z[8], y[8];
    unpack8(*reinterpret_cast<const uint4*>(proj + rb), b);
    unpack8(*reinterpret_cast<const uint4*>(proj + rb + 1024), c);
    unpack8(*reinterpret_cast<const uint4*>(proj + rb + 2048), x);
    unpack8(*reinterpret_cast<const uint4*>(proj + rb + 3072), z);
#pragma unroll
    for (int e = 0; e < 8; ++e) {
      const float u = c[e] * x[e];
      const float cv = w0[e] * um2[e] + w1[e] * um1[e] + w2[e] * u;
      y[e] = b[e] * cv * silu_f(z[e]);
      um2[e] = um1[e]; um1[e] = u;
    }
    uint4 o;
    o.x = pack2(y[0], y[1]); o.y = pack2(y[2], y[3]); o.z = pack2(y[4], y[5]); o.w = pack2(y[6], y[7]);
    *reinterpret_cast<uint4*>(ymix + (long)(row0 + t) * DM + c0) = o;
  }
  if (last) {
    float* dst = p.out + (samp ? SCA_OFF + (long)(layer * 8 + sidx) * 2 * 1024 : PCA_OFF + (long)(layer * 4 + sidx) * 2 * 1024) + c0;
#pragma unroll
    for (int e = 0; e < 8; ++e) { dst[e] = um2[e]; dst[1024 + e] = um1[e]; }
  }
}

__device__ __forceinline__ void phase_post(const Params& p, int layer) {
  const int tid = opaque_tid() & 511;
  const u16* proj = (const u16*)(p.ws + OFF_PROJ);
  u16* ymix = (u16*)(p.ws + OFF_YMIX);
  const int hh = (tid >> 4) & 7, d = (tid & 15) * 8;
  float w[8];
#pragma unroll
  for (int e = 0; e < 8; ++e) w[e] = p.onw[layer * 128 + d + e];
  for (int g = blockIdx.x; g < ROWS / 4; g += gridDim.x) {
    const int row = g * 4 + (tid >> 7);
    u16* op = ymix + (long)row * DM + 1024 + hh * 128 + d;
    float o[8], z[8];
    unpack8(*reinterpret_cast<const uint4*>(op), o);
    unpack8(*reinterpret_cast<const uint4*>(proj + (long)row * NP + 7168 + hh * 128 + d), z);
    float ss = 0.f;
#pragma unroll
    for (int e = 0; e < 8; ++e) ss += o[e] * o[e];
    ss += __shfl_xor(ss, 1); ss += __shfl_xor(ss, 2); ss += __shfl_xor(ss, 4); ss += __shfl_xor(ss, 8);
    const float rs = rsqrtf(ss * (1.f / 128.f) + EPS);
    float y[8];
#pragma unroll
    for (int e = 0; e < 8; ++e) y[e] = o[e] * rs * w[e] * silu_f(z[e]);
    uint4 ov;
    ov.x = pack2(y[0], y[1]); ov.y = pack2(y[2], y[3]); ov.z = pack2(y[4], y[5]); ov.w = pack2(y[6], y[7]);
    *reinterpret_cast<uint4*>(op) = ov;
  }
}

__device__ __forceinline__ void phase_final(const Params& p) {
  const int tid = opaque_tid() & 511, wv = tid >> 6, lane = tid & 63;
  const float* sumsq = (const float*)(p.ws + OFF_SUMSQ) + 2L * ROWSP;
  for (int r = blockIdx.x * 8 + wv; r < ROWS; r += gridDim.x * 8) {
    float* dst;
    if (r < ROWS_P) {
      const int b = r / TP, t = r - b * TP;
      if (t < 16) continue;
      dst = p.out + ((long)b * 8192 + (t - 16)) * DM;
    } else {
      dst = p.out + YS_OFF + (long)(r - ROWS_P) * DM;
    }
    const float rs = rsqrtf(sumsq[r] * (1.f / DM) + EPS);
#pragma unroll
    for (int i = 0; i < 8; ++i) {
      const int c = (i * 64 + lane) * 4;
      float4 v = *reinterpret_cast<const float4*>(dst + c);
      const float4 w = *reinterpret_cast<const float4*>(p.fnw + c);
      v.x *= rs * w.x; v.y *= rs * w.y; v.z *= rs * w.z; v.w *= rs * w.w;
      *reinterpret_cast<float4*>(dst + c) = v;
    }
  }
}

typedef const __attribute__((address_space(4))) Params* CParamsPtr;
__device__ __forceinline__ Params ldparams(CParamsPtr q) {
#if defined(__HIP_DEVICE_COMPILE__)
  asm volatile("" : "+s"(q));
  Params r;
  r.xp = q->xp; r.xs = q->xs; r.sca = q->sca; r.scq = q->scq; r.sdel = q->sdel; r.meta = q->meta; r.normw = q->normw; r.win = q->win;
  r.cvaw = q->cvaw; r.cvqw = q->cvqw; r.alog = q->alog; r.dtb = q->dtb; r.onw = q->onw; r.wout = q->wout; r.fnw = q->fnw;
  r.out = q->out; r.ws = q->ws;
  return r;
#else
  return Params{};
#endif
}

__global__ void __launch_bounds__(512) mega(Params p_unused) {
  extern __shared__ __attribute__((aligned(16))) unsigned char smem[];
  cg::grid_group grid = cg::this_grid();
  CParamsPtr kp = (CParamsPtr)__builtin_amdgcn_kernarg_segment_ptr();
  { const Params p = ldparams(kp); phase_prep(p, smem); }
  grid.sync();
  for (int layer = 0; layer < 2; ++layer) {
    { const Params p = ldparams(kp); gemm_phase<1>(p, layer, smem); }
    grid.sync();
    { const Params p = ldparams(kp); for (int item = blockIdx.x; item < NITEM; item += gridDim.x) chunk_prep(p, layer, item, smem); }
    grid.sync();
    {
      const Params p = ldparams(kp);
      const int G = gridDim.x, b = blockIdx.x;
      if (G >= 256) {
        if (b < 128) gdn_scan(p, layer, b, smem);
        else {
          if (b < 256) { gdn_scan(p, layer, b, smem); gdn_scan(p, layer, b + 128, smem); }
          for (int ug = b - 128; ug < (NUNIT + 3) / 4; ug += G - 128) mixer_a_group(p, layer, ug);
        }
      } else {
        for (int w = b; w < 384; w += G) gdn_scan(p, layer, w, smem);
        for (int ug = b; ug < (NUNIT + 3) / 4; ug += G) mixer_a_group(p, layer, ug);
      }
    }
    grid.sync();
    { const Params p = ldparams(kp); phase_post(p, layer); }
    grid.sync();
    { const Params p = ldparams(kp); if (layer == 0) gemm_phase<2>(p, layer, smem); else gemm_phase<3>(p, layer, smem); }
    grid.sync();
  }
  { const Params p = ldparams(kp); phase_final(p); }
}

extern "C" void kernel_launch(void* const* d_in, const int* in_sizes, int n_in,
                              void* d_out, int out_size, void* d_ws, size_t ws_size,
                              hipStream_t stream) {
  constexpr size_t kLds = 131072;
  static int grid_blocks = 0;
  if (!grid_blocks) {
    int dev = 0, cus = 0, per_cu = 0;
    (void)hipGetDevice(&dev);
    (void)hipDeviceGetAttribute(&cus, hipDeviceAttributeMultiprocessorCount, dev);
    (void)hipFuncSetAttribute((const void*)mega, hipFuncAttributeMaxDynamicSharedMemorySize, (int)kLds);
    (void)hipOccupancyMaxActiveBlocksPerMultiprocessor(&per_cu, (const void*)mega, 512, kLds);
    if (per_cu < 1) per_cu = 1;
    grid_blocks = cus * per_cu;
    if (ws_size < (size_t)WS_END) fprintf(stderr, "workspace too small: %zu < %ld\n", ws_size, WS_END);
  }
  Params p{};
  p.xp = (const float*)d_in[0]; p.xs = (const float*)d_in[1]; p.sca = (const float*)d_in[2]; p.scq = (const float*)d_in[3];
  p.sdel = (const float*)d_in[4]; p.meta = (const float*)d_in[5]; p.normw = (const float*)d_in[6]; p.win = (const float*)d_in[7];
  p.cvaw = (const float*)d_in[8]; p.cvqw = (const float*)d_in[9]; p.alog = (const float*)d_in[10]; p.dtb = (const float*)d_in[11];
  p.onw = (const float*)d_in[12]; p.wout = (const float*)d_in[13]; p.fnw = (const float*)d_in[14];
  p.out = (float*)d_out; p.ws = (unsigned char*)d_ws;
  void* args[] = {&p};
  hipError_t e = hipLaunchCooperativeKernel((void*)mega, dim3(grid_blocks), dim3(512), args, kLds, stream);
  if (e != hipSuccess) fprintf(stderr, "cooperative launch failed: %s (grid %d)\n", hipGetErrorString(e), grid_blocks);
}
```

```cpp
#include <hip/hip_runtime.h>
#include <hip/hip_bf16.h>
#include <hip/hip_cooperative_groups.h>
#include <cstdio>
namespace cg = cooperative_groups;

typedef unsigned short u16;
using bf16x8 = __attribute__((ext_vector_type(8))) short;
using f32x4 = __attribute__((ext_vector_type(4))) float;

constexpr int DM = 2048;
constexpr int NP = 8208;
constexpr int NPP = 8448;
constexpr int TP = 8208;
constexpr int ROWS_P = 4 * TP;
constexpr int ROWS = ROWS_P + 512;
constexpr int ROWSP = 33536;
constexpr int NCHUNK = 524;
constexpr int NITEM = NCHUNK * 8;
constexpr float EPS = 1e-6f;

constexpr long OFF_WTIN = 0;
constexpr long OFF_WTOUT = OFF_WTIN + 2L * NPP * DM * 2;
constexpr long OFF_HB = OFF_WTOUT + 2L * DM * DM * 2;
constexpr long OFF_PROJ = OFF_HB + (long)ROWSP * DM * 2;
constexpr long OFF_YMIX = OFF_PROJ + (long)ROWS * NP * 2;
constexpr long OFF_SUMSQ = OFF_YMIX + (long)ROWSP * DM * 2;
constexpr long OFF_EGL = OFF_SUMSQ + 3L * ROWSP * 4;
constexpr long OFF_QK = OFF_EGL + 16896;
constexpr long OFF_UT = OFF_QK + (long)NITEM * 4096 * 2;
constexpr long WS_END = OFF_UT + (long)NITEM * 8192 * 2;
constexpr long OOFF_W = 0;
constexpr long OOFF_QG = OOFF_W + (long)NITEM * 8192 * 2;
constexpr long OOFF_KPT = OOFF_QG + (long)NITEM * 8192 * 2;
constexpr long YS_OFF = 67108864L;
constexpr long PCA_OFF = YS_OFF + 1048576L;
constexpr long PCQ_OFF = PCA_OFF + 16384L;
constexpr long PD_OFF = PCQ_OFF + 73728L;
constexpr long SCA_OFF = PD_OFF + 1048576L;
constexpr long SCQ_OFF = SCA_OFF + 32768L;
constexpr long SD_OFF = SCQ_OFF + 147456L;

struct Params {
  const float *xp, *xs, *sca, *scq, *sdel, *meta, *normw, *win, *cvaw, *cvqw, *alog, *dtb, *onw, *wout, *fnw;
  float* out;
  unsigned char* ws;
};

typedef __bf16 bf16x2_t __attribute__((ext_vector_type(2)));
typedef float f32x2_t __attribute__((ext_vector_type(2)));
__device__ __forceinline__ unsigned pack2(float a, float b) {
#if defined(__HIP_DEVICE_COMPILE__)
  f32x2_t v = {a, b};
  return __builtin_bit_cast(unsigned, __builtin_convertvector(v, bf16x2_t));
#else
  return 0u;
#endif
}
__device__ __forceinline__ u16 f2bf(float f) { return (u16)(pack2(f, 0.f) & 0xffffu); }
__device__ __forceinline__ int opaque_tid() { int t; asm volatile("v_mov_b32 %0, %1" : "=v"(t) : "v"((int)threadIdx.x)); return t; }
__device__ __forceinline__ float bf2f(u16 h) { return __uint_as_float(((unsigned)h) << 16); }
__device__ __forceinline__ uint2 pack4(float a, float b, float c, float d) { return make_uint2(pack2(a, b), pack2(c, d)); }
__device__ __forceinline__ void unpack4(uint2 v, float* o) {
  o[0] = __uint_as_float(v.x << 16); o[1] = __uint_as_float(v.x & 0xffff0000u);
  o[2] = __uint_as_float(v.y << 16); o[3] = __uint_as_float(v.y & 0xffff0000u);
}
__device__ __forceinline__ void unpack8(uint4 v, float* o) {
  o[0] = __uint_as_float(v.x << 16); o[1] = __uint_as_float(v.x & 0xffff0000u);
  o[2] = __uint_as_float(v.y << 16); o[3] = __uint_as_float(v.y & 0xffff0000u);
  o[4] = __uint_as_float(v.z << 16); o[5] = __uint_as_float(v.z & 0xffff0000u);
  o[6] = __uint_as_float(v.w << 16); o[7] = __uint_as_float(v.w & 0xffff0000u);
}
__device__ __forceinline__ float silu_f(float x) { return x * __frcp_rn(1.f + __expf(-x)); }
__device__ __forceinline__ f32x4 mfma16(bf16x8 a, bf16x8 b, f32x4 c) {
  return __builtin_amdgcn_mfma_f32_16x16x32_bf16(a, b, c, 0, 0, 0);
}
__device__ __forceinline__ bf16x8 ldfrag(const u16* base, int stride, int row, int k) {
  return *reinterpret_cast<const bf16x8*>(base + row * stride + k);
}

__device__ __forceinline__ void l2_touch(const void* ptr) {
  (void)ptr;
}
__device__ __forceinline__ unsigned touch_ld(const void* ptr) { return *reinterpret_cast<const unsigned*>(ptr); }
__device__ __forceinline__ void touch_use(unsigned& acc, unsigned v) { asm volatile("v_add_u32 %0, %0, %1" : "+v"(acc) : "v"(v)); }

__device__ __forceinline__ f32x4 mm16(const float* X, int xr, int xc, const float* Y, int yr, int yc, int kn, int fr, int fq) {
  f32x4 c = {0.f, 0.f, 0.f, 0.f};
  for (int k0 = 0; k0 < kn; k0 += 4) {
    const float a = X[(xr + fr) * 68 + xc + k0 + fq];
    const float b = Y[(yr + k0 + fq) * 68 + yc + fr];
    c = __builtin_amdgcn_mfma_f32_16x16x4f32(a, b, c, 0, 0, 0);
  }
  return c;
}

__device__ __forceinline__ void transpose_tiles(const float* __restrict__ src, u16* __restrict__ dst, const float* __restrict__ scale,
                                                int nsrc, int ntile_n, unsigned char* smem) {
  float* tile = (float*)smem;
  const int tid = opaque_tid();
  const int ntiles = 32 * ntile_n;
  for (int t = blockIdx.x; t < ntiles; t += gridDim.x) {
    const int kt = t & 31, nt = t >> 5;
    const int k0 = kt * 64, n0 = nt * 64;
    {
      const int nl = tid & 63, kb = tid >> 6;
#pragma unroll
      for (int it = 0; it < 8; ++it) {
        const int kl = kb + it * 8;
        const int n = n0 + nl;
        float v = 0.f;
        if (n < nsrc) v = src[(long)(k0 + kl) * nsrc + n] * (scale ? scale[k0 + kl] : 1.f);
        tile[kl * 65 + nl] = v;
      }
    }
    __syncthreads();
    {
      const int nl = tid >> 3, kg = tid & 7;
      float v[8];
#pragma unroll
      for (int e = 0; e < 8; ++e) v[e] = tile[(kg * 8 + e) * 65 + nl];
      uint4 o;
      o.x = pack2(v[0], v[1]); o.y = pack2(v[2], v[3]); o.z = pack2(v[4], v[5]); o.w = pack2(v[6], v[7]);
      *reinterpret_cast<uint4*>(dst + (long)(n0 + nl) * DM + k0 + kg * 8) = o;
    }
    __syncthreads();
  }
}

__device__ __forceinline__ void phase_prep(const Params& p, unsigned char* smem) {
  const int tid = opaque_tid(), wv = tid >> 6, lane = tid & 63;
  u16* hb = (u16*)(p.ws + OFF_HB);
  float* sumsq = (float*)(p.ws + OFF_SUMSQ);
  for (int r = blockIdx.x * 8 + wv; r < ROWSP; r += gridDim.x * 8) {
    const float* src = nullptr;
    if (r < ROWS_P) {
      const int b = r / TP, t = r - b * TP;
      src = (t < 16) ? (p.meta + (long)t * DM) : (p.xp + ((long)b * 8192 + (t - 16)) * DM);
    } else if (r < ROWS) {
      src = p.xs + (long)(r - ROWS_P) * DM;
    }
    float ss = 0.f;
#pragma unroll
    for (int i = 0; i < 8; ++i) {
      const int c = (i * 64 + lane) * 4;
      float4 v = make_float4(0.f, 0.f, 0.f, 0.f);
      if (src) v = *reinterpret_cast<const float4*>(src + c);
      ss += v.x * v.x + v.y * v.y + v.z * v.z + v.w * v.w;
      *reinterpret_cast<uint2*>(hb + (long)r * DM + c) = pack4(v.x, v.y, v.z, v.w);
    }
#pragma unroll
    for (int o = 32; o > 0; o >>= 1) ss += __shfl_xor(ss, o);
    if (lane == 0) sumsq[r] = ss;
  }
  for (long i = (long)blockIdx.x * 512 + tid; i < 2L * ROWSP; i += (long)gridDim.x * 512) sumsq[ROWSP + i] = 0.f;
  for (int l = 0; l < 2; ++l) {
    transpose_tiles(p.win + (long)l * DM * NP, (u16*)(p.ws + OFF_WTIN) + (long)l * NPP * DM, p.normw + l * DM, NP, NPP / 64, smem);
    transpose_tiles(p.wout + (long)l * DM * DM, (u16*)(p.ws + OFF_WTOUT) + (long)l * DM * DM, nullptr, DM, DM / 64, smem);
  }
}

constexpr int BM = 256, BK = 64, HALF = 128, HT = HALF * BK;

__device__ __forceinline__ int lds_byte(int r, int c) {
  int st = (r >> 4) * 2 + (c >> 5), rr = r & 15, cc = c & 31, ob = rr * 64 + cc * 2;
  return st * 1024 + (ob ^ (((ob >> 9) & 1) << 5));
}
__device__ __forceinline__ void stage_rc(int b, int& R, int& C) {
  int st = b / 1024, sb = b % 1024, swz = sb ^ (((sb >> 9) & 1) << 5);
  R = (st >> 1) * 16 + swz / 64; C = (st & 1) * 32 + (swz % 64) / 2;
}

template <int EPI>
__device__ __forceinline__ void gemm_phase(const Params& p, int layer, unsigned char* smem) {
  typedef __hip_bfloat16 bf16;
  bf16* shm = (bf16*)smem;
  const bf16* A = (const bf16*)(p.ws + (EPI == 1 ? OFF_HB : OFF_YMIX));
  const bf16* Bt = (EPI == 1) ? (const bf16*)(p.ws + OFF_WTIN) + (long)layer * NPP * DM
                              : (const bf16*)(p.ws + OFF_WTOUT) + (long)layer * DM * DM;
  constexpr int K = DM;
  constexpr int nM = ROWSP / BM;
  constexpr int nN = (EPI == 1) ? NPP / BM : DM / BM;
  constexpr int WGM = 8;
  constexpr int nwg = nM * nN;
#define SA(b, h) (shm + ((b) * 2 + (h)) * HT)
#define SB(b, h) (shm + (4 + (b) * 2 + (h)) * HT)
#define OA(b, h) ((((b) * 2 + (h)) * HT) * 2)
#define OB(b, h) (((4 + (b) * 2 + (h)) * HT) * 2)
#define STAGE(PO, BASE, br, kt) do { const char* _ub = (const char*)(BASE) + ((long)(br) * K + (long)(kt) * BK) * 2; \
      const unsigned _l = ldsw + (PO); \
      asm volatile("s_mov_b32 m0, %0\n\ts_nop 0\n\tglobal_load_lds_dwordx4 %1, %2" :: "s"(_l), "v"(soff0), "s"(_ub) : "memory"); \
      asm volatile("s_mov_b32 m0, %0\n\ts_nop 0\n\tglobal_load_lds_dwordx4 %1, %2" :: "s"(_l + 8192u), "v"(soff1), "s"(_ub) : "memory"); } while (0)
#define LDA(dst, b, h) for (int m = 0; m < 4; ++m) for (int k = 0; k < 2; ++k) \
    dst[m][k] = *reinterpret_cast<const bf16x8*>((char*)SA(b, h) + lds_byte(wr * 64 + m * 16 + fr, k * 32 + fq * 8))
#define LDB(dst, b, h) for (int n = 0; n < 2; ++n) for (int k = 0; k < 2; ++k) \
    dst[n][k] = *reinterpret_cast<const bf16x8*>((char*)SB(b, h) + lds_byte(wc * 32 + n * 16 + fr, k * 32 + fq * 8))
#define MMA(ai, bj, At, Bt_) do { __builtin_amdgcn_s_setprio(1); \
    for (int m = 0; m < 4; ++m) for (int n = 0; n < 2; ++n) for (int k = 0; k < 2; ++k) \
      acc[ai][bj][m][n] = __builtin_amdgcn_mfma_f32_16x16x32_bf16(At[m][k], Bt_[n][k], acc[ai][bj][m][n], 0, 0, 0); \
    __builtin_amdgcn_s_setprio(0); } while (0)
#define WAIT_V(n) asm volatile("s_waitcnt vmcnt(" #n ")" ::: "memory")
#define WAIT_L(n) asm volatile("s_waitcnt lgkmcnt(" #n ")" ::: "memory")
#define BAR __builtin_amdgcn_s_barrier()
#define SCHED __builtin_amdgcn_sched_barrier(0)

  const int gtid = opaque_tid() & 511;
  const int wid = __builtin_amdgcn_readfirstlane(gtid >> 6), lane = gtid & 63, wr = wid >> 2, wc = wid & 3, fr = lane & 15, fq = lane >> 4;
  unsigned soff0, soff1;
  { int _r, _c; stage_rc(gtid * 16, _r, _c); soff0 = (unsigned)(_r * K + _c) * 2u;
    stage_rc(gtid * 16 + 8192, _r, _c); soff1 = (unsigned)(_r * K + _c) * 2u; }
  const unsigned ldsw = (unsigned)(size_t)((__attribute__((address_space(3))) unsigned char*)smem) + (unsigned)wid * 1024u;
  int vb = blockIdx.x;
  if ((gridDim.x & 7) == 0) vb = (blockIdx.x & 7) * (gridDim.x >> 3) + (blockIdx.x >> 3);
  constexpr int nig = WGM * nN;
  for (int wgid = vb; wgid < nwg; wgid += gridDim.x) {
    const int gid = wgid / nig, fm = gid * WGM, gsz = min(nM - fm, WGM);
    const int pm = fm + ((wgid % nig) % gsz), pn = (wgid % nig) / gsz, brow = pm * BM, bcol = pn * BM;
    f32x4 acc[2][2][4][2] = {};
    bf16x8 At[4][2], B0[2][2], B1[2][2];
    constexpr int nt = K / BK;
    STAGE(OB(0, 0), Bt, bcol, 0); STAGE(OA(0, 0), A, brow, 0);
    STAGE(OB(0, 1), Bt, bcol + HALF, 0); STAGE(OA(0, 1), A, brow + HALF, 0);
    if (wr == 1) BAR;
    WAIT_V(4); BAR;
    STAGE(OB(1, 0), Bt, bcol, 1); STAGE(OA(1, 0), A, brow, 1); STAGE(OB(1, 1), Bt, bcol + HALF, 1);
    WAIT_V(6); BAR;
    for (int t = 0; t < nt - 2; t += 2) {
      LDB(B0, 0, 0); SCHED; LDA(At, 0, 0); STAGE(OA(1, 1), A, brow + HALF, t + 1);
      WAIT_L(8); BAR; WAIT_L(0); MMA(0, 0, At, B0); BAR; SCHED;
      LDB(B1, 0, 1); STAGE(OB(0, 0), Bt, bcol, t + 2);
      BAR; WAIT_L(0); MMA(0, 1, At, B1); BAR;
      LDA(At, 0, 1); STAGE(OA(0, 0), A, brow, t + 2);
      BAR; WAIT_L(0); MMA(1, 0, At, B0); BAR; SCHED;
      STAGE(OB(0, 1), Bt, bcol + HALF, t + 2);
      WAIT_V(6); BAR; MMA(1, 1, At, B1); BAR;
      LDB(B0, 1, 0); SCHED; LDA(At, 1, 0); STAGE(OA(0, 1), A, brow + HALF, t + 2);
      WAIT_L(8); BAR; WAIT_L(0); MMA(0, 0, At, B0); BAR; SCHED;
      LDB(B1, 1, 1); STAGE(OB(1, 0), Bt, bcol, t + 3);
      BAR; WAIT_L(0); MMA(0, 1, At, B1); BAR;
      LDA(At, 1, 1); STAGE(OA(1, 0), A, brow, t + 3);
      BAR; WAIT_L(0); MMA(1, 0, At, B0); BAR; SCHED;
      STAGE(OB(1, 1), Bt, bcol + HALF, t + 3);
      WAIT_V(6); BAR; MMA(1, 1, At, B1); BAR;
    }
    { LDB(B0, 0, 0); LDA(At, 0, 0); STAGE(OA(1, 1), A, brow + HALF, nt - 1);
      BAR; WAIT_L(0); MMA(0, 0, At, B0); BAR;
      LDB(B1, 0, 1); BAR; WAIT_L(0); MMA(0, 1, At, B1); BAR;
      LDA(At, 0, 1); WAIT_V(4); BAR; WAIT_L(0); MMA(1, 0, At, B0); MMA(1, 1, At, B1); BAR; }
    { LDB(B0, 1, 0); LDA(At, 1, 0); WAIT_V(2); BAR; WAIT_L(0); MMA(0, 0, At, B0); BAR;
      LDB(B1, 1, 1); WAIT_V(0); BAR; WAIT_L(0); MMA(0, 1, At, B1); BAR;
      LDA(At, 1, 1); BAR; WAIT_L(0); MMA(1, 0, At, B0); MMA(1, 1, At, B1); BAR; }
    if (wr == 0) BAR;
    if (EPI == 1) {
      u16* proj = (u16*)(p.ws + OFF_PROJ);
      const float* sumsq = (const float*)(p.ws + OFF_SUMSQ) + (long)layer * ROWSP;
#pragma unroll
      for (int ai = 0; ai < 2; ++ai)
#pragma unroll
        for (int m = 0; m < 4; ++m)
#pragma unroll
          for (int j = 0; j < 4; ++j) {
            const int row = brow + ai * HALF + wr * 64 + m * 16 + fq * 4 + j;
            if (row < ROWS) {
              const float rs = rsqrtf(sumsq[row] * (1.f / DM) + EPS);
#pragma unroll
              for (int bj = 0; bj < 2; ++bj)
#pragma unroll
                for (int n = 0; n < 2; ++n) {
                  const int col = bcol + bj * HALF + wc * 32 + n * 16 + fr;
                  if (col < NP) proj[(long)row * NP + col] = f2bf(acc[ai][bj][m][n][j] * rs);
                }
            }
          }
    } else {
      u16* hb = (u16*)(p.ws + OFF_HB);
      float* sumsq = (float*)(p.ws + OFF_SUMSQ) + (long)(EPI == 2 ? 1 : 2) * ROWSP;
#pragma unroll
      for (int ai = 0; ai < 2; ++ai)
#pragma unroll
        for (int m = 0; m < 4; ++m)
#pragma unroll
          for (int j = 0; j < 4; ++j) {
            const int row = brow + ai * HALF + wr * 64 + m * 16 + fq * 4 + j;
            float* dst = nullptr;
            if (EPI == 3) {
              if (row < ROWS_P) {
                const int b = row / TP, t = row - b * TP;
                if (t >= 16) dst = p.out + ((long)b * 8192 + (t - 16)) * DM;
              } else if (row < ROWS) {
                dst = p.out + YS_OFF + (long)(row - ROWS_P) * DM;
              }
            }
            float rsum = 0.f;
#pragma unroll
            for (int bj = 0; bj < 2; ++bj)
#pragma unroll
              for (int n = 0; n < 2; ++n) {
                const int col = bcol + bj * HALF + wc * 32 + n * 16 + fr;
                const float v = acc[ai][bj][m][n][j] + bf2f(hb[(long)row * DM + col]);
                rsum += v * v;
                if (EPI == 2) hb[(long)row * DM + col] = f2bf(v);
                else if (dst) dst[col] = v;
              }
            rsum += __shfl_xor(rsum, 1); rsum += __shfl_xor(rsum, 2);
            rsum += __shfl_xor(rsum, 4); rsum += __shfl_xor(rsum, 8);
            if (fr == 0) atomicAdd(&sumsq[row], rsum);
          }
    }
    __syncthreads();
  }
#undef SA
#undef SB
#undef OA
#undef OB
#undef STAGE
#undef LDA
#undef LDB
#undef MMA
}

__device__ __forceinline__ void chunk_geom(int cid, int& row0, int& nvalid, int& prevmode, int& sidx, bool& lastc) {
  if (cid < 516) {
    const int s = cid / 129, c = cid - s * 129;
    sidx = s; lastc = (c == 128);
    if (c == 0) { row0 = s * TP; nvalid = 16; prevmode = 0; }
    else { row0 = s * TP + 16 + (c - 1) * 64; nvalid = 64; prevmode = 1; }
  } else {
    sidx = cid - 516; row0 = ROWS_P + sidx * 64; nvalid = 64; prevmode = 2; lastc = true;
  }
}

__device__ __forceinline__ void chunk_prep(const Params& p, int layer, int item, unsigned char* smem) {
  const int tid = opaque_tid() & 511, wv = __builtin_amdgcn_readfirstlane(tid >> 6), lane = tid & 63, fr = lane & 15, fq = lane >> 4;
  const int cid = item >> 3, h = item & 7;
  int row0, nvalid, prevmode, sidx; bool lastc;
  chunk_geom(cid, row0, nvalid, prevmode, sidx, lastc);
  u16* sKB = (u16*)smem;
  u16* sK = sKB + 64 * 136;
  u16* sQ = sK + 64 * 136;
  u16* sVBT = sQ + 64 * 136;
  u16* sKBGT = sVBT + 128 * 72;
  u16* sT = sKBGT + 128 * 72;
  float* sA = (float*)(sT + 64 * 72);
  float* sBeta = sA + 64 * 68;
  float* sGc = sBeta + 64;
  float* sTf = (float*)smem;
  float* sY = sTf + 64 * 68;
  int zoff;
  asm volatile("v_mov_b32 %0, 0" : "=v"(zoff));
  const u16* proj = (const u16*)(p.ws + OFF_PROJ);
  u16* QG = (u16*)((unsigned char*)p.out + OOFF_QG) + (long)item * 8192;
  u16* KPT = (u16*)((unsigned char*)p.out + OOFF_KPT) + (long)item * 8192;
  u16* Wd = (u16*)((unsigned char*)p.out + OOFF_W) + (long)item * 8192;
  u16* QKd = (u16*)(p.ws + OFF_QK) + (long)item * 4096;
  u16* UTd = (u16*)(p.ws + OFF_UT) + (long)item * 8192;
  float* EGL = (float*)(p.ws + OFF_EGL);

  unsigned tch = 0;
  {
    const int nitem = item + gridDim.x;
    if (nitem < NITEM) {
      int nrow0, nnv, npm, nsi; bool nl;
      chunk_geom(nitem >> 3, nrow0, nnv, npm, nsi, nl);
      const int nh = nitem & 7;
      if (tid < 402) {
        const int r = tid / 6, m6 = tid - r * 6;
        tch = touch_ld(proj + (long)(nrow0 - 3 + r) * NP + 4096 + (m6 >> 1) * 1024 + nh * 128 + (m6 & 1) * 64);
      } else if (tid >= 448) {
        tch = touch_ld(proj + (long)(nrow0 + (tid - 448)) * NP + 8192 + nh);
      }
    }
  }
  if (wv == 0) {
    float beta = 0.f, g = 0.f;
    if (lane < nvalid) {
      const long rb = (long)(row0 + lane) * NP;
      const float bl = bf2f(proj[rb + 8192 + h]);
      const float al = bf2f(proj[rb + 8200 + h]) + p.dtb[layer * 8 + h];
      beta = 1.f / (1.f + expf(-bl));
      const float sp = (al > 20.f) ? al : log1pf(expf(al));
      g = -expf(p.alog[layer * 8 + h]) * sp;
    }
    float gc = g;
#pragma unroll
    for (int o = 1; o < 64; o <<= 1) { const float t = __shfl_up(gc, o); if (lane >= o) gc += t; }
    sBeta[lane] = beta; sGc[lane] = gc;
  }

  const int rg = tid >> 5, cg = tid & 31, i0 = rg * 4, d0 = cg * 4;
  float qv[4][4], kv[4][4], vv[4][4];
#pragma unroll
  for (int mat = 0; mat < 3; ++mat) {
    const int ch = mat * 1024 + h * 128 + d0;
    const int colbase = 4096 + ch;
    float xr[7][4];
#pragma unroll
    for (int a = 0; a < 7; ++a) {
      const int ri = i0 - 3 + a;
      if (ri >= 0 || prevmode == 1) {
        uint2 raw = *reinterpret_cast<const uint2*>(proj + (long)(row0 + ri) * NP + colbase);
        unpack4(raw, xr[a]);
      } else if (prevmode == 2) {
        const float4 v = *reinterpret_cast<const float4*>(p.scq + ((long)(layer * 8 + sidx) * 3 + (3 + ri)) * 3072 + ch);
        xr[a][0] = v.x; xr[a][1] = v.y; xr[a][2] = v.z; xr[a][3] = v.w;
      } else {
        xr[a][0] = xr[a][1] = xr[a][2] = xr[a][3] = 0.f;
      }
    }
    if (lastc && rg == 15) {
      float* dst = p.out + (prevmode == 2 ? SCQ_OFF + (long)(layer * 8 + sidx) * 3 * 3072 : PCQ_OFF + (long)(layer * 4 + sidx) * 3 * 3072) + ch;
#pragma unroll
      for (int a = 4; a < 7; ++a)
        *reinterpret_cast<float4*>(dst + (a - 4) * 3072) = make_float4(xr[a][0], xr[a][1], xr[a][2], xr[a][3]);
    }
    float cw[4][4];
#pragma unroll
    for (int j = 0; j < 4; ++j) {
      const float4 v = *reinterpret_cast<const float4*>(p.cvqw + (long)(layer * 4 + j) * 3072 + ch);
      cw[j][0] = v.x; cw[j][1] = v.y; cw[j][2] = v.z; cw[j][3] = v.w;
    }
#pragma unroll
    for (int ii = 0; ii < 4; ++ii)
#pragma unroll
      for (int e = 0; e < 4; ++e) {
        float o = 0.f;
#pragma unroll
        for (int j = 0; j < 4; ++j) o += cw[j][e] * xr[ii + j][e];
        o = silu_f(o);
        if (mat == 0) qv[ii][e] = o; else if (mat == 1) kv[ii][e] = o; else vv[ii][e] = o;
      }
  }
#pragma unroll
  for (int ii = 0; ii < 4; ++ii) {
    float sq = 0.f, sk = 0.f;
#pragma unroll
    for (int e = 0; e < 4; ++e) { sq += qv[ii][e] * qv[ii][e]; sk += kv[ii][e] * kv[ii][e]; }
#pragma unroll
    for (int o = 1; o < 32; o <<= 1) { sq += __shfl_xor(sq, o); sk += __shfl_xor(sk, o); }
    const float rq = rsqrtf(sq + EPS) * 0.08838834764831845f, rk = rsqrtf(sk + EPS);
    const bool valid = (i0 + ii) < nvalid;
#pragma unroll
    for (int e = 0; e < 4; ++e) {
      qv[ii][e] = valid ? qv[ii][e] * rq : 0.f;
      kv[ii][e] = valid ? kv[ii][e] * rk : 0.f;
      vv[ii][e] = valid ? vv[ii][e] : 0.f;
    }
  }
  __syncthreads();
  float beta[4], gcv[4];
#pragma unroll
  for (int ii = 0; ii < 4; ++ii) { beta[ii] = sBeta[i0 + ii]; gcv[ii] = sGc[i0 + ii]; }
  const float glast = sGc[63];
  if (tid == 0) EGL[item] = expf(glast);

#pragma unroll
  for (int ii = 0; ii < 4; ++ii) {
    const int i = i0 + ii;
    const float b = beta[ii], eg = __expf(gcv[ii]);
    *reinterpret_cast<uint2*>(sKB + i * 136 + d0) = pack4(kv[ii][0] * b, kv[ii][1] * b, kv[ii][2] * b, kv[ii][3] * b);
    *reinterpret_cast<uint2*>(sK + i * 136 + d0) = pack4(kv[ii][0], kv[ii][1], kv[ii][2], kv[ii][3]);
    *reinterpret_cast<uint2*>(sQ + i * 136 + d0) = pack4(qv[ii][0], qv[ii][1], qv[ii][2], qv[ii][3]);
    *reinterpret_cast<uint2*>(QG + i * 128 + d0) = pack4(qv[ii][0] * eg, qv[ii][1] * eg, qv[ii][2] * eg, qv[ii][3] * eg);
  }
  {
    float bg[4], kd[4];
#pragma unroll
    for (int ii = 0; ii < 4; ++ii) { bg[ii] = beta[ii] * __expf(gcv[ii]); kd[ii] = __expf(glast - gcv[ii]); }
#pragma unroll
    for (int e = 0; e < 4; ++e) {
      const int d = d0 + e;
      *reinterpret_cast<uint2*>(sVBT + d * 72 + i0) = pack4(vv[0][e] * beta[0], vv[1][e] * beta[1], vv[2][e] * beta[2], vv[3][e] * beta[3]);
      *reinterpret_cast<uint2*>(sKBGT + d * 72 + i0) = pack4(kv[0][e] * bg[0], kv[1][e] * bg[1], kv[2][e] * bg[2], kv[3][e] * bg[3]);
      *reinterpret_cast<uint2*>(KPT + d * 64 + i0) = pack4(kv[0][e] * kd[0], kv[1][e] * kd[1], kv[2][e] * kd[2], kv[3][e] * kd[3]);
    }
  }
  __syncthreads();
  {
    const int ib = wv >> 1;
#pragma unroll
    for (int jj = 0; jj < 2; ++jj) {
      const int jb = (wv & 1) * 2 + jj;
      f32x4 c = {0.f, 0.f, 0.f, 0.f}, c2 = {0.f, 0.f, 0.f, 0.f};
#pragma unroll
      for (int kk = 0; kk < 4; ++kk) {
        const bf16x8 a = ldfrag(sKB, 136, ib * 16 + fr, kk * 32 + fq * 8);
        const bf16x8 b = ldfrag(sK, 136, jb * 16 + fr, kk * 32 + fq * 8);
        c = mfma16(a, b, c);
        const bf16x8 b2 = ldfrag(sQ, 136, ib * 16 + fr, kk * 32 + fq * 8);
        c2 = mfma16(b, b2, c2);
      }
      {
        const int j = jb * 16 + fr;
        const float gj = sGc[j];
#pragma unroll
        for (int r = 0; r < 4; ++r) {
          const int i = ib * 16 + fq * 4 + r;
          sA[i * 68 + j] = (i > j) ? c[r] * __expf(sGc[i] - gj) : 0.f;
        }
      }
      {
        const int i = ib * 16 + fr;
        const float gi = sGc[i];
        float o[4];
#pragma unroll
        for (int r = 0; r < 4; ++r) {
          const int j = jb * 16 + fq * 4 + r;
          o[r] = (i >= j) ? c2[r] * __expf(gi - sGc[j]) : 0.f;
        }
        *reinterpret_cast<uint2*>(QKd + i * 64 + jb * 16 + fq * 4) = pack4(o[0], o[1], o[2], o[3]);
      }
    }
  }
  __syncthreads();
  {
    for (int e = tid; e < 64 * 68; e += 512) sTf[e] = 0.f;
    __syncthreads();
    if (wv < 4 && lane < 16) {
      const float* Ab = sA + (wv * 16) * 68 + wv * 16 + zoff;
      float t[16], ac[16], an[16];
      t[0] = (lane == 0) ? 1.f : 0.f;
      sTf[(wv * 16) * 68 + wv * 16 + lane] = t[0];
      ac[0] = Ab[68];
#pragma unroll
      for (int i = 1; i < 16; ++i) {
        if (i + 1 < 16) {
#pragma unroll
          for (int j = 0; j <= i; ++j) an[j] = Ab[(i + 1) * 68 + j];
        }
        float a = (lane == i) ? 1.f : 0.f;
#pragma unroll
        for (int j = 0; j < i; ++j) a -= ac[j] * t[j];
        t[i] = a;
        sTf[(wv * 16 + i) * 68 + wv * 16 + lane] = a;
        if (i + 1 < 16) {
#pragma unroll
          for (int j = 0; j <= i; ++j) ac[j] = an[j];
        }
        __builtin_amdgcn_sched_barrier(0);
      }
    }
    __syncthreads();
    if (wv < 2) {
      const int o = wv * 32;
      const f32x4 c = mm16(sA, o + 16, o, sTf, o, o, 16, fr, fq);
#pragma unroll
      for (int r = 0; r < 4; ++r) sY[(o + 16 + fq * 4 + r) * 68 + o + fr] = c[r];
    }
    __syncthreads();
    if (wv < 2) {
      const int o = wv * 32;
      const f32x4 c = mm16(sTf, o + 16, o + 16, sY, o + 16, o, 16, fr, fq);
#pragma unroll
      for (int r = 0; r < 4; ++r) sTf[(o + 16 + fq * 4 + r) * 68 + o + fr] = -c[r];
    }
    __syncthreads();
    if (wv < 4) {
      const int bi = wv >> 1, bj = wv & 1;
      const f32x4 c = mm16(sA, 32 + bi * 16, 0, sTf, 0, bj * 16, 32, fr, fq);
#pragma unroll
      for (int r = 0; r < 4; ++r) sY[(32 + bi * 16 + fq * 4 + r) * 68 + bj * 16 + fr] = c[r];
    }
    __syncthreads();
    if (wv < 4) {
      const int bi = wv >> 1, bj = wv & 1;
      const f32x4 c = mm16(sTf, 32 + bi * 16, 32, sY, 32, bj * 16, 32, fr, fq);
#pragma unroll
      for (int r = 0; r < 4; ++r) sTf[(32 + bi * 16 + fq * 4 + r) * 68 + bj * 16 + fr] = -c[r];
    }
    __syncthreads();
    {
      const int i = tid >> 3, j0 = (tid & 7) * 8;
      float v[8];
#pragma unroll
      for (int e = 0; e < 8; ++e) v[e] = sTf[i * 68 + j0 + e];
      uint4 o;
      o.x = pack2(v[0], v[1]); o.y = pack2(v[2], v[3]); o.z = pack2(v[4], v[5]); o.w = pack2(v[6], v[7]);
      *reinterpret_cast<uint4*>(sT + i * 72 + j0) = o;
    }
  }
  __syncthreads();
  {
    const int ib = wv >> 1;
#pragma unroll
    for (int x = 0; x < 4; ++x) {
      const int dvb = (wv & 1) * 4 + x;
      f32x4 c = {0.f, 0.f, 0.f, 0.f};
#pragma unroll
      for (int kk = 0; kk < 2; ++kk)
        c = mfma16(ldfrag(sT, 72, ib * 16 + fr, kk * 32 + fq * 8), ldfrag(sVBT, 72, dvb * 16 + fr, kk * 32 + fq * 8), c);
      *reinterpret_cast<uint2*>(UTd + (dvb * 16 + fr) * 64 + ib * 16 + fq * 4) = pack4(c[0], c[1], c[2], c[3]);
    }
#pragma unroll
    for (int ib2 = 0; ib2 < 4; ++ib2) {
      f32x4 c = {0.f, 0.f, 0.f, 0.f};
#pragma unroll
      for (int kk = 0; kk < 2; ++kk)
        c = mfma16(ldfrag(sKBGT, 72, wv * 16 + fr, kk * 32 + fq * 8), ldfrag(sT, 72, ib2 * 16 + fr, kk * 32 + fq * 8), c);
      *reinterpret_cast<uint2*>(Wd + (ib2 * 16 + fr) * 128 + wv * 16 + fq * 4) = pack4(c[0], c[1], c[2], c[3]);
    }
  }
  __syncthreads();
  {
    unsigned tacc = 0;
    touch_use(tacc, tch);
    if (tacc == 0x9e3779b9u) ((volatile float*)EGL)[NITEM + 9] = 1.f;
  }
}

__device__ __forceinline__ void gdn_scan(const Params& p, int layer, int widx, unsigned char* smem) {
  const int tid = opaque_tid() & 511, wv = __builtin_amdgcn_readfirstlane(tid >> 6), lane = tid & 63, fr = lane & 15, fq = lane >> 4;
  const bool is_prompt = widx < 128;
  int s, h, sl, nsteps, cid0;
  if (is_prompt) { s = widx >> 5; h = (widx >> 2) & 7; sl = widx & 3; nsteps = 129; cid0 = s * 129; }
  else { const int j = widx - 128; s = j >> 5; h = (j >> 2) & 7; sl = j & 3; nsteps = 1; cid0 = 516 + s; }
  const int dv0 = sl * 32;
  u16* sST = (u16*)smem;
  u16* sVT = sST + 32 * 136;
  u16* sO = sVT + 32 * 72;
  const u16* Wg = (const u16*)((const unsigned char*)p.out + OOFF_W);
  const u16* QGg = (const u16*)((const unsigned char*)p.out + OOFF_QG);
  const u16* KPTg = (const u16*)((const unsigned char*)p.out + OOFF_KPT);
  const u16* QKg = (const u16*)(p.ws + OFF_QK);
  const u16* UTg = (const u16*)(p.ws + OFF_UT);
  const float* EGL = (const float*)(p.ws + OFF_EGL);
  u16* ymix = (u16*)(p.ws + OFF_YMIX);

  f32x4 accS[2];
#pragma unroll
  for (int nb = 0; nb < 2; ++nb) {
    if (is_prompt) { accS[nb][0] = 0.f; accS[nb][1] = 0.f; accS[nb][2] = 0.f; accS[nb][3] = 0.f; }
    else {
      const float4 v = *reinterpret_cast<const float4*>(p.sdel + ((long)(layer * 8 + s) * 8 + h) * 16384 + (wv * 16 + fr) * 128 + dv0 + nb * 16 + fq * 4);
      accS[nb][0] = v.x; accS[nb][1] = v.y; accS[nb][2] = v.z; accS[nb][3] = v.w;
    }
#pragma unroll
    for (int r = 0; r < 4; ++r) sST[(nb * 16 + fq * 4 + r) * 136 + wv * 16 + fr] = f2bf(accS[nb][r]);
  }
  __syncthreads();
  const bool front = wv < 4;
  const int ib = wv & 3;
  int zoff;
  asm volatile("v_mov_b32 %0, 0" : "=v"(zoff));
#define LDS_BAR() asm volatile("s_waitcnt lgkmcnt(0)\n\ts_barrier" ::: "memory")
#define SCAN_LOAD(IT, WF, QF, QKF, KPF, UU0, UU1, EG) do { \
    const u16* KPTp = KPTg + (IT) * 8192; \
    _Pragma("unroll") for (int kk = 0; kk < 2; ++kk) \
      KPF[kk] = *reinterpret_cast<const bf16x8*>(KPTp + (wv * 16 + fr) * 64 + kk * 32 + fq * 8); \
    EG = EGL[(IT) + zoff]; \
    if (front) { \
      const u16* Wp = Wg + (IT) * 8192; const u16* QGp = QGg + (IT) * 8192; const u16* QKp = QKg + (IT) * 4096; const u16* UTp = UTg + (IT) * 8192; \
      _Pragma("unroll") for (int kk = 0; kk < 4; ++kk) { \
        WF[kk] = *reinterpret_cast<const bf16x8*>(Wp + (ib * 16 + fr) * 128 + kk * 32 + fq * 8); \
        QF[kk] = *reinterpret_cast<const bf16x8*>(QGp + (ib * 16 + fr) * 128 + kk * 32 + fq * 8); } \
      _Pragma("unroll") for (int kk = 0; kk < 2; ++kk) \
        QKF[kk] = *reinterpret_cast<const bf16x8*>(QKp + (ib * 16 + fr) * 64 + kk * 32 + fq * 8); \
      UU0 = *reinterpret_cast<const uint2*>(UTp + (dv0 + fr) * 64 + ib * 16 + fq * 4); \
      UU1 = *reinterpret_cast<const uint2*>(UTp + (dv0 + 16 + fr) * 64 + ib * 16 + fq * 4); } } while (0)
#define SCAN_FLUSH(PROW0, PNV) do { \
    if (tid < 256) { const int i_ = tid >> 2, sg_ = tid & 3; \
      if (i_ < (PNV)) *reinterpret_cast<uint4*>(ymix + (long)((PROW0) + i_) * DM + 1024 + h * 128 + dv0 + sg_ * 8) = \
          *reinterpret_cast<const uint4*>(sO + i_ * 40 + sg_ * 8); } } while (0)
#define SCAN_STEP(STEP, WF, QF, QKF, KPF, UU0, UU1, EGLV, WFN, QFN, QKFN, KPFN, UU0N, UU1N, EGLN) do { \
    const int cid = cid0 + (STEP); \
    int row0, nvalid, prevmode, sidx; bool lastc; \
    chunk_geom(cid, row0, nvalid, prevmode, sidx, lastc); \
    { const long itn = (long)(cid0 + min((STEP) + 1, nsteps - 1)) * 8 + h; \
      SCAN_LOAD(itn, WFN, QFN, QKFN, KPFN, UU0N, UU1N, EGLN); } \
    if ((STEP) > 0) SCAN_FLUSH(prow0, pnv); \
    f32x4 co0 = {0.f, 0.f, 0.f, 0.f}, co1 = {0.f, 0.f, 0.f, 0.f}; \
    if (front) { \
      float u0[4], u1[4]; \
      unpack4(UU0, u0); unpack4(UU1, u1); \
      f32x4 cw0 = {0.f, 0.f, 0.f, 0.f}, cw1 = {0.f, 0.f, 0.f, 0.f}; \
      _Pragma("unroll") for (int kk = 0; kk < 4; ++kk) { \
        const bf16x8 sf0 = ldfrag(sST, 136, fr, kk * 32 + fq * 8); \
        const bf16x8 sf1 = ldfrag(sST, 136, 16 + fr, kk * 32 + fq * 8); \
        cw0 = mfma16(WF[kk], sf0, cw0); cw1 = mfma16(WF[kk], sf1, cw1); \
        co0 = mfma16(QF[kk], sf0, co0); co1 = mfma16(QF[kk], sf1, co1); } \
      *reinterpret_cast<uint2*>(sVT + fr * 72 + ib * 16 + fq * 4) = pack4(u0[0] - cw0[0], u0[1] - cw0[1], u0[2] - cw0[2], u0[3] - cw0[3]); \
      *reinterpret_cast<uint2*>(sVT + (16 + fr) * 72 + ib * 16 + fq * 4) = pack4(u1[0] - cw1[0], u1[1] - cw1[1], u1[2] - cw1[2], u1[3] - cw1[3]); } \
    LDS_BAR(); \
    _Pragma("unroll") for (int nb = 0; nb < 2; ++nb) { \
      f32x4 c = accS[nb]; \
      c[0] *= EGLV; c[1] *= EGLV; c[2] *= EGLV; c[3] *= EGLV; \
      _Pragma("unroll") for (int kk = 0; kk < 2; ++kk) \
        c = mfma16(ldfrag(sVT, 72, nb * 16 + fr, kk * 32 + fq * 8), KPF[kk], c); \
      accS[nb] = c; \
      _Pragma("unroll") for (int r = 0; r < 4; ++r) sST[(nb * 16 + fq * 4 + r) * 136 + wv * 16 + fr] = f2bf(c[r]); } \
    if (front) { \
      _Pragma("unroll") for (int kk = 0; kk < 2; ++kk) { \
        co0 = mfma16(QKF[kk], ldfrag(sVT, 72, fr, kk * 32 + fq * 8), co0); \
        co1 = mfma16(QKF[kk], ldfrag(sVT, 72, 16 + fr, kk * 32 + fq * 8), co1); } \
      _Pragma("unroll") for (int r = 0; r < 4; ++r) { \
        sO[(ib * 16 + fq * 4 + r) * 40 + fr] = f2bf(co0[r]); \
        sO[(ib * 16 + fq * 4 + r) * 40 + 16 + fr] = f2bf(co1[r]); } } \
    LDS_BAR(); \
    prow0 = row0; pnv = nvalid; } while (0)
  bf16x8 wfA[4], qfA[4], qkfA[2], kpfA[2]; uint2 u0A, u1A; float eglA;
  bf16x8 wfB[4], qfB[4], qkfB[2], kpfB[2]; uint2 u0B, u1B; float eglB;
  int prow0 = 0, pnv = 0;
  SCAN_LOAD((long)cid0 * 8 + h, wfA, qfA, qkfA, kpfA, u0A, u1A, eglA);
  for (int step = 0; step < nsteps; step += 2) {
    SCAN_STEP(step, wfA, qfA, qkfA, kpfA, u0A, u1A, eglA, wfB, qfB, qkfB, kpfB, u0B, u1B, eglB);
    if (step + 1 < nsteps) SCAN_STEP(step + 1, wfB, qfB, qkfB, kpfB, u0B, u1B, eglB, wfA, qfA, qkfA, kpfA, u0A, u1A, eglA);
  }
  SCAN_FLUSH(prow0, pnv);
#undef SCAN_STEP
#undef SCAN_FLUSH
#undef SCAN_LOAD
  float* dst = p.out + (is_prompt ? PD_OFF + ((long)(layer * 4 + s) * 8 + h) * 16384 : SD_OFF + ((long)(layer * 8 + s) * 8 + h) * 16384);
#pragma unroll
  for (int nb = 0; nb < 2; ++nb)
    *reinterpret_cast<float4*>(dst + (wv * 16 + fr) * 128 + dv0 + nb * 16 + fq * 4) = make_float4(accS[nb][0], accS[nb][1], accS[nb][2], accS[nb][3]);
  __syncthreads();
}

constexpr int NUNIT = 4 * 513 + 32;
__device__ __forceinline__ void mixer_a_group(const Params& p, int layer, int ug) {
  const int tid = opaque_tid() & 511;
  const int uid = ug * 4 + (tid >> 7);
  if (uid >= NUNIT) return;
  const int c0 = (tid & 127) * 8;
  int row0, sidx; bool first, last, samp;
  if (uid < 2052) { sidx = uid / 513; const int k = uid - sidx * 513; row0 = sidx * TP + 16 * k; first = (k == 0); last = (k == 512); samp = false; }
  else { const int v = uid - 2052; sidx = v >> 2; const int k = v & 3; row0 = ROWS_P + sidx * 64 + 16 * k; first = (k == 0); last = (k == 3); samp = true; }
  const u16* proj = (const u16*)(p.ws + OFF_PROJ);
  u16* ymix = (u16*)(p.ws + OFF_YMIX);
  float w0[8], w1[8], w2[8], um2[8], um1[8];
  {
    const float* cw = p.cvaw + (long)layer * 3 * 1024 + c0;
#pragma unroll
    for (int e = 0; e < 8; ++e) { w0[e] = cw[e]; w1[e] = cw[1024 + e]; w2[e] = cw[2048 + e]; }
  }
  if (first) {
    if (samp) {
      const float* st = p.sca + (long)(layer * 8 + sidx) * 2 * 1024 + c0;
#pragma unroll
      for (int e = 0; e < 8; ++e) { um2[e] = st[e]; um1[e] = st[1024 + e]; }
    } else {
#pragma unroll
      for (int e = 0; e < 8; ++e) { um2[e] = 0.f; um1[e] = 0.f; }
    }
  } else {
    float c[8], x[8];
    unpack8(*reinterpret_cast<const uint4*>(proj + (long)(row0 - 2) * NP + 1024 + c0), c);
    unpack8(*reinterpret_cast<const uint4*>(proj + (long)(row0 - 2) * NP + 2048 + c0), x);
#pragma unroll
    for (int e = 0; e < 8; ++e) um2[e] = c[e] * x[e];
    unpack8(*reinterpret_cast<const uint4*>(proj + (long)(row0 - 1) * NP + 1024 + c0), c);
    unpack8(*reinterpret_cast<const uint4*>(proj + (long)(row0 - 1) * NP + 2048 + c0), x);
#pragma unroll
    for (int e = 0; e < 8; ++e) um1[e] = c[e] * x[e];
  }
  for (int t0 = 0; t0 < 16; t0 += 4) {
    uint4 rbv[4], rcv[4], rxv[4], rzv[4];
#pragma unroll
    for (int q = 0; q < 4; ++q) {
      const long rb = (long)(row0 + t0 + q) * NP + c0;
      rbv[q] = *reinterpret_cast<const uint4*>(proj + rb);
      rcv[q] = *reinterpret_cast<const uint4*>(proj + rb + 1024);
      rxv[q] = *reinterpret_cast<const uint4*>(proj + rb + 2048);
      rzv[q] = *reinterpret_cast<const uint4*>(proj + rb + 3072);
    }
#pragma unroll
    for (int q = 0; q < 4; ++q) {
      float b[8], c[8], x[8], z[8], y[8];
      unpack8(rbv[q], b); unpack8(rcv[q], c); unpack8(rxv[q], x); unpack8(rzv[q], z);
#pragma unroll
      for (int e = 0; e < 8; ++e) {
        const float u = c[e] * x[e];
        const float cv = w0[e] * um2[e] + w1[e] * um1[e] + w2[e] * u;
        y[e] = b[e] * cv * silu_f(z[e]);
        um2[e] = um1[e]; um1[e] = u;
      }
      uint4 o;
      o.x = pack2(y[0], y[1]); o.y = pack2(y[2], y[3]); o.z = pack2(y[4], y[5]); o.w = pack2(y[6], y[7]);
      *reinterpret_cast<uint4*>(ymix + (long)(row0 + t0 + q) * DM + c0) = o;
    }
  }
  if (last) {
    float* dst = p.out + (samp ? SCA_OFF + (long)(layer * 8 + sidx) * 2 * 1024 : PCA_OFF + (long)(layer * 4 + sidx) * 2 * 1024) + c0;
#pragma unroll
    for (int e = 0; e < 8; ++e) { dst[e] = um2[e]; dst[1024 + e] = um1[e]; }
  }
}

__device__ __forceinline__ void phase_post(const Params& p, int layer) {
  const int tid = opaque_tid() & 511;
  const u16* proj = (const u16*)(p.ws + OFF_PROJ);
  u16* ymix = (u16*)(p.ws + OFF_YMIX);
  const int hh = (tid >> 4) & 7, d = (tid & 15) * 8;
  float w[8];
#pragma unroll
  for (int e = 0; e < 8; ++e) w[e] = p.onw[layer * 128 + d + e];
  for (int g = blockIdx.x; g < ROWS / 4; g += gridDim.x) {
    const int row = g * 4 + (tid >> 7);
    u16* op = ymix + (long)row * DM + 1024 + hh * 128 + d;
    float o[8], z[8];
    unpack8(*reinterpret_cast<const uint4*>(op), o);
    unpack8(*reinterpret_cast<const uint4*>(proj + (long)row * NP + 7168 + hh * 128 + d), z);
    float ss = 0.f;
#pragma unroll
    for (int e = 0; e < 8; ++e) ss += o[e] * o[e];
    ss += __shfl_xor(ss, 1); ss += __shfl_xor(ss, 2); ss += __shfl_xor(ss, 4); ss += __shfl_xor(ss, 8);
    const float rs = rsqrtf(ss * (1.f / 128.f) + EPS);
    float y[8];
#pragma unroll
    for (int e = 0; e < 8; ++e) y[e] = o[e] * rs * w[e] * silu_f(z[e]);
    uint4 ov;
    ov.x = pack2(y[0], y[1]); ov.y = pack2(y[2], y[3]); ov.z = pack2(y[4], y[5]); ov.w = pack2(y[6], y[7]);
    *reinterpret_cast<uint4*>(op) = ov;
  }
}

__device__ __forceinline__ void phase_final(const Params& p) {
  const int tid = opaque_tid() & 511, wv = tid >> 6, lane = tid & 63;
  const float* sumsq = (const float*)(p.ws + OFF_SUMSQ) + 2L * ROWSP;
  for (int r = blockIdx.x * 8 + wv; r < ROWS; r += gridDim.x * 8) {
    float* dst;
    if (r < ROWS_P) {
      const int b = r / TP, t = r - b * TP;
      if (t < 16) continue;
      dst = p.out + ((long)b * 8192 + (t - 16)) * DM;
    } else {
      dst = p.out + YS_OFF + (long)(r - ROWS_P) * DM;
    }
    const float rs = rsqrtf(sumsq[r] * (1.f / DM) + EPS);
#pragma unroll
    for (int i = 0; i < 8; ++i) {
      const int c = (i * 64 + lane) * 4;
      float4 v = *reinterpret_cast<const float4*>(dst + c);
      const float4 w = *reinterpret_cast<const float4*>(p.fnw + c);
      v.x *= rs * w.x; v.y *= rs * w.y; v.z *= rs * w.z; v.w *= rs * w.w;
      *reinterpret_cast<float4*>(dst + c) = v;
    }
  }
}

typedef const __attribute__((address_space(4))) Params* CParamsPtr;
__device__ __forceinline__ Params ldparams(CParamsPtr q) {
#if defined(__HIP_DEVICE_COMPILE__)
  asm volatile("" : "+s"(q));
  Params r;
  r.xp = q->xp; r.xs = q->xs; r.sca = q->sca; r.scq = q->scq; r.sdel = q->sdel; r.meta = q->meta; r.normw = q->normw; r.win = q->win;
  r.cvaw = q->cvaw; r.cvqw = q->cvqw; r.alog = q->alog; r.dtb = q->dtb; r.onw = q->onw; r.wout = q->wout; r.fnw = q->fnw;
  r.out = q->out; r.ws = q->ws;
  return r;
#else
  return Params{};
#endif
}

__global__ void __launch_bounds__(512) mega(Params p_unused) {
  extern __shared__ __attribute__((aligned(16))) unsigned char smem[];
  cg::grid_group grid = cg::this_grid();
  CParamsPtr kp = (CParamsPtr)__builtin_amdgcn_kernarg_segment_ptr();
  { const Params p = ldparams(kp); phase_prep(p, smem); }
  grid.sync();
  for (int layer = 0; layer < 2; ++layer) {
    { const Params p = ldparams(kp); gemm_phase<1>(p, layer, smem); }
    grid.sync();
    { const Params p = ldparams(kp); for (int item = blockIdx.x; item < NITEM; item += gridDim.x) chunk_prep(p, layer, item, smem); }
    grid.sync();
    {
      const Params p = ldparams(kp);
      const int G = gridDim.x, b = blockIdx.x;
      if (G >= 256) {
        if (b < 128) gdn_scan(p, layer, (((b & 7) + 8 * (b >> 5)) << 2) + ((b >> 3) & 3), smem);
        else {
          if (b < 256) { gdn_scan(p, layer, b, smem); gdn_scan(p, layer, b + 128, smem); }
          for (int ug = b - 128; ug < (NUNIT + 3) / 4; ug += G - 128) mixer_a_group(p, layer, ug);
        }
      } else {
        for (int w = b; w < 384; w += G) gdn_scan(p, layer, w, smem);
        for (int ug = b; ug < (NUNIT + 3) / 4; ug += G) mixer_a_group(p, layer, ug);
      }
    }
    grid.sync();
    { const Params p = ldparams(kp); phase_post(p, layer); }
    grid.sync();
    { const Params p = ldparams(kp); if (layer == 0) gemm_phase<2>(p, layer, smem); else gemm_phase<3>(p, layer, smem); }
    grid.sync();
  }
  { const Params p = ldparams(kp); phase_final(p); }
}

extern "C" void kernel_launch(void* const* d_in, const int* in_sizes, int n_in,
                              void* d_out, int out_size, void* d_ws, size_t ws_size,
                              hipStream_t stream) {
  constexpr size_t kLds = 131072;
  static int grid_blocks = 0;
  if (!grid_blocks) {
    int dev = 0, cus = 0, per_cu = 0;
    (void)hipGetDevice(&dev);
    (void)hipDeviceGetAttribute(&cus, hipDeviceAttributeMultiprocessorCount, dev);
    (void)hipFuncSetAttribute((const void*)mega, hipFuncAttributeMaxDynamicSharedMemorySize, (int)kLds);
    (void)hipOccupancyMaxActiveBlocksPerMultiprocessor(&per_cu, (const void*)mega, 512, kLds);
    if (per_cu < 1) per_cu = 1;
    grid_blocks = cus * per_cu;
    if (ws_size < (size_t)WS_END) fprintf(stderr, "workspace too small: %zu < %ld\n", ws_size, WS_END);
  }
  Params p{};
  p.xp = (const float*)d_in[0]; p.xs = (const float*)d_in[1]; p.sca = (const float*)d_in[2]; p.scq = (const float*)d_in[3];
  p.sdel = (const float*)d_in[4]; p.meta = (const float*)d_in[5]; p.normw = (const float*)d_in[6]; p.win = (const float*)d_in[7];
  p.cvaw = (const float*)d_in[8]; p.cvqw = (const float*)d_in[9]; p.alog = (const float*)d_in[10]; p.dtb = (const float*)d_in[11];
  p.onw = (const float*)d_in[12]; p.wout = (const float*)d_in[13]; p.fnw = (const float*)d_in[14];
  p.out = (float*)d_out; p.ws = (unsigned char*)d_ws;
  void* args[] = {&p};
  hipError_t e = hipLaunchCooperativeKernel((void*)mega, dim3(grid_blocks), dim3(512), args, kLds, stream);
  if (e != hipSuccess) fprintf(stderr, "cooperative launch failed: %s (grid %d)\n", hipGetErrorString(e), grid_blocks);
}
```

```cpp
#include <hip/hip_runtime.h>
#include <hip/hip_bf16.h>
#include <hip/hip_cooperative_groups.h>
#include <cstdio>
namespace cg = cooperative_groups;

typedef unsigned short u16;
using bf16x8 = __attribute__((ext_vector_type(8))) short;
using f32x4 = __attribute__((ext_vector_type(4))) float;

constexpr int DM = 2048;
constexpr int NP = 8208;
constexpr int NPP = 8448;
constexpr int TP = 8208;
constexpr int ROWS_P = 4 * TP;
constexpr int ROWS = ROWS_P + 512;
constexpr int ROWSP = 33536;
constexpr int NCHUNK = 524;
constexpr int NITEM = NCHUNK * 8;
constexpr float EPS = 1e-6f;

constexpr long OFF_WTIN = 0;
constexpr long OFF_WTOUT = OFF_WTIN + 2L * NPP * DM * 2;
constexpr long OFF_HB = OFF_WTOUT + 2L * DM * DM * 2;
constexpr long OFF_PROJ = OFF_HB + (long)ROWSP * DM * 2;
constexpr long OFF_YMIX = OFF_PROJ + (long)ROWS * NP * 2;
constexpr long OFF_SUMSQ = OFF_YMIX + (long)ROWSP * DM * 2;
constexpr long OFF_EGL = OFF_SUMSQ + 3L * ROWSP * 4;
constexpr long OFF_QK = OFF_EGL + 16896;
constexpr long OFF_UT = OFF_QK + (long)NITEM * 4096 * 2;
constexpr long WS_END = OFF_UT + (long)NITEM * 8192 * 2;
constexpr long OOFF_W = 0;
constexpr long OOFF_QG = OOFF_W + (long)NITEM * 8192 * 2;
constexpr long OOFF_KPT = OOFF_QG + (long)NITEM * 8192 * 2;
constexpr long YS_OFF = 67108864L;
constexpr long PCA_OFF = YS_OFF + 1048576L;
constexpr long PCQ_OFF = PCA_OFF + 16384L;
constexpr long PD_OFF = PCQ_OFF + 73728L;
constexpr long SCA_OFF = PD_OFF + 1048576L;
constexpr long SCQ_OFF = SCA_OFF + 32768L;
constexpr long SD_OFF = SCQ_OFF + 147456L;

struct Params {
  const float *xp, *xs, *sca, *scq, *sdel, *meta, *normw, *win, *cvaw, *cvqw, *alog, *dtb, *onw, *wout, *fnw;
  float* out;
  unsigned char* ws;
};

typedef __bf16 bf16x2_t __attribute__((ext_vector_type(2)));
typedef float f32x2_t __attribute__((ext_vector_type(2)));
__device__ __forceinline__ unsigned pack2(float a, float b) {
#if defined(__HIP_DEVICE_COMPILE__)
  f32x2_t v = {a, b};
  return __builtin_bit_cast(unsigned, __builtin_convertvector(v, bf16x2_t));
#else
  return 0u;
#endif
}
__device__ __forceinline__ u16 f2bf(float f) { return (u16)(pack2(f, 0.f) & 0xffffu); }
__device__ __forceinline__ int opaque_tid() { int t; asm volatile("v_mov_b32 %0, %1" : "=v"(t) : "v"((int)threadIdx.x)); return t; }
__device__ __forceinline__ float bf2f(u16 h) { return __uint_as_float(((unsigned)h) << 16); }
__device__ __forceinline__ uint2 pack4(float a, float b, float c, float d) { return make_uint2(pack2(a, b), pack2(c, d)); }
__device__ __forceinline__ void unpack4(uint2 v, float* o) {
  o[0] = __uint_as_float(v.x << 16); o[1] = __uint_as_float(v.x & 0xffff0000u);
  o[2] = __uint_as_float(v.y << 16); o[3] = __uint_as_float(v.y & 0xffff0000u);
}
__device__ __forceinline__ void unpack8(uint4 v, float* o) {
  o[0] = __uint_as_float(v.x << 16); o[1] = __uint_as_float(v.x & 0xffff0000u);
  o[2] = __uint_as_float(v.y << 16); o[3] = __uint_as_float(v.y & 0xffff0000u);
  o[4] = __uint_as_float(v.z << 16); o[5] = __uint_as_float(v.z & 0xffff0000u);
  o[6] = __uint_as_float(v.w << 16); o[7] = __uint_as_float(v.w & 0xffff0000u);
}
__device__ __forceinline__ float silu_f(float x) { return x * __frcp_rn(1.f + __expf(-x)); }
__device__ __forceinline__ f32x4 mfma16(bf16x8 a, bf16x8 b, f32x4 c) {
  return __builtin_amdgcn_mfma_f32_16x16x32_bf16(a, b, c, 0, 0, 0);
}
__device__ __forceinline__ bf16x8 ldfrag(const u16* base, int stride, int row, int k) {
  return *reinterpret_cast<const bf16x8*>(base + row * stride + k);
}

__device__ __forceinline__ void l2_touch(const void* ptr) {
  (void)ptr;
}
__device__ __forceinline__ unsigned touch_ld(const void* ptr) { return *reinterpret_cast<const unsigned*>(ptr); }
__device__ __forceinline__ void touch_use(unsigned& acc, unsigned v) { asm volatile("v_add_u32 %0, %0, %1" : "+v"(acc) : "v"(v)); }

__device__ __forceinline__ f32x4 mm16(const float* X, int xr, int xc, const float* Y, int yr, int yc, int kn, int fr, int fq) {
  f32x4 c = {0.f, 0.f, 0.f, 0.f};
  for (int k0 = 0; k0 < kn; k0 += 4) {
    const float a = X[(xr + fr) * 68 + xc + k0 + fq];
    const float b = Y[(yr + k0 + fq) * 68 + yc + fr];
    c = __builtin_amdgcn_mfma_f32_16x16x4f32(a, b, c, 0, 0, 0);
  }
  return c;
}

__device__ __forceinline__ void transpose_tiles(const float* __restrict__ src, u16* __restrict__ dst, const float* __restrict__ scale,
                                                int nsrc, int ntile_n, unsigned char* smem) {
  float* tile = (float*)smem;
  const int tid = opaque_tid();
  const int ntiles = 32 * ntile_n;
  for (int t = blockIdx.x; t < ntiles; t += gridDim.x) {
    const int kt = t & 31, nt = t >> 5;
    const int k0 = kt * 64, n0 = nt * 64;
    {
      const int nl = tid & 63, kb = tid >> 6;
#pragma unroll
      for (int it = 0; it < 8; ++it) {
        const int kl = kb + it * 8;
        const int n = n0 + nl;
        float v = 0.f;
        if (n < nsrc) v = src[(long)(k0 + kl) * nsrc + n] * (scale ? scale[k0 + kl] : 1.f);
        tile[kl * 65 + nl] = v;
      }
    }
    __syncthreads();
    {
      const int nl = tid >> 3, kg = tid & 7;
      float v[8];
#pragma unroll
      for (int e = 0; e < 8; ++e) v[e] = tile[(kg * 8 + e) * 65 + nl];
      uint4 o;
      o.x = pack2(v[0], v[1]); o.y = pack2(v[2], v[3]); o.z = pack2(v[4], v[5]); o.w = pack2(v[6], v[7]);
      *reinterpret_cast<uint4*>(dst + (long)(n0 + nl) * DM + k0 + kg * 8) = o;
    }
    __syncthreads();
  }
}

__device__ __forceinline__ void phase_prep(const Params& p, unsigned char* smem) {
  const int tid = opaque_tid(), wv = tid >> 6, lane = tid & 63;
  u16* hb = (u16*)(p.ws + OFF_HB);
  float* sumsq = (float*)(p.ws + OFF_SUMSQ);
  for (int r = blockIdx.x * 8 + wv; r < ROWSP; r += gridDim.x * 8) {
    const float* src = nullptr;
    if (r < ROWS_P) {
      const int b = r / TP, t = r - b * TP;
      src = (t < 16) ? (p.meta + (long)t * DM) : (p.xp + ((long)b * 8192 + (t - 16)) * DM);
    } else if (r < ROWS) {
      src = p.xs + (long)(r - ROWS_P) * DM;
    }
    float ss = 0.f;
#pragma unroll
    for (int i = 0; i < 8; ++i) {
      const int c = (i * 64 + lane) * 4;
      float4 v = make_float4(0.f, 0.f, 0.f, 0.f);
      if (src) v = *reinterpret_cast<const float4*>(src + c);
      ss += v.x * v.x + v.y * v.y + v.z * v.z + v.w * v.w;
      *reinterpret_cast<uint2*>(hb + (long)r * DM + c) = pack4(v.x, v.y, v.z, v.w);
    }
#pragma unroll
    for (int o = 32; o > 0; o >>= 1) ss += __shfl_xor(ss, o);
    if (lane == 0) sumsq[r] = ss;
  }
  for (long i = (long)blockIdx.x * 512 + tid; i < 2L * ROWSP; i += (long)gridDim.x * 512) sumsq[ROWSP + i] = 0.f;
  for (int l = 0; l < 2; ++l) {
    transpose_tiles(p.win + (long)l * DM * NP, (u16*)(p.ws + OFF_WTIN) + (long)l * NPP * DM, p.normw + l * DM, NP, NPP / 64, smem);
    transpose_tiles(p.wout + (long)l * DM * DM, (u16*)(p.ws + OFF_WTOUT) + (long)l * DM * DM, nullptr, DM, DM / 64, smem);
  }
}

constexpr int BM = 256, BK = 64, HALF = 128, HT = HALF * BK;

__device__ __forceinline__ int lds_byte(int r, int c) {
  int st = (r >> 4) * 2 + (c >> 5), rr = r & 15, cc = c & 31, ob = rr * 64 + cc * 2;
  return st * 1024 + (ob ^ (((ob >> 9) & 1) << 5));
}
__device__ __forceinline__ void stage_rc(int b, int& R, int& C) {
  int st = b / 1024, sb = b % 1024, swz = sb ^ (((sb >> 9) & 1) << 5);
  R = (st >> 1) * 16 + swz / 64; C = (st & 1) * 32 + (swz % 64) / 2;
}

template <int EPI>
__device__ __forceinline__ void gemm_phase(const Params& p, int layer, unsigned char* smem) {
  typedef __hip_bfloat16 bf16;
  bf16* shm = (bf16*)smem;
  const bf16* A = (const bf16*)(p.ws + (EPI == 1 ? OFF_HB : OFF_YMIX));
  const bf16* Bt = (EPI == 1) ? (const bf16*)(p.ws + OFF_WTIN) + (long)layer * NPP * DM
                              : (const bf16*)(p.ws + OFF_WTOUT) + (long)layer * DM * DM;
  constexpr int K = DM;
  constexpr int nM = ROWSP / BM;
  constexpr int nN = (EPI == 1) ? NPP / BM : DM / BM;
  constexpr int WGM = 8;
  constexpr int nwg = nM * nN;
#define SA(b, h) (shm + ((b) * 2 + (h)) * HT)
#define SB(b, h) (shm + (4 + (b) * 2 + (h)) * HT)
#define OA(b, h) ((((b) * 2 + (h)) * HT) * 2)
#define OB(b, h) (((4 + (b) * 2 + (h)) * HT) * 2)
#define STAGE(PO, BASE, br, kt) do { const char* _ub = (const char*)(BASE) + ((long)(br) * K + (long)(kt) * BK) * 2; \
      asm volatile("s_add_u32 m0, %0, %3\n\ts_nop 0\n\tglobal_load_lds_dwordx4 %1, %2" :: "s"(ldsw), "v"(soff0), "s"(_ub), "n"(PO) : "memory", "scc"); \
      asm volatile("s_add_u32 m0, %0, %3\n\ts_nop 0\n\tglobal_load_lds_dwordx4 %1, %2" :: "s"(ldsw), "v"(soff1), "s"(_ub), "n"((PO) + 8192) : "memory", "scc"); } while (0)
#define LDA(dst, b, h) for (int m = 0; m < 4; ++m) for (int k = 0; k < 2; ++k) \
    dst[m][k] = *reinterpret_cast<const bf16x8*>((char*)SA(b, h) + lds_byte(wr * 64 + m * 16 + fr, k * 32 + fq * 8))
#define LDB(dst, b, h) for (int n = 0; n < 2; ++n) for (int k = 0; k < 2; ++k) \
    dst[n][k] = *reinterpret_cast<const bf16x8*>((char*)SB(b, h) + lds_byte(wc * 32 + n * 16 + fr, k * 32 + fq * 8))
#define MMA(ai, bj, At, Bt_) do { __builtin_amdgcn_s_setprio(1); \
    for (int m = 0; m < 4; ++m) for (int n = 0; n < 2; ++n) for (int k = 0; k < 2; ++k) \
      acc[ai][bj][m][n] = __builtin_amdgcn_mfma_f32_16x16x32_bf16(At[m][k], Bt_[n][k], acc[ai][bj][m][n], 0, 0, 0); \
    __builtin_amdgcn_s_setprio(0); } while (0)
#define WAIT_V(n) asm volatile("s_waitcnt vmcnt(" #n ")" ::: "memory")
#define WAIT_L(n) asm volatile("s_waitcnt lgkmcnt(" #n ")" ::: "memory")
#define BAR __builtin_amdgcn_s_barrier()
#define SCHED __builtin_amdgcn_sched_barrier(0)

  const int gtid = opaque_tid() & 511;
  const int wid = __builtin_amdgcn_readfirstlane(gtid >> 6), lane = gtid & 63, wr = wid >> 2, wc = wid & 3, fr = lane & 15, fq = lane >> 4;
  unsigned soff0, soff1;
  { int _r, _c; stage_rc(gtid * 16, _r, _c); soff0 = (unsigned)(_r * K + _c) * 2u;
    stage_rc(gtid * 16 + 8192, _r, _c); soff1 = (unsigned)(_r * K + _c) * 2u; }
  const unsigned ldsw = (unsigned)(size_t)((__attribute__((address_space(3))) unsigned char*)smem) + (unsigned)wid * 1024u;
  int gdim = (int)gridDim.x;
  asm volatile("" : "+s"(gdim));
  int vb = blockIdx.x;
  if ((gdim & 7) == 0) vb = (blockIdx.x & 7) * (gdim >> 3) + (blockIdx.x >> 3);
  constexpr int nig = WGM * nN;
#define TILE_RC(wg, BR, BC) do { const int gid_ = (wg) / nig, fm_ = gid_ * WGM, gsz_ = min(nM - fm_, WGM); \
    BC = (fm_ + (((wg) % nig) % gsz_)) * BM; BR = (((wg) % nig) / gsz_) * BM; } while (0)
  int brow = 0, bcol = 0;
  if (vb < nwg) {
    TILE_RC(vb, brow, bcol);
    STAGE(OB(0, 0), A, bcol, 0); STAGE(OA(0, 0), Bt, brow, 0);
    STAGE(OB(0, 1), A, bcol + HALF, 0); STAGE(OA(0, 1), Bt, brow + HALF, 0);
  }
  for (int wgid = vb; wgid < nwg; wgid += gdim) {
    f32x4 acc[2][2][4][2] = {};
    bf16x8 At[4][2], B0[2][2], B1[2][2];
    constexpr int nt = K / BK;
    if (wr == 1) BAR;
    WAIT_V(4); BAR;
    STAGE(OB(1, 0), A, bcol, 1); STAGE(OA(1, 0), Bt, brow, 1); STAGE(OB(1, 1), A, bcol + HALF, 1);
    WAIT_V(6); BAR;
    for (int t = 0; t < nt - 2; t += 2) {
      LDB(B0, 0, 0); SCHED; LDA(At, 0, 0); STAGE(OA(1, 1), Bt, brow + HALF, t + 1);
      WAIT_L(8); BAR; WAIT_L(0); MMA(0, 0, At, B0); BAR; SCHED;
      LDB(B1, 0, 1); STAGE(OB(0, 0), A, bcol, t + 2);
      BAR; WAIT_L(0); MMA(0, 1, At, B1); BAR;
      LDA(At, 0, 1); STAGE(OA(0, 0), Bt, brow, t + 2);
      BAR; WAIT_L(0); MMA(1, 0, At, B0); BAR; SCHED;
      STAGE(OB(0, 1), A, bcol + HALF, t + 2);
      WAIT_V(6); BAR; MMA(1, 1, At, B1); BAR;
      LDB(B0, 1, 0); SCHED; LDA(At, 1, 0); STAGE(OA(0, 1), Bt, brow + HALF, t + 2);
      WAIT_L(8); BAR; WAIT_L(0); MMA(0, 0, At, B0); BAR; SCHED;
      LDB(B1, 1, 1); STAGE(OB(1, 0), A, bcol, t + 3);
      BAR; WAIT_L(0); MMA(0, 1, At, B1); BAR;
      LDA(At, 1, 1); STAGE(OA(1, 0), Bt, brow, t + 3);
      BAR; WAIT_L(0); MMA(1, 0, At, B0); BAR; SCHED;
      STAGE(OB(1, 1), A, bcol + HALF, t + 3);
      WAIT_V(6); BAR; MMA(1, 1, At, B1); BAR;
    }
    { LDB(B0, 0, 0); LDA(At, 0, 0); STAGE(OA(1, 1), Bt, brow + HALF, nt - 1);
      BAR; WAIT_L(0); MMA(0, 0, At, B0); BAR;
      LDB(B1, 0, 1); BAR; WAIT_L(0); MMA(0, 1, At, B1); BAR;
      LDA(At, 0, 1); WAIT_V(4); BAR; WAIT_L(0); MMA(1, 0, At, B0); MMA(1, 1, At, B1); BAR; }
    { LDB(B0, 1, 0); LDA(At, 1, 0); WAIT_V(2); BAR; WAIT_L(0); MMA(0, 0, At, B0); BAR;
      LDB(B1, 1, 1); WAIT_V(0); BAR; WAIT_L(0); MMA(0, 1, At, B1); BAR;
      LDA(At, 1, 1); BAR; WAIT_L(0); MMA(1, 0, At, B0); MMA(1, 1, At, B1); BAR; }
    if (wr == 0) BAR;
    const int erow = brow, ecol = bcol;
    if (wgid + gdim < nwg) {
      TILE_RC(wgid + gdim, brow, bcol);
      STAGE(OB(0, 0), A, bcol, 0); STAGE(OA(0, 0), Bt, brow, 0);
      STAGE(OB(0, 1), A, bcol + HALF, 0); STAGE(OA(0, 1), Bt, brow + HALF, 0);
    }
    if (EPI == 1) {
      u16* proj = (u16*)(p.ws + OFF_PROJ);
      const float* sumsq = (const float*)(p.ws + OFF_SUMSQ) + (long)layer * ROWSP;
#pragma unroll
      for (int bj = 0; bj < 2; ++bj)
#pragma unroll
        for (int n = 0; n < 2; ++n) {
          const int tok = ecol + bj * HALF + wc * 32 + n * 16 + fr;
          if (tok < ROWS) {
            const float rs = rsqrtf(sumsq[tok] * (1.f / DM) + EPS);
            u16* prow = proj + (long)tok * NP;
#pragma unroll
            for (int ai = 0; ai < 2; ++ai)
#pragma unroll
              for (int m = 0; m < 4; ++m) {
                const int n0 = erow + ai * HALF + wr * 64 + m * 16 + fq * 4;
                if (n0 < NP)
                  *reinterpret_cast<uint2*>(prow + n0) = pack4(acc[ai][bj][m][n][0] * rs, acc[ai][bj][m][n][1] * rs,
                                                                acc[ai][bj][m][n][2] * rs, acc[ai][bj][m][n][3] * rs);
              }
          }
        }
    } else {
      u16* hb = (u16*)(p.ws + OFF_HB);
      float* sumsq = (float*)(p.ws + OFF_SUMSQ) + (long)(EPI == 2 ? 1 : 2) * ROWSP;
#pragma unroll
      for (int bj = 0; bj < 2; ++bj)
#pragma unroll
        for (int n = 0; n < 2; ++n) {
          const int tok = ecol + bj * HALF + wc * 32 + n * 16 + fr;
          float* dst = nullptr;
          if (EPI == 3) {
            if (tok < ROWS_P) {
              const int b = tok / TP, t = tok - b * TP;
              if (t >= 16) dst = p.out + ((long)b * 8192 + (t - 16)) * DM;
            } else if (tok < ROWS) {
              dst = p.out + YS_OFF + (long)(tok - ROWS_P) * DM;
            }
          }
          u16* hrow = hb + (long)tok * DM;
          float rsum = 0.f;
#pragma unroll
          for (int ai = 0; ai < 2; ++ai)
#pragma unroll
            for (int m = 0; m < 4; ++m) {
              const int n0 = erow + ai * HALF + wr * 64 + m * 16 + fq * 4;
              float r4[4];
              unpack4(*reinterpret_cast<const uint2*>(hrow + n0), r4);
              float v[4];
#pragma unroll
              for (int j = 0; j < 4; ++j) { v[j] = acc[ai][bj][m][n][j] + r4[j]; rsum += v[j] * v[j]; }
              if (EPI == 2) *reinterpret_cast<uint2*>(hrow + n0) = pack4(v[0], v[1], v[2], v[3]);
              else if (dst) *reinterpret_cast<float4*>(dst + n0) = make_float4(v[0], v[1], v[2], v[3]);
            }
          rsum += __shfl_xor(rsum, 16); rsum += __shfl_xor(rsum, 32);
          if (fq == 0) atomicAdd(&sumsq[tok], rsum);
        }
    }
  }
  __syncthreads();
#undef TILE_RC
#undef SA
#undef SB
#undef OA
#undef OB
#undef STAGE
#undef LDA
#undef LDB
#undef MMA
}

__device__ __forceinline__ void chunk_geom(int cid, int& row0, int& nvalid, int& prevmode, int& sidx, bool& lastc) {
  if (cid < 516) {
    const int s = cid / 129, c = cid - s * 129;
    sidx = s; lastc = (c == 128);
    if (c == 0) { row0 = s * TP; nvalid = 16; prevmode = 0; }
    else { row0 = s * TP + 16 + (c - 1) * 64; nvalid = 64; prevmode = 1; }
  } else {
    sidx = cid - 516; row0 = ROWS_P + sidx * 64; nvalid = 64; prevmode = 2; lastc = true;
  }
}

__device__ __forceinline__ long item_slot(int cid, int h) {
  if (cid < 516) { const int s = cid / 129, c = cid - s * 129; return (long)((s * 8 + h) * 129 + c); }
  return (long)(4128 + (cid - 516) * 8 + h);
}

__device__ __forceinline__ void chunk_prep(const Params& p, int layer, int item, unsigned char* smem) {
  const int tid = opaque_tid() & 511, wv = __builtin_amdgcn_readfirstlane(tid >> 6), lane = tid & 63, fr = lane & 15, fq = lane >> 4;
  const int cid = item >> 3, h = item & 7;
  int row0, nvalid, prevmode, sidx; bool lastc;
  chunk_geom(cid, row0, nvalid, prevmode, sidx, lastc);
  u16* sKB = (u16*)smem;
  u16* sK = sKB + 64 * 136;
  u16* sQ = sK + 64 * 136;
  u16* sVBT = sQ + 64 * 136;
  u16* sKBGT = sVBT + 128 * 72;
  u16* sT = sKBGT + 128 * 72;
  float* sA = (float*)(sT + 64 * 72);
  float* sBeta = sA + 64 * 68;
  float* sGc = sBeta + 64;
  float* sTf = (float*)smem;
  float* sY = sTf + 64 * 68;
  int zoff;
  asm volatile("v_mov_b32 %0, 0" : "=v"(zoff));
  const u16* proj = (const u16*)(p.ws + OFF_PROJ);
  const long slot = item_slot(cid, h);
  u16* Wd = (u16*)((unsigned char*)p.out) + slot * 24576;
  u16* QG = Wd + 8192;
  u16* KPT = Wd + 16384;
  u16* UTd = (u16*)(p.ws + OFF_QK) + slot * 12288;
  u16* QKd = UTd + 8192;
  float* EGL = (float*)(p.ws + OFF_EGL);

  unsigned tch = 0;
  {
    const int nitem = item + gridDim.x;
    if (nitem < NITEM) {
      int nrow0, nnv, npm, nsi; bool nl;
      chunk_geom(nitem >> 3, nrow0, nnv, npm, nsi, nl);
      const int nh = nitem & 7;
      if (tid < 402) {
        const int r = tid / 6, m6 = tid - r * 6;
        tch = touch_ld(proj + (long)(nrow0 - 3 + r) * NP + 4096 + (m6 >> 1) * 1024 + nh * 128 + (m6 & 1) * 64);
      } else if (tid >= 448) {
        tch = touch_ld(proj + (long)(nrow0 + (tid - 448)) * NP + 8192 + nh);
      }
    }
  }
  if (wv == 0) {
    float beta = 0.f, g = 0.f;
    if (lane < nvalid) {
      const long rb = (long)(row0 + lane) * NP;
      const float bl = bf2f(proj[rb + 8192 + h]);
      const float al = bf2f(proj[rb + 8200 + h]) + p.dtb[layer * 8 + h];
      beta = 1.f / (1.f + expf(-bl));
      const float sp = (al > 20.f) ? al : log1pf(expf(al));
      g = -expf(p.alog[layer * 8 + h]) * sp;
    }
    float gc = g;
#pragma unroll
    for (int o = 1; o < 64; o <<= 1) { const float t = __shfl_up(gc, o); if (lane >= o) gc += t; }
    sBeta[lane] = beta; sGc[lane] = gc;
  }

  const int rg = tid >> 5, cg = tid & 31, i0 = rg * 4, d0 = cg * 4;
  float qv[4][4], kv[4][4], vv[4][4];
#pragma unroll
  for (int mat = 0; mat < 3; ++mat) {
    const int ch = mat * 1024 + h * 128 + d0;
    const int colbase = 4096 + ch;
    float xr[7][4];
#pragma unroll
    for (int a = 0; a < 7; ++a) {
      const int ri = i0 - 3 + a;
      if (ri >= 0 || prevmode == 1) {
        uint2 raw = *reinterpret_cast<const uint2*>(proj + (long)(row0 + ri) * NP + colbase);
        unpack4(raw, xr[a]);
      } else if (prevmode == 2) {
        const float4 v = *reinterpret_cast<const float4*>(p.scq + ((long)(layer * 8 + sidx) * 3 + (3 + ri)) * 3072 + ch);
        xr[a][0] = v.x; xr[a][1] = v.y; xr[a][2] = v.z; xr[a][3] = v.w;
      } else {
        xr[a][0] = xr[a][1] = xr[a][2] = xr[a][3] = 0.f;
      }
    }
    if (lastc && rg == 15) {
      float* dst = p.out + (prevmode == 2 ? SCQ_OFF + (long)(layer * 8 + sidx) * 3 * 3072 : PCQ_OFF + (long)(layer * 4 + sidx) * 3 * 3072) + ch;
#pragma unroll
      for (int a = 4; a < 7; ++a)
        *reinterpret_cast<float4*>(dst + (a - 4) * 3072) = make_float4(xr[a][0], xr[a][1], xr[a][2], xr[a][3]);
    }
    float cw[4][4];
#pragma unroll
    for (int j = 0; j < 4; ++j) {
      const float4 v = *reinterpret_cast<const float4*>(p.cvqw + (long)(layer * 4 + j) * 3072 + ch);
      cw[j][0] = v.x; cw[j][1] = v.y; cw[j][2] = v.z; cw[j][3] = v.w;
    }
#pragma unroll
    for (int ii = 0; ii < 4; ++ii)
#pragma unroll
      for (int e = 0; e < 4; ++e) {
        float o = 0.f;
#pragma unroll
        for (int j = 0; j < 4; ++j) o += cw[j][e] * xr[ii + j][e];
        o = silu_f(o);
        if (mat == 0) qv[ii][e] = o; else if (mat == 1) kv[ii][e] = o; else vv[ii][e] = o;
      }
  }
#pragma unroll
  for (int ii = 0; ii < 4; ++ii) {
    float sq = 0.f, sk = 0.f;
#pragma unroll
    for (int e = 0; e < 4; ++e) { sq += qv[ii][e] * qv[ii][e]; sk += kv[ii][e] * kv[ii][e]; }
#pragma unroll
    for (int o = 1; o < 32; o <<= 1) { sq += __shfl_xor(sq, o); sk += __shfl_xor(sk, o); }
    const float rq = rsqrtf(sq + EPS) * 0.08838834764831845f, rk = rsqrtf(sk + EPS);
    const bool valid = (i0 + ii) < nvalid;
#pragma unroll
    for (int e = 0; e < 4; ++e) {
      qv[ii][e] = valid ? qv[ii][e] * rq : 0.f;
      kv[ii][e] = valid ? kv[ii][e] * rk : 0.f;
      vv[ii][e] = valid ? vv[ii][e] : 0.f;
    }
  }
  __syncthreads();
  float beta[4], gcv[4];
#pragma unroll
  for (int ii = 0; ii < 4; ++ii) { beta[ii] = sBeta[i0 + ii]; gcv[ii] = sGc[i0 + ii]; }
  const float glast = sGc[63];
  if (tid == 0) EGL[slot] = expf(glast);

#pragma unroll
  for (int ii = 0; ii < 4; ++ii) {
    const int i = i0 + ii;
    const float b = beta[ii], eg = __expf(gcv[ii]);
    *reinterpret_cast<uint2*>(sKB + i * 136 + d0) = pack4(kv[ii][0] * b, kv[ii][1] * b, kv[ii][2] * b, kv[ii][3] * b);
    *reinterpret_cast<uint2*>(sK + i * 136 + d0) = pack4(kv[ii][0], kv[ii][1], kv[ii][2], kv[ii][3]);
    *reinterpret_cast<uint2*>(sQ + i * 136 + d0) = pack4(qv[ii][0], qv[ii][1], qv[ii][2], qv[ii][3]);
    *reinterpret_cast<uint2*>(QG + i * 128 + d0) = pack4(qv[ii][0] * eg, qv[ii][1] * eg, qv[ii][2] * eg, qv[ii][3] * eg);
  }
  {
    float bg[4], kd[4];
#pragma unroll
    for (int ii = 0; ii < 4; ++ii) { bg[ii] = beta[ii] * __expf(gcv[ii]); kd[ii] = __expf(glast - gcv[ii]); }
#pragma unroll
    for (int e = 0; e < 4; ++e) {
      const int d = d0 + e;
      *reinterpret_cast<uint2*>(sVBT + d * 72 + i0) = pack4(vv[0][e] * beta[0], vv[1][e] * beta[1], vv[2][e] * beta[2], vv[3][e] * beta[3]);
      *reinterpret_cast<uint2*>(sKBGT + d * 72 + i0) = pack4(kv[0][e] * bg[0], kv[1][e] * bg[1], kv[2][e] * bg[2], kv[3][e] * bg[3]);
      *reinterpret_cast<uint2*>(KPT + d * 64 + i0) = pack4(kv[0][e] * kd[0], kv[1][e] * kd[1], kv[2][e] * kd[2], kv[3][e] * kd[3]);
    }
  }
  __syncthreads();
  {
    const int ib = wv >> 1;
#pragma unroll
    for (int jj = 0; jj < 2; ++jj) {
      const int jb = (wv & 1) * 2 + jj;
      f32x4 c = {0.f, 0.f, 0.f, 0.f}, c2 = {0.f, 0.f, 0.f, 0.f};
#pragma unroll
      for (int kk = 0; kk < 4; ++kk) {
        const bf16x8 a = ldfrag(sKB, 136, ib * 16 + fr, kk * 32 + fq * 8);
        const bf16x8 b = ldfrag(sK, 136, jb * 16 + fr, kk * 32 + fq * 8);
        c = mfma16(a, b, c);
        const bf16x8 b2 = ldfrag(sQ, 136, ib * 16 + fr, kk * 32 + fq * 8);
        c2 = mfma16(b, b2, c2);
      }
      {
        const int j = jb * 16 + fr;
        const float gj = sGc[j];
#pragma unroll
        for (int r = 0; r < 4; ++r) {
          const int i = ib * 16 + fq * 4 + r;
          sA[i * 68 + j] = (i > j) ? c[r] * __expf(sGc[i] - gj) : 0.f;
        }
      }
      {
        const int i = ib * 16 + fr;
        const float gi = sGc[i];
        float o[4];
#pragma unroll
        for (int r = 0; r < 4; ++r) {
          const int j = jb * 16 + fq * 4 + r;
          o[r] = (i >= j) ? c2[r] * __expf(gi - sGc[j]) : 0.f;
        }
        *reinterpret_cast<uint2*>(QKd + i * 64 + jb * 16 + fq * 4) = pack4(o[0], o[1], o[2], o[3]);
      }
    }
  }
  __syncthreads();
  {
    for (int e = tid; e < 64 * 68; e += 512) sTf[e] = 0.f;
    __syncthreads();
    if (wv < 4 && lane < 16) {
      const float* Ab = sA + (wv * 16) * 68 + wv * 16 + zoff;
      float t[16], ac[16], an[16];
      t[0] = (lane == 0) ? 1.f : 0.f;
      sTf[(wv * 16) * 68 + wv * 16 + lane] = t[0];
      ac[0] = Ab[68];
#pragma unroll
      for (int i = 1; i < 16; ++i) {
        if (i + 1 < 16) {
#pragma unroll
          for (int j = 0; j <= i; ++j) an[j] = Ab[(i + 1) * 68 + j];
        }
        float a = (lane == i) ? 1.f : 0.f;
#pragma unroll
        for (int j = 0; j < i; ++j) a -= ac[j] * t[j];
        t[i] = a;
        sTf[(wv * 16 + i) * 68 + wv * 16 + lane] = a;
        if (i + 1 < 16) {
#pragma unroll
          for (int j = 0; j <= i; ++j) ac[j] = an[j];
        }
        __builtin_amdgcn_sched_barrier(0);
      }
    }
    __syncthreads();
    if (wv < 2) {
      const int o = wv * 32;
      const f32x4 c = mm16(sA, o + 16, o, sTf, o, o, 16, fr, fq);
#pragma unroll
      for (int r = 0; r < 4; ++r) sY[(o + 16 + fq * 4 + r) * 68 + o + fr] = c[r];
    }
    __syncthreads();
    if (wv < 2) {
      const int o = wv * 32;
      const f32x4 c = mm16(sTf, o + 16, o + 16, sY, o + 16, o, 16, fr, fq);
#pragma unroll
      for (int r = 0; r < 4; ++r) sTf[(o + 16 + fq * 4 + r) * 68 + o + fr] = -c[r];
    }
    __syncthreads();
    if (wv < 4) {
      const int bi = wv >> 1, bj = wv & 1;
      const f32x4 c = mm16(sA, 32 + bi * 16, 0, sTf, 0, bj * 16, 32, fr, fq);
#pragma unroll
      for (int r = 0; r < 4; ++r) sY[(32 + bi * 16 + fq * 4 + r) * 68 + bj * 16 + fr] = c[r];
    }
    __syncthreads();
    if (wv < 4) {
      const int bi = wv >> 1, bj = wv & 1;
      const f32x4 c = mm16(sTf, 32 + bi * 16, 32, sY, 32, bj * 16, 32, fr, fq);
#pragma unroll
      for (int r = 0; r < 4; ++r) sTf[(32 + bi * 16 + fq * 4 + r) * 68 + bj * 16 + fr] = -c[r];
    }
    __syncthreads();
    {
      const int i = tid >> 3, j0 = (tid & 7) * 8;
      float v[8];
#pragma unroll
      for (int e = 0; e < 8; ++e) v[e] = sTf[i * 68 + j0 + e];
      uint4 o;
      o.x = pack2(v[0], v[1]); o.y = pack2(v[2], v[3]); o.z = pack2(v[4], v[5]); o.w = pack2(v[6], v[7]);
      *reinterpret_cast<uint4*>(sT + i * 72 + j0) = o;
    }
  }
  __syncthreads();
  {
    const int ib = wv >> 1;
#pragma unroll
    for (int x = 0; x < 4; ++x) {
      const int dvb = (wv & 1) * 4 + x;
      f32x4 c = {0.f, 0.f, 0.f, 0.f};
#pragma unroll
      for (int kk = 0; kk < 2; ++kk)
        c = mfma16(ldfrag(sT, 72, ib * 16 + fr, kk * 32 + fq * 8), ldfrag(sVBT, 72, dvb * 16 + fr, kk * 32 + fq * 8), c);
      *reinterpret_cast<uint2*>(UTd + (dvb * 16 + fr) * 64 + ib * 16 + fq * 4) = pack4(c[0], c[1], c[2], c[3]);
    }
#pragma unroll
    for (int ib2 = 0; ib2 < 4; ++ib2) {
      f32x4 c = {0.f, 0.f, 0.f, 0.f};
#pragma unroll
      for (int kk = 0; kk < 2; ++kk)
        c = mfma16(ldfrag(sKBGT, 72, wv * 16 + fr, kk * 32 + fq * 8), ldfrag(sT, 72, ib2 * 16 + fr, kk * 32 + fq * 8), c);
      *reinterpret_cast<uint2*>(Wd + (ib2 * 16 + fr) * 128 + wv * 16 + fq * 4) = pack4(c[0], c[1], c[2], c[3]);
    }
  }
  __syncthreads();
  {
    unsigned tacc = 0;
    touch_use(tacc, tch);
    if (tacc == 0x9e3779b9u) ((volatile float*)EGL)[NITEM + 9] = 1.f;
  }
}

__device__ __forceinline__ void gdn_scan(const Params& p, int layer, int widx, unsigned char* smem) {
  const int tid = opaque_tid() & 511, wv = __builtin_amdgcn_readfirstlane(tid >> 6), lane = tid & 63, fr = lane & 15, fq = lane >> 4;
  const bool is_prompt = widx < 128;
  int s, h, sl, nsteps, cid0;
  if (is_prompt) { s = widx >> 5; h = (widx >> 2) & 7; sl = widx & 3; nsteps = 129; cid0 = s * 129; }
  else { const int j = widx - 128; s = j >> 5; h = (j >> 2) & 7; sl = j & 3; nsteps = 1; cid0 = 516 + s; }
  const int dv0 = sl * 32;
  u16* sST = (u16*)smem;
  u16* sVT = sST + 32 * 136;
  u16* sO = sVT + 32 * 72;
  const u16* R1g = (const u16*)((const unsigned char*)p.out);
  const u16* R2g = (const u16*)(p.ws + OFF_QK);
  const float* EGL = (const float*)(p.ws + OFF_EGL);
  const long slot0 = item_slot(cid0, h);
  const int rowbase = is_prompt ? s * TP : ROWS_P + s * 64;
  u16* ymix = (u16*)(p.ws + OFF_YMIX);

  f32x4 accS[2];
#pragma unroll
  for (int nb = 0; nb < 2; ++nb) {
    if (is_prompt) { accS[nb][0] = 0.f; accS[nb][1] = 0.f; accS[nb][2] = 0.f; accS[nb][3] = 0.f; }
    else {
      const float4 v = *reinterpret_cast<const float4*>(p.sdel + ((long)(layer * 8 + s) * 8 + h) * 16384 + (wv * 16 + fr) * 128 + dv0 + nb * 16 + fq * 4);
      accS[nb][0] = v.x; accS[nb][1] = v.y; accS[nb][2] = v.z; accS[nb][3] = v.w;
    }
#pragma unroll
    for (int r = 0; r < 4; ++r) sST[(nb * 16 + fq * 4 + r) * 136 + wv * 16 + fr] = f2bf(accS[nb][r]);
  }
  __syncthreads();
  const int part = wv >> 2;
  const int ib = wv & 3;
  int zoff;
  asm volatile("v_mov_b32 %0, 0" : "=v"(zoff));
#define LDS_BAR() asm volatile("s_waitcnt lgkmcnt(0)\n\ts_barrier" ::: "memory")
#define SCAN_LOAD(IT, F, G, KPF, UU0, UU1, EG) do { \
    const u16* R1p = R1g + (IT) * 24576; const u16* R2p = R2g + (IT) * 12288; \
    _Pragma("unroll") for (int kk = 0; kk < 2; ++kk) \
      KPF[kk] = *reinterpret_cast<const bf16x8*>(R1p + 16384 + (wv * 16 + fr) * 64 + kk * 32 + fq * 8); \
    EG = EGL[(IT) + zoff]; \
    { const u16* Fp = R1p + part * 8192;     \
      _Pragma("unroll") for (int kk = 0; kk < 4; ++kk) \
        F[kk] = *reinterpret_cast<const bf16x8*>(Fp + (ib * 16 + fr) * 128 + kk * 32 + fq * 8); } \
    if (part == 0) { \
      UU0 = *reinterpret_cast<const uint2*>(R2p + (dv0 + fr) * 64 + ib * 16 + fq * 4); \
      UU1 = *reinterpret_cast<const uint2*>(R2p + (dv0 + 16 + fr) * 64 + ib * 16 + fq * 4); \
    } else { \
      _Pragma("unroll") for (int kk = 0; kk < 2; ++kk) \
        G[kk] = *reinterpret_cast<const bf16x8*>(R2p + 8192 + (ib * 16 + fr) * 64 + kk * 32 + fq * 8); } } while (0)
#define SCAN_FLUSH(PROW0, PNV) do { \
    if (tid < 256) { const int i_ = tid >> 2, sg_ = tid & 3; \
      if (i_ < (PNV)) *reinterpret_cast<uint4*>(ymix + (long)((PROW0) + i_) * DM + 1024 + h * 128 + dv0 + sg_ * 8) = \
          *reinterpret_cast<const uint4*>(sO + i_ * 40 + sg_ * 8); } } while (0)
#define SCAN_STEP(STEP, F, G, KPF, UU0, UU1, EGLV, FN, GN, KPFN, UU0N, UU1N, EGLN) do { \
    const int row0 = (is_prompt && (STEP) > 0) ? rowbase + 16 + ((STEP) - 1) * 64 : rowbase; \
    const int nvalid = (is_prompt && (STEP) == 0) ? 16 : 64; \
    { const long itn = slot0 + min((STEP) + 2, nsteps - 1); \
      SCAN_LOAD(itn, FN, GN, KPFN, UU0N, UU1N, EGLN); } \
    if ((STEP) > 0) SCAN_FLUSH(prow0, pnv); \
    f32x4 c0 = {0.f, 0.f, 0.f, 0.f}, c1 = {0.f, 0.f, 0.f, 0.f}; \
    _Pragma("unroll") for (int kk = 0; kk < 4; ++kk) { \
      c0 = mfma16(F[kk], ldfrag(sST, 136, fr, kk * 32 + fq * 8), c0); \
      c1 = mfma16(F[kk], ldfrag(sST, 136, 16 + fr, kk * 32 + fq * 8), c1); } \
    if (part == 0) { \
      float u0[4], u1[4]; \
      unpack4(UU0, u0); unpack4(UU1, u1); \
      *reinterpret_cast<uint2*>(sVT + fr * 72 + ib * 16 + fq * 4) = pack4(u0[0] - c0[0], u0[1] - c0[1], u0[2] - c0[2], u0[3] - c0[3]); \
      *reinterpret_cast<uint2*>(sVT + (16 + fr) * 72 + ib * 16 + fq * 4) = pack4(u1[0] - c1[0], u1[1] - c1[1], u1[2] - c1[2], u1[3] - c1[3]); } \
    LDS_BAR(); \
    _Pragma("unroll") for (int nb = 0; nb < 2; ++nb) { \
      f32x4 c = accS[nb]; \
      c[0] *= EGLV; c[1] *= EGLV; c[2] *= EGLV; c[3] *= EGLV; \
      _Pragma("unroll") for (int kk = 0; kk < 2; ++kk) \
        c = mfma16(ldfrag(sVT, 72, nb * 16 + fr, kk * 32 + fq * 8), KPF[kk], c); \
      accS[nb] = c; \
      _Pragma("unroll") for (int r = 0; r < 4; ++r) sST[(nb * 16 + fq * 4 + r) * 136 + wv * 16 + fr] = f2bf(c[r]); } \
    if (part == 1) { \
      _Pragma("unroll") for (int kk = 0; kk < 2; ++kk) { \
        c0 = mfma16(G[kk], ldfrag(sVT, 72, fr, kk * 32 + fq * 8), c0); \
        c1 = mfma16(G[kk], ldfrag(sVT, 72, 16 + fr, kk * 32 + fq * 8), c1); } \
      _Pragma("unroll") for (int r = 0; r < 4; ++r) { \
        sO[(ib * 16 + fq * 4 + r) * 40 + fr] = f2bf(c0[r]); \
        sO[(ib * 16 + fq * 4 + r) * 40 + 16 + fr] = f2bf(c1[r]); } } \
    LDS_BAR(); \
    prow0 = row0; pnv = nvalid; } while (0)
  bf16x8 fA[4], gA[2], kpfA[2]; uint2 u0A, u1A; float eglA;
  bf16x8 fB[4], gB[2], kpfB[2]; uint2 u0B, u1B; float eglB;
  bf16x8 fC[4], gC[2], kpfC[2]; uint2 u0C, u1C; float eglC;
  int prow0 = 0, pnv = 0;
  SCAN_LOAD(slot0, fA, gA, kpfA, u0A, u1A, eglA);
  SCAN_LOAD(slot0 + min(1, nsteps - 1), fB, gB, kpfB, u0B, u1B, eglB);
  for (int step = 0; step < nsteps; step += 3) {
    SCAN_STEP(step, fA, gA, kpfA, u0A, u1A, eglA, fC, gC, kpfC, u0C, u1C, eglC);
    if (step + 1 < nsteps) SCAN_STEP(step + 1, fB, gB, kpfB, u0B, u1B, eglB, fA, gA, kpfA, u0A, u1A, eglA);
    if (step + 2 < nsteps) SCAN_STEP(step + 2, fC, gC, kpfC, u0C, u1C, eglC, fB, gB, kpfB, u0B, u1B, eglB);
  }
  SCAN_FLUSH(prow0, pnv);
#undef SCAN_STEP
#undef SCAN_FLUSH
#undef SCAN_LOAD
  float* dst = p.out + (is_prompt ? PD_OFF + ((long)(layer * 4 + s) * 8 + h) * 16384 : SD_OFF + ((long)(layer * 8 + s) * 8 + h) * 16384);
#pragma unroll
  for (int nb = 0; nb < 2; ++nb)
    *reinterpret_cast<float4*>(dst + (wv * 16 + fr) * 128 + dv0 + nb * 16 + fq * 4) = make_float4(accS[nb][0], accS[nb][1], accS[nb][2], accS[nb][3]);
  __syncthreads();
}

constexpr int NUNIT = 4 * 513 + 32;
__device__ __forceinline__ void mixer_a_group(const Params& p, int layer, int ug) {
  const int tid = opaque_tid() & 511;
  const int uid = ug * 4 + (tid >> 7);
  if (uid >= NUNIT) return;
  const int c0 = (tid & 127) * 8;
  int row0, sidx; bool first, last, samp;
  if (uid < 2052) { sidx = uid / 513; const int k = uid - sidx * 513; row0 = sidx * TP + 16 * k; first = (k == 0); last = (k == 512); samp = false; }
  else { const int v = uid - 2052; sidx = v >> 2; const int k = v & 3; row0 = ROWS_P + sidx * 64 + 16 * k; first = (k == 0); last = (k == 3); samp = true; }
  const u16* proj = (const u16*)(p.ws + OFF_PROJ);
  u16* ymix = (u16*)(p.ws + OFF_YMIX);
  float w0[8], w1[8], w2[8], um2[8], um1[8];
  {
    const float* cw = p.cvaw + (long)layer * 3 * 1024 + c0;
#pragma unroll
    for (int e = 0; e < 8; ++e) { w0[e] = cw[e]; w1[e] = cw[1024 + e]; w2[e] = cw[2048 + e]; }
  }
  if (first) {
    if (samp) {
      const float* st = p.sca + (long)(layer * 8 + sidx) * 2 * 1024 + c0;
#pragma unroll
      for (int e = 0; e < 8; ++e) { um2[e] = st[e]; um1[e] = st[1024 + e]; }
    } else {
#pragma unroll
      for (int e = 0; e < 8; ++e) { um2[e] = 0.f; um1[e] = 0.f; }
    }
  } else {
    float c[8], x[8];
    unpack8(*reinterpret_cast<const uint4*>(proj + (long)(row0 - 2) * NP + 1024 + c0), c);
    unpack8(*reinterpret_cast<const uint4*>(proj + (long)(row0 - 2) * NP + 2048 + c0), x);
#pragma unroll
    for (int e = 0; e < 8; ++e) um2[e] = c[e] * x[e];
    unpack8(*reinterpret_cast<const uint4*>(proj + (long)(row0 - 1) * NP + 1024 + c0), c);
    unpack8(*reinterpret_cast<const uint4*>(proj + (long)(row0 - 1) * NP + 2048 + c0), x);
#pragma unroll
    for (int e = 0; e < 8; ++e) um1[e] = c[e] * x[e];
  }
  for (int t0 = 0; t0 < 16; t0 += 4) {
    uint4 rbv[4], rcv[4], rxv[4], rzv[4];
#pragma unroll
    for (int q = 0; q < 4; ++q) {
      const long rb = (long)(row0 + t0 + q) * NP + c0;
      rbv[q] = *reinterpret_cast<const uint4*>(proj + rb);
      rcv[q] = *reinterpret_cast<const uint4*>(proj + rb + 1024);
      rxv[q] = *reinterpret_cast<const uint4*>(proj + rb + 2048);
      rzv[q] = *reinterpret_cast<const uint4*>(proj + rb + 3072);
    }
#pragma unroll
    for (int q = 0; q < 4; ++q) {
      float b[8], c[8], x[8], z[8], y[8];
      unpack8(rbv[q], b); unpack8(rcv[q], c); unpack8(rxv[q], x); unpack8(rzv[q], z);
#pragma unroll
      for (int e = 0; e < 8; ++e) {
        const float u = c[e] * x[e];
        const float cv = w0[e] * um2[e] + w1[e] * um1[e] + w2[e] * u;
        y[e] = b[e] * cv * silu_f(z[e]);
        um2[e] = um1[e]; um1[e] = u;
      }
      uint4 o;
      o.x = pack2(y[0], y[1]); o.y = pack2(y[2], y[3]); o.z = pack2(y[4], y[5]); o.w = pack2(y[6], y[7]);
      *reinterpret_cast<uint4*>(ymix + (long)(row0 + t0 + q) * DM + c0) = o;
    }
  }
  if (last) {
    float* dst = p.out + (samp ? SCA_OFF + (long)(layer * 8 + sidx) * 2 * 1024 : PCA_OFF + (long)(layer * 4 + sidx) * 2 * 1024) + c0;
#pragma unroll
    for (int e = 0; e < 8; ++e) { dst[e] = um2[e]; dst[1024 + e] = um1[e]; }
  }
}

__device__ __forceinline__ void phase_post(const Params& p, int layer) {
  const int tid = opaque_tid() & 511;
  const u16* proj = (const u16*)(p.ws + OFF_PROJ);
  u16* ymix = (u16*)(p.ws + OFF_YMIX);
  const int hh = (tid >> 4) & 7, d = (tid & 15) * 8;
  float w[8];
#pragma unroll
  for (int e = 0; e < 8; ++e) w[e] = p.onw[layer * 128 + d + e];
  for (int g = blockIdx.x; g < ROWS / 4; g += gridDim.x) {
    const int row = g * 4 + (tid >> 7);
    u16* op = ymix + (long)row * DM + 1024 + hh * 128 + d;
    float o[8], z[8];
    unpack8(*reinterpret_cast<const uint4*>(op), o);
    unpack8(*reinterpret_cast<const uint4*>(proj + (long)row * NP + 7168 + hh * 128 + d), z);
    float ss = 0.f;
#pragma unroll
    for (int e = 0; e < 8; ++e) ss += o[e] * o[e];
    ss += __shfl_xor(ss, 1); ss += __shfl_xor(ss, 2); ss += __shfl_xor(ss, 4); ss += __shfl_xor(ss, 8);
    const float rs = rsqrtf(ss * (1.f / 128.f) + EPS);
    float y[8];
#pragma unroll
    for (int e = 0; e < 8; ++e) y[e] = o[e] * rs * w[e] * silu_f(z[e]);
    uint4 ov;
    ov.x = pack2(y[0], y[1]); ov.y = pack2(y[2], y[3]); ov.z = pack2(y[4], y[5]); ov.w = pack2(y[6], y[7]);
    *reinterpret_cast<uint4*>(op) = ov;
  }
}

__device__ __forceinline__ void phase_final(const Params& p) {
  const int tid = opaque_tid() & 511, wv = tid >> 6, lane = tid & 63;
  const float* sumsq = (const float*)(p.ws + OFF_SUMSQ) + 2L * ROWSP;
  for (int r = blockIdx.x * 8 + wv; r < ROWS; r += gridDim.x * 8) {
    float* dst;
    if (r < ROWS_P) {
      const int b = r / TP, t = r - b * TP;
      if (t < 16) continue;
      dst = p.out + ((long)b * 8192 + (t - 16)) * DM;
    } else {
      dst = p.out + YS_OFF + (long)(r - ROWS_P) * DM;
    }
    const float rs = rsqrtf(sumsq[r] * (1.f / DM) + EPS);
#pragma unroll
    for (int i = 0; i < 8; ++i) {
      const int c = (i * 64 + lane) * 4;
      float4 v = *reinterpret_cast<const float4*>(dst + c);
      const float4 w = *reinterpret_cast<const float4*>(p.fnw + c);
      v.x *= rs * w.x; v.y *= rs * w.y; v.z *= rs * w.z; v.w *= rs * w.w;
      *reinterpret_cast<float4*>(dst + c) = v;
    }
  }
}

typedef const __attribute__((address_space(4))) Params* CParamsPtr;
__device__ __forceinline__ Params ldparams(CParamsPtr q) {
#if defined(__HIP_DEVICE_COMPILE__)
  asm volatile("" : "+s"(q));
  Params r;
  r.xp = q->xp; r.xs = q->xs; r.sca = q->sca; r.scq = q->scq; r.sdel = q->sdel; r.meta = q->meta; r.normw = q->normw; r.win = q->win;
  r.cvaw = q->cvaw; r.cvqw = q->cvqw; r.alog = q->alog; r.dtb = q->dtb; r.onw = q->onw; r.wout = q->wout; r.fnw = q->fnw;
  r.out = q->out; r.ws = q->ws;
  return r;
#else
  return Params{};
#endif
}

__global__ void __launch_bounds__(512) mega(Params p_unused) {
  extern __shared__ __attribute__((aligned(16))) unsigned char smem[];
  cg::grid_group grid = cg::this_grid();
  CParamsPtr kp = (CParamsPtr)__builtin_amdgcn_kernarg_segment_ptr();
  { const Params p = ldparams(kp); phase_prep(p, smem); }
  grid.sync();
  for (int layer = 0; layer < 2; ++layer) {
    { const Params p = ldparams(kp); gemm_phase<1>(p, layer, smem); }
    grid.sync();
    { const Params p = ldparams(kp); for (int item = blockIdx.x; item < NITEM; item += gridDim.x) chunk_prep(p, layer, item, smem); }
    grid.sync();
    {
      const Params p = ldparams(kp);
      const int G = gridDim.x, b = blockIdx.x;
      if (G >= 256) {
        if (b < 128) gdn_scan(p, layer, (((b & 7) + 8 * (b >> 5)) << 2) + ((b >> 3) & 3), smem);
        else {
          if (b < 256) { gdn_scan(p, layer, b, smem); gdn_scan(p, layer, b + 128, smem); }
          for (int ug = b - 128; ug < (NUNIT + 3) / 4; ug += G - 128) mixer_a_group(p, layer, ug);
        }
      } else {
        for (int w = b; w < 384; w += G) gdn_scan(p, layer, w, smem);
        for (int ug = b; ug < (NUNIT + 3) / 4; ug += G) mixer_a_group(p, layer, ug);
      }
    }
    grid.sync();
    { const Params p = ldparams(kp); phase_post(p, layer); }
    grid.sync();
    { const Params p = ldparams(kp); if (layer == 0) gemm_phase<2>(p, layer, smem); else gemm_phase<3>(p, layer, smem); }
    grid.sync();
  }
  { const Params p = ldparams(kp); phase_final(p); }
}

extern "C" void kernel_launch(void* const* d_in, const int* in_sizes, int n_in,
                              void* d_out, int out_size, void* d_ws, size_t ws_size,
                              hipStream_t stream) {
  constexpr size_t kLds = 131072;
  static int grid_blocks = 0;
  if (!grid_blocks) {
    int dev = 0, cus = 0, per_cu = 0;
    (void)hipGetDevice(&dev);
    (void)hipDeviceGetAttribute(&cus, hipDeviceAttributeMultiprocessorCount, dev);
    (void)hipFuncSetAttribute((const void*)mega, hipFuncAttributeMaxDynamicSharedMemorySize, (int)kLds);
    (void)hipOccupancyMaxActiveBlocksPerMultiprocessor(&per_cu, (const void*)mega, 512, kLds);
    if (per_cu < 1) per_cu = 1;
    grid_blocks = cus * per_cu;
    if (ws_size < (size_t)WS_END) fprintf(stderr, "workspace too small: %zu < %ld\n", ws_size, WS_END);
  }
  Params p{};
  p.xp = (const float*)d_in[0]; p.xs = (const float*)d_in[1]; p.sca = (const float*)d_in[2]; p.scq = (const float*)d_in[3];
  p.sdel = (const float*)d_in[4]; p.meta = (const float*)d_in[5]; p.normw = (const float*)d_in[6]; p.win = (const float*)d_in[7];
  p.cvaw = (const float*)d_in[8]; p.cvqw = (const float*)d_in[9]; p.alog = (const float*)d_in[10]; p.dtb = (const float*)d_in[11];
  p.onw = (const float*)d_in[12]; p.wout = (const float*)d_in[13]; p.fnw = (const float*)d_in[14];
  p.out = (float*)d_out; p.ws = (unsigned char*)d_ws;
  void* args[] = {&p};
  hipError_t e = hipLaunchCooperativeKernel((void*)mega, dim3(grid_blocks), dim3(512), args, kLds, stream);
  if (e != hipSuccess) fprintf(stderr, "cooperative launch failed: %s (grid %d)\n", hipGetErrorString(e), grid_blocks);
}
```

```cpp
#include <hip/hip_runtime.h>
#include <hip/hip_bf16.h>
#include <hip/hip_cooperative_groups.h>
#include <cstdio>
namespace cg = cooperative_groups;

typedef unsigned short u16;
using bf16x8 = __attribute__((ext_vector_type(8))) short;
using f32x4 = __attribute__((ext_vector_type(4))) float;

constexpr int DM = 2048;
constexpr int NP = 8208;
constexpr int NPP = 8448;
constexpr int TP = 8208;
constexpr int ROWS_P = 4 * TP;
constexpr int ROWS = ROWS_P + 512;
constexpr int ROWSP = 33536;
constexpr int NCHUNK = 524;
constexpr int NITEM = NCHUNK * 8;
constexpr float EPS = 1e-6f;

constexpr long OFF_WTIN = 0;
constexpr long OFF_WTOUT = OFF_WTIN + 2L * NPP * DM * 2;
constexpr long OFF_HB = OFF_WTOUT + 2L * DM * DM * 2;
constexpr long OFF_PROJ = OFF_HB + (long)ROWSP * DM * 2;
constexpr long OFF_YMIX = OFF_PROJ + (long)ROWS * NP * 2;
constexpr long OFF_SUMSQ = OFF_YMIX + (long)ROWSP * DM * 2;
constexpr long OFF_EGL = OFF_SUMSQ + 3L * ROWSP * 4;
constexpr long OFF_QK = OFF_EGL + 16896;
constexpr long OFF_UT = OFF_QK + (long)NITEM * 4096 * 2;
constexpr long WS_END = OFF_UT + (long)NITEM * 8192 * 2;
constexpr long OOFF_W = 0;
constexpr long OOFF_QG = OOFF_W + (long)NITEM * 8192 * 2;
constexpr long OOFF_KPT = OOFF_QG + (long)NITEM * 8192 * 2;
constexpr long YS_OFF = 67108864L;
constexpr long PCA_OFF = YS_OFF + 1048576L;
constexpr long PCQ_OFF = PCA_OFF + 16384L;
constexpr long PD_OFF = PCQ_OFF + 73728L;
constexpr long SCA_OFF = PD_OFF + 1048576L;
constexpr long SCQ_OFF = SCA_OFF + 32768L;
constexpr long SD_OFF = SCQ_OFF + 147456L;

struct Params {
  const float *xp, *xs, *sca, *scq, *sdel, *meta, *normw, *win, *cvaw, *cvqw, *alog, *dtb, *onw, *wout, *fnw;
  float* out;
  unsigned char* ws;
};

typedef __bf16 bf16x2_t __attribute__((ext_vector_type(2)));
typedef float f32x2_t __attribute__((ext_vector_type(2)));
__device__ __forceinline__ unsigned pack2(float a, float b) {
#if defined(__HIP_DEVICE_COMPILE__)
  f32x2_t v = {a, b};
  return __builtin_bit_cast(unsigned, __builtin_convertvector(v, bf16x2_t));
#else
  return 0u;
#endif
}
__device__ __forceinline__ u16 f2bf(float f) { return (u16)(pack2(f, 0.f) & 0xffffu); }
__device__ __forceinline__ int opaque_tid() { int t; asm volatile("v_mov_b32 %0, %1" : "=v"(t) : "v"((int)threadIdx.x)); return t; }
__device__ __forceinline__ float bf2f(u16 h) { return __uint_as_float(((unsigned)h) << 16); }
__device__ __forceinline__ uint2 pack4(float a, float b, float c, float d) { return make_uint2(pack2(a, b), pack2(c, d)); }
__device__ __forceinline__ void unpack4(uint2 v, float* o) {
  o[0] = __uint_as_float(v.x << 16); o[1] = __uint_as_float(v.x & 0xffff0000u);
  o[2] = __uint_as_float(v.y << 16); o[3] = __uint_as_float(v.y & 0xffff0000u);
}
__device__ __forceinline__ void unpack8(uint4 v, float* o) {
  o[0] = __uint_as_float(v.x << 16); o[1] = __uint_as_float(v.x & 0xffff0000u);
  o[2] = __uint_as_float(v.y << 16); o[3] = __uint_as_float(v.y & 0xffff0000u);
  o[4] = __uint_as_float(v.z << 16); o[5] = __uint_as_float(v.z & 0xffff0000u);
  o[6] = __uint_as_float(v.w << 16); o[7] = __uint_as_float(v.w & 0xffff0000u);
}
__device__ __forceinline__ float silu_f(float x) { return x * __frcp_rn(1.f + __expf(-x)); }
__device__ __forceinline__ f32x4 mfma16(bf16x8 a, bf16x8 b, f32x4 c) {
  return __builtin_amdgcn_mfma_f32_16x16x32_bf16(a, b, c, 0, 0, 0);
}
__device__ __forceinline__ bf16x8 ldfrag(const u16* base, int stride, int row, int k) {
  return *reinterpret_cast<const bf16x8*>(base + row * stride + k);
}

__device__ __forceinline__ void l2_touch(const void* ptr) {
  (void)ptr;
}
__device__ __forceinline__ unsigned touch_ld(const void* ptr) { return *reinterpret_cast<const unsigned*>(ptr); }
__device__ __forceinline__ void touch_use(unsigned& acc, unsigned v) { asm volatile("v_add_u32 %0, %0, %1" : "+v"(acc) : "v"(v)); }

__device__ __forceinline__ f32x4 mm16(const float* X, int xr, int xc, const float* Y, int yr, int yc, int kn, int fr, int fq) {
  f32x4 c = {0.f, 0.f, 0.f, 0.f};
  for (int k0 = 0; k0 < kn; k0 += 4) {
    const float a = X[(xr + fr) * 68 + xc + k0 + fq];
    const float b = Y[(yr + k0 + fq) * 68 + yc + fr];
    c = __builtin_amdgcn_mfma_f32_16x16x4f32(a, b, c, 0, 0, 0);
  }
  return c;
}

__device__ __forceinline__ void transpose_tiles(const float* __restrict__ src, u16* __restrict__ dst, const float* __restrict__ scale,
                                                int nsrc, int ntile_n, unsigned char* smem) {
  float* tile = (float*)smem;
  const int tid = opaque_tid();
  const int ntiles = 32 * ntile_n;
  for (int t = blockIdx.x; t < ntiles; t += gridDim.x) {
    const int kt = t & 31, nt = t >> 5;
    const int k0 = kt * 64, n0 = nt * 64;
    {
      const int nl = tid & 63, kb = tid >> 6;
#pragma unroll
      for (int it = 0; it < 8; ++it) {
        const int kl = kb + it * 8;
        const int n = n0 + nl;
        float v = 0.f;
        if (n < nsrc) v = src[(long)(k0 + kl) * nsrc + n] * (scale ? scale[k0 + kl] : 1.f);
        tile[kl * 65 + nl] = v;
      }
    }
    __syncthreads();
    {
      const int nl = tid >> 3, kg = tid & 7;
      float v[8];
#pragma unroll
      for (int e = 0; e < 8; ++e) v[e] = tile[(kg * 8 + e) * 65 + nl];
      uint4 o;
      o.x = pack2(v[0], v[1]); o.y = pack2(v[2], v[3]); o.z = pack2(v[4], v[5]); o.w = pack2(v[6], v[7]);
      *reinterpret_cast<uint4*>(dst + (long)(n0 + nl) * DM + k0 + kg * 8) = o;
    }
    __syncthreads();
  }
}

__device__ __forceinline__ void phase_prep(const Params& p, unsigned char* smem) {
  const int tid = opaque_tid(), wv = tid >> 6, lane = tid & 63;
  u16* hb = (u16*)(p.ws + OFF_HB);
  float* sumsq = (float*)(p.ws + OFF_SUMSQ);
  for (int r = blockIdx.x * 8 + wv; r < ROWSP; r += gridDim.x * 8) {
    const float* src = nullptr;
    if (r < ROWS_P) {
      const int b = r / TP, t = r - b * TP;
      src = (t < 16) ? (p.meta + (long)t * DM) : (p.xp + ((long)b * 8192 + (t - 16)) * DM);
    } else if (r < ROWS) {
      src = p.xs + (long)(r - ROWS_P) * DM;
    }
    float ss = 0.f;
#pragma unroll
    for (int i = 0; i < 8; ++i) {
      const int c = (i * 64 + lane) * 4;
      float4 v = make_float4(0.f, 0.f, 0.f, 0.f);
      if (src) v = *reinterpret_cast<const float4*>(src + c);
      ss += v.x * v.x + v.y * v.y + v.z * v.z + v.w * v.w;
      *reinterpret_cast<uint2*>(hb + (long)r * DM + c) = pack4(v.x, v.y, v.z, v.w);
    }
#pragma unroll
    for (int o = 32; o > 0; o >>= 1) ss += __shfl_xor(ss, o);
    if (lane == 0) sumsq[r] = ss;
  }
  for (long i = (long)blockIdx.x * 512 + tid; i < 2L * ROWSP; i += (long)gridDim.x * 512) sumsq[ROWSP + i] = 0.f;
  for (int l = 0; l < 2; ++l) {
    transpose_tiles(p.win + (long)l * DM * NP, (u16*)(p.ws + OFF_WTIN) + (long)l * NPP * DM, p.normw + l * DM, NP, NPP / 64, smem);
    transpose_tiles(p.wout + (long)l * DM * DM, (u16*)(p.ws + OFF_WTOUT) + (long)l * DM * DM, nullptr, DM, DM / 64, smem);
  }
}

constexpr int BM = 256, BK = 64, HALF = 128, HT = HALF * BK;

__device__ __forceinline__ int lds_byte(int r, int c) {
  int st = (r >> 4) * 2 + (c >> 5), rr = r & 15, cc = c & 31, ob = rr * 64 + cc * 2;
  return st * 1024 + (ob ^ (((ob >> 9) & 1) << 5));
}
__device__ __forceinline__ void stage_rc(int b, int& R, int& C) {
  int st = b / 1024, sb = b % 1024, swz = sb ^ (((sb >> 9) & 1) << 5);
  R = (st >> 1) * 16 + swz / 64; C = (st & 1) * 32 + (swz % 64) / 2;
}

template <int EPI>
__device__ __forceinline__ void gemm_phase(const Params& p, int layer, unsigned char* smem) {
  typedef __hip_bfloat16 bf16;
  bf16* shm = (bf16*)smem;
  const bf16* A = (const bf16*)(p.ws + (EPI == 1 ? OFF_HB : OFF_YMIX));
  const bf16* Bt = (EPI == 1) ? (const bf16*)(p.ws + OFF_WTIN) + (long)layer * NPP * DM
                              : (const bf16*)(p.ws + OFF_WTOUT) + (long)layer * DM * DM;
  constexpr int K = DM;
  constexpr int nM = ROWSP / BM;
  constexpr int nN = (EPI == 1) ? NPP / BM : DM / BM;
  constexpr int WGM = 4;
  constexpr int nwg = nM * nN;
#define SA(b, h) (shm + ((b) * 2 + (h)) * HT)
#define SB(b, h) (shm + (4 + (b) * 2 + (h)) * HT)
#define OA(b, h) ((((b) * 2 + (h)) * HT) * 2)
#define OB(b, h) (((4 + (b) * 2 + (h)) * HT) * 2)
#define STAGE(PO, BASE, br, kt) do { const char* _ub = (const char*)(BASE) + ((long)(br) * K + (long)(kt) * BK) * 2; \
      asm volatile("s_add_u32 m0, %0, %3\n\ts_nop 0\n\tglobal_load_lds_dwordx4 %1, %2" :: "s"(ldsw), "v"(soff0), "s"(_ub), "n"(PO) : "memory", "scc"); \
      asm volatile("s_add_u32 m0, %0, %3\n\ts_nop 0\n\tglobal_load_lds_dwordx4 %1, %2" :: "s"(ldsw), "v"(soff1), "s"(_ub), "n"((PO) + 8192) : "memory", "scc"); } while (0)
#define LDA(dst, b, h) for (int m = 0; m < 4; ++m) for (int k = 0; k < 2; ++k) \
    dst[m][k] = *reinterpret_cast<const bf16x8*>((char*)SA(b, h) + lds_byte(wr * 64 + m * 16 + fr, k * 32 + fq * 8))
#define LDB(dst, b, h) for (int n = 0; n < 2; ++n) for (int k = 0; k < 2; ++k) \
    dst[n][k] = *reinterpret_cast<const bf16x8*>((char*)SB(b, h) + lds_byte(wc * 32 + n * 16 + fr, k * 32 + fq * 8))
#define MMA(ai, bj, At, Bt_) do { __builtin_amdgcn_s_setprio(1); \
    for (int m = 0; m < 4; ++m) for (int n = 0; n < 2; ++n) for (int k = 0; k < 2; ++k) \
      acc[ai][bj][m][n] = __builtin_amdgcn_mfma_f32_16x16x32_bf16(At[m][k], Bt_[n][k], acc[ai][bj][m][n], 0, 0, 0); \
    __builtin_amdgcn_s_setprio(0); } while (0)
#define WAIT_V(n) asm volatile("s_waitcnt vmcnt(" #n ")" ::: "memory")
#define WAIT_L(n) asm volatile("s_waitcnt lgkmcnt(" #n ")" ::: "memory")
#define BAR __builtin_amdgcn_s_barrier()
#define SCHED __builtin_amdgcn_sched_barrier(0)

  const int gtid = opaque_tid() & 511;
  const int wid = __builtin_amdgcn_readfirstlane(gtid >> 6), lane = gtid & 63, wr = wid >> 2, wc = wid & 3, fr = lane & 15, fq = lane >> 4;
  unsigned soff0, soff1;
  { int _r, _c; stage_rc(gtid * 16, _r, _c); soff0 = (unsigned)(_r * K + _c) * 2u;
    stage_rc(gtid * 16 + 8192, _r, _c); soff1 = (unsigned)(_r * K + _c) * 2u; }
  const unsigned ldsw = (unsigned)(size_t)((__attribute__((address_space(3))) unsigned char*)smem) + (unsigned)wid * 1024u;
  int gdim = (int)gridDim.x;
  asm volatile("" : "+s"(gdim));
  int vb = blockIdx.x;
  if ((gdim & 7) == 0) vb = (blockIdx.x & 7) * (gdim >> 3) + (blockIdx.x >> 3);
  constexpr int nig = WGM * nN;
#define TILE_RC(wg, BR, BC) do { const int gid_ = (wg) / nig, fm_ = gid_ * WGM, gsz_ = min(nM - fm_, WGM); \
    BC = (fm_ + (((wg) % nig) % gsz_)) * BM; BR = (((wg) % nig) / gsz_) * BM; } while (0)
  int brow = 0, bcol = 0;
  if (vb < nwg) {
    TILE_RC(vb, brow, bcol);
    STAGE(OB(0, 0), A, bcol, 0); STAGE(OA(0, 0), Bt, brow, 0);
    STAGE(OB(0, 1), A, bcol + HALF, 0); STAGE(OA(0, 1), Bt, brow + HALF, 0);
  }
  for (int wgid = vb; wgid < nwg; wgid += gdim) {
    f32x4 acc[2][2][4][2] = {};
    bf16x8 At[4][2], B0[2][2], B1[2][2];
    constexpr int nt = K / BK;
    if (wr == 1) BAR;
    WAIT_V(4); BAR;
    STAGE(OB(1, 0), A, bcol, 1); STAGE(OA(1, 0), Bt, brow, 1); STAGE(OB(1, 1), A, bcol + HALF, 1);
    WAIT_V(6); BAR;
    for (int t = 0; t < nt - 2; t += 2) {
      LDB(B0, 0, 0); SCHED; LDA(At, 0, 0); STAGE(OA(1, 1), Bt, brow + HALF, t + 1);
      WAIT_L(8); BAR; WAIT_L(0); MMA(0, 0, At, B0); BAR; SCHED;
      LDB(B1, 0, 1); STAGE(OB(0, 0), A, bcol, t + 2);
      BAR; WAIT_L(0); MMA(0, 1, At, B1); BAR;
      LDA(At, 0, 1); STAGE(OA(0, 0), Bt, brow, t + 2);
      BAR; WAIT_L(0); MMA(1, 0, At, B0); BAR; SCHED;
      STAGE(OB(0, 1), A, bcol + HALF, t + 2);
      WAIT_V(6); BAR; MMA(1, 1, At, B1); BAR;
      LDB(B0, 1, 0); SCHED; LDA(At, 1, 0); STAGE(OA(0, 1), Bt, brow + HALF, t + 2);
      WAIT_L(8); BAR; WAIT_L(0); MMA(0, 0, At, B0); BAR; SCHED;
      LDB(B1, 1, 1); STAGE(OB(1, 0), A, bcol, t + 3);
      BAR; WAIT_L(0); MMA(0, 1, At, B1); BAR;
      LDA(At, 1, 1); STAGE(OA(1, 0), Bt, brow, t + 3);
      BAR; WAIT_L(0); MMA(1, 0, At, B0); BAR; SCHED;
      STAGE(OB(1, 1), A, bcol + HALF, t + 3);
      WAIT_V(6); BAR; MMA(1, 1, At, B1); BAR;
    }
    { LDB(B0, 0, 0); LDA(At, 0, 0); STAGE(OA(1, 1), Bt, brow + HALF, nt - 1);
      BAR; WAIT_L(0); MMA(0, 0, At, B0); BAR;
      LDB(B1, 0, 1); BAR; WAIT_L(0); MMA(0, 1, At, B1); BAR;
      LDA(At, 0, 1); WAIT_V(4); BAR; WAIT_L(0); MMA(1, 0, At, B0); MMA(1, 1, At, B1); BAR; }
    { LDB(B0, 1, 0); LDA(At, 1, 0); WAIT_V(2); BAR; WAIT_L(0); MMA(0, 0, At, B0); BAR;
      LDB(B1, 1, 1); WAIT_V(0); BAR; WAIT_L(0); MMA(0, 1, At, B1); BAR;
      LDA(At, 1, 1); BAR; WAIT_L(0); MMA(1, 0, At, B0); MMA(1, 1, At, B1); BAR; }
    if (wr == 0) BAR;
    const int erow = brow, ecol = bcol;
    if (wgid + gdim < nwg) {
      TILE_RC(wgid + gdim, brow, bcol);
      STAGE(OB(0, 0), A, bcol, 0); STAGE(OA(0, 0), Bt, brow, 0);
      STAGE(OB(0, 1), A, bcol + HALF, 0); STAGE(OA(0, 1), Bt, brow + HALF, 0);
    }
    if (EPI == 1) {
      u16* proj = (u16*)(p.ws + OFF_PROJ);
      const float* sumsq = (const float*)(p.ws + OFF_SUMSQ) + (long)layer * ROWSP;
#pragma unroll
      for (int bj = 0; bj < 2; ++bj)
#pragma unroll
        for (int n = 0; n < 2; ++n) {
          const int tok = ecol + bj * HALF + wc * 32 + n * 16 + fr;
          if (tok < ROWS) {
            const float rs = rsqrtf(sumsq[tok] * (1.f / DM) + EPS);
            u16* prow = proj + (long)tok * NP;
#pragma unroll
            for (int ai = 0; ai < 2; ++ai)
#pragma unroll
              for (int m = 0; m < 4; ++m) {
                const int n0 = erow + ai * HALF + wr * 64 + m * 16 + fq * 4;
                if (n0 < NP)
                  *reinterpret_cast<uint2*>(prow + n0) = pack4(acc[ai][bj][m][n][0] * rs, acc[ai][bj][m][n][1] * rs,
                                                                acc[ai][bj][m][n][2] * rs, acc[ai][bj][m][n][3] * rs);
              }
          }
        }
    } else {
      u16* hb = (u16*)(p.ws + OFF_HB);
      float* sumsq = (float*)(p.ws + OFF_SUMSQ) + (long)(EPI == 2 ? 1 : 2) * ROWSP;
#pragma unroll
      for (int bj = 0; bj < 2; ++bj)
#pragma unroll
        for (int n = 0; n < 2; ++n) {
          const int tok = ecol + bj * HALF + wc * 32 + n * 16 + fr;
          float* dst = nullptr;
          if (EPI == 3) {
            if (tok < ROWS_P) {
              const int b = tok / TP, t = tok - b * TP;
              if (t >= 16) dst = p.out + ((long)b * 8192 + (t - 16)) * DM;
            } else if (tok < ROWS) {
              dst = p.out + YS_OFF + (long)(tok - ROWS_P) * DM;
            }
          }
          u16* hrow = hb + (long)tok * DM;
          float rsum = 0.f;
#pragma unroll
          for (int ai = 0; ai < 2; ++ai)
#pragma unroll
            for (int m = 0; m < 4; ++m) {
              const int n0 = erow + ai * HALF + wr * 64 + m * 16 + fq * 4;
              float r4[4];
              unpack4(*reinterpret_cast<const uint2*>(hrow + n0), r4);
              float v[4];
#pragma unroll
              for (int j = 0; j < 4; ++j) { v[j] = acc[ai][bj][m][n][j] + r4[j]; rsum += v[j] * v[j]; }
              if (EPI == 2) *reinterpret_cast<uint2*>(hrow + n0) = pack4(v[0], v[1], v[2], v[3]);
              else if (dst) *reinterpret_cast<float4*>(dst + n0) = make_float4(v[0], v[1], v[2], v[3]);
            }
          rsum += __shfl_xor(rsum, 16); rsum += __shfl_xor(rsum, 32);
          if (fq == 0) atomicAdd(&sumsq[tok], rsum);
        }
    }
  }
  __syncthreads();
#undef TILE_RC
#undef SA
#undef SB
#undef OA
#undef OB
#undef STAGE
#undef LDA
#undef LDB
#undef MMA
}

__device__ __forceinline__ void chunk_geom(int cid, int& row0, int& nvalid, int& prevmode, int& sidx, bool& lastc) {
  if (cid < 516) {
    const int s = cid / 129, c = cid - s * 129;
    sidx = s; lastc = (c == 128);
    if (c == 0) { row0 = s * TP; nvalid = 16; prevmode = 0; }
    else { row0 = s * TP + 16 + (c - 1) * 64; nvalid = 64; prevmode = 1; }
  } else {
    sidx = cid - 516; row0 = ROWS_P + sidx * 64; nvalid = 64; prevmode = 2; lastc = true;
  }
}

__device__ __forceinline__ long item_slot(int cid, int h) {
  if (cid < 516) { const int s = cid / 129, c = cid - s * 129; return (long)((s * 8 + h) * 129 + c); }
  return (long)(4128 + (cid - 516) * 8 + h);
}

__device__ __forceinline__ void chunk_prep(const Params& p, int layer, int item, unsigned char* smem) {
  const int tid = opaque_tid() & 511, wv = __builtin_amdgcn_readfirstlane(tid >> 6), lane = tid & 63, fr = lane & 15, fq = lane >> 4;
  const int cid = item >> 3, h = item & 7;
  int row0, nvalid, prevmode, sidx; bool lastc;
  chunk_geom(cid, row0, nvalid, prevmode, sidx, lastc);
  u16* sKB = (u16*)smem;
  u16* sK = sKB + 64 * 136;
  u16* sQ = sK + 64 * 136;
  u16* sVBT = sQ + 64 * 136;
  u16* sKBGT = sVBT + 128 * 72;
  u16* sT = sKBGT + 128 * 72;
  float* sA = (float*)(sT + 64 * 72);
  float* sBeta = sA + 64 * 68;
  float* sGc = sBeta + 64;
  float* sTf = (float*)smem;
  float* sY = sTf + 64 * 68;
  int zoff;
  asm volatile("v_mov_b32 %0, 0" : "=v"(zoff));
  const u16* proj = (const u16*)(p.ws + OFF_PROJ);
  const long slot = item_slot(cid, h);
  u16* Wd = (u16*)((unsigned char*)p.out) + slot * 24576;
  u16* QG = Wd + 8192;
  u16* KPT = Wd + 16384;
  u16* UTd = (u16*)(p.ws + OFF_QK) + slot * 12288;
  u16* QKd = UTd + 8192;
  float* EGL = (float*)(p.ws + OFF_EGL);

  unsigned tch = 0;
  {
    const int nitem = item + gridDim.x;
    if (nitem < NITEM) {
      int nrow0, nnv, npm, nsi; bool nl;
      chunk_geom(nitem >> 3, nrow0, nnv, npm, nsi, nl);
      const int nh = nitem & 7;
      if (tid < 402) {
        const int r = tid / 6, m6 = tid - r * 6;
        tch = touch_ld(proj + (long)(nrow0 - 3 + r) * NP + 4096 + (m6 >> 1) * 1024 + nh * 128 + (m6 & 1) * 64);
      } else if (tid >= 448) {
        tch = touch_ld(proj + (long)(nrow0 + (tid - 448)) * NP + 8192 + nh);
      }
    }
  }
  if (wv == 0) {
    float beta = 0.f, g = 0.f;
    if (lane < nvalid) {
      const long rb = (long)(row0 + lane) * NP;
      const float bl = bf2f(proj[rb + 8192 + h]);
      const float al = bf2f(proj[rb + 8200 + h]) + p.dtb[layer * 8 + h];
      beta = 1.f / (1.f + expf(-bl));
      const float sp = (al > 20.f) ? al : log1pf(expf(al));
      g = -expf(p.alog[layer * 8 + h]) * sp;
    }
    float gc = g;
#pragma unroll
    for (int o = 1; o < 64; o <<= 1) { const float t = __shfl_up(gc, o); if (lane >= o) gc += t; }
    sBeta[lane] = beta; sGc[lane] = gc;
  }

  const int rg = tid >> 5, cg = tid & 31, i0 = rg * 4, d0 = cg * 4;
  float qv[4][4], kv[4][4], vv[4][4];
#pragma unroll
  for (int mat = 0; mat < 3; ++mat) {
    const int ch = mat * 1024 + h * 128 + d0;
    const int colbase = 4096 + ch;
    float xr[7][4];
#pragma unroll
    for (int a = 0; a < 7; ++a) {
      const int ri = i0 - 3 + a;
      if (ri >= 0 || prevmode == 1) {
        uint2 raw = *reinterpret_cast<const uint2*>(proj + (long)(row0 + ri) * NP + colbase);
        unpack4(raw, xr[a]);
      } else if (prevmode == 2) {
        const float4 v = *reinterpret_cast<const float4*>(p.scq + ((long)(layer * 8 + sidx) * 3 + (3 + ri)) * 3072 + ch);
        xr[a][0] = v.x; xr[a][1] = v.y; xr[a][2] = v.z; xr[a][3] = v.w;
      } else {
        xr[a][0] = xr[a][1] = xr[a][2] = xr[a][3] = 0.f;
      }
    }
    if (lastc && rg == 15) {
      float* dst = p.out + (prevmode == 2 ? SCQ_OFF + (long)(layer * 8 + sidx) * 3 * 3072 : PCQ_OFF + (long)(layer * 4 + sidx) * 3 * 3072) + ch;
#pragma unroll
      for (int a = 4; a < 7; ++a)
        *reinterpret_cast<float4*>(dst + (a - 4) * 3072) = make_float4(xr[a][0], xr[a][1], xr[a][2], xr[a][3]);
    }
    float cw[4][4];
#pragma unroll
    for (int j = 0; j < 4; ++j) {
      const float4 v = *reinterpret_cast<const float4*>(p.cvqw + (long)(layer * 4 + j) * 3072 + ch);
      cw[j][0] = v.x; cw[j][1] = v.y; cw[j][2] = v.z; cw[j][3] = v.w;
    }
#pragma unroll
    for (int ii = 0; ii < 4; ++ii)
#pragma unroll
      for (int e = 0; e < 4; ++e) {
        float o = 0.f;
#pragma unroll
        for (int j = 0; j < 4; ++j) o += cw[j][e] * xr[ii + j][e];
        o = silu_f(o);
        if (mat == 0) qv[ii][e] = o; else if (mat == 1) kv[ii][e] = o; else vv[ii][e] = o;
      }
  }
#pragma unroll
  for (int ii = 0; ii < 4; ++ii) {
    float sq = 0.f, sk = 0.f;
#pragma unroll
    for (int e = 0; e < 4; ++e) { sq += qv[ii][e] * qv[ii][e]; sk += kv[ii][e] * kv[ii][e]; }
#pragma unroll
    for (int o = 1; o < 32; o <<= 1) { sq += __shfl_xor(sq, o); sk += __shfl_xor(sk, o); }
    const float rq = rsqrtf(sq + EPS) * 0.08838834764831845f, rk = rsqrtf(sk + EPS);
    const bool valid = (i0 + ii) < nvalid;
#pragma unroll
    for (int e = 0; e < 4; ++e) {
      qv[ii][e] = valid ? qv[ii][e] * rq : 0.f;
      kv[ii][e] = valid ? kv[ii][e] * rk : 0.f;
      vv[ii][e] = valid ? vv[ii][e] : 0.f;
    }
  }
  __syncthreads();
  float beta[4], gcv[4];
#pragma unroll
  for (int ii = 0; ii < 4; ++ii) { beta[ii] = sBeta[i0 + ii]; gcv[ii] = sGc[i0 + ii]; }
  const float glast = sGc[63];
  if (tid == 0) EGL[slot] = expf(glast);

#pragma unroll
  for (int ii = 0; ii < 4; ++ii) {
    const int i = i0 + ii;
    const float b = beta[ii], eg = __expf(gcv[ii]);
    *reinterpret_cast<uint2*>(sKB + i * 136 + d0) = pack4(kv[ii][0] * b, kv[ii][1] * b, kv[ii][2] * b, kv[ii][3] * b);
    *reinterpret_cast<uint2*>(sK + i * 136 + d0) = pack4(kv[ii][0], kv[ii][1], kv[ii][2], kv[ii][3]);
    *reinterpret_cast<uint2*>(sQ + i * 136 + d0) = pack4(qv[ii][0], qv[ii][1], qv[ii][2], qv[ii][3]);
    *reinterpret_cast<uint2*>(QG + i * 128 + d0) = pack4(qv[ii][0] * eg, qv[ii][1] * eg, qv[ii][2] * eg, qv[ii][3] * eg);
  }
  {
    float bg[4], kd[4];
#pragma unroll
    for (int ii = 0; ii < 4; ++ii) { bg[ii] = beta[ii] * __expf(gcv[ii]); kd[ii] = __expf(glast - gcv[ii]); }
#pragma unroll
    for (int e = 0; e < 4; ++e) {
      const int d = d0 + e;
      *reinterpret_cast<uint2*>(sVBT + d * 72 + i0) = pack4(vv[0][e] * beta[0], vv[1][e] * beta[1], vv[2][e] * beta[2], vv[3][e] * beta[3]);
      *reinterpret_cast<uint2*>(sKBGT + d * 72 + i0) = pack4(kv[0][e] * bg[0], kv[1][e] * bg[1], kv[2][e] * bg[2], kv[3][e] * bg[3]);
      *reinterpret_cast<uint2*>(KPT + d * 64 + i0) = pack4(kv[0][e] * kd[0], kv[1][e] * kd[1], kv[2][e] * kd[2], kv[3][e] * kd[3]);
    }
  }
  __syncthreads();
  {
    const int ib = wv >> 1;
#pragma unroll
    for (int jj = 0; jj < 2; ++jj) {
      const int jb = (wv & 1) * 2 + jj;
      f32x4 c = {0.f, 0.f, 0.f, 0.f}, c2 = {0.f, 0.f, 0.f, 0.f};
#pragma unroll
      for (int kk = 0; kk < 4; ++kk) {
        const bf16x8 a = ldfrag(sKB, 136, ib * 16 + fr, kk * 32 + fq * 8);
        const bf16x8 b = ldfrag(sK, 136, jb * 16 + fr, kk * 32 + fq * 8);
        c = mfma16(a, b, c);
        const bf16x8 b2 = ldfrag(sQ, 136, ib * 16 + fr, kk * 32 + fq * 8);
        c2 = mfma16(b, b2, c2);
      }
      {
        const int j = jb * 16 + fr;
        const float gj = sGc[j];
#pragma unroll
        for (int r = 0; r < 4; ++r) {
          const int i = ib * 16 + fq * 4 + r;
          sA[i * 68 + j] = (i > j) ? c[r] * __expf(sGc[i] - gj) : 0.f;
        }
      }
      {
        const int i = ib * 16 + fr;
        const float gi = sGc[i];
        float o[4];
#pragma unroll
        for (int r = 0; r < 4; ++r) {
          const int j = jb * 16 + fq * 4 + r;
          o[r] = (i >= j) ? c2[r] * __expf(gi - sGc[j]) : 0.f;
        }
        *reinterpret_cast<uint2*>(QKd + i * 64 + jb * 16 + fq * 4) = pack4(o[0], o[1], o[2], o[3]);
      }
    }
  }
  __syncthreads();
  {
    for (int e = tid; e < 64 * 68; e += 512) sTf[e] = 0.f;
    __syncthreads();
    if (wv < 4 && lane < 16) {
      const float* Ab = sA + (wv * 16) * 68 + wv * 16 + zoff;
      float t[16], ac[16], an[16];
      t[0] = (lane == 0) ? 1.f : 0.f;
      sTf[(wv * 16) * 68 + wv * 16 + lane] = t[0];
      ac[0] = Ab[68];
#pragma unroll
      for (int i = 1; i < 16; ++i) {
        if (i + 1 < 16) {
#pragma unroll
          for (int j = 0; j <= i; ++j) an[j] = Ab[(i + 1) * 68 + j];
        }
        float a = (lane == i) ? 1.f : 0.f;
#pragma unroll
        for (int j = 0; j < i; ++j) a -= ac[j] * t[j];
        t[i] = a;
        sTf[(wv * 16 + i) * 68 + wv * 16 + lane] = a;
        if (i + 1 < 16) {
#pragma unroll
          for (int j = 0; j <= i; ++j) ac[j] = an[j];
        }
        __builtin_amdgcn_sched_barrier(0);
      }
    }
    __syncthreads();
    if (wv < 2) {
      const int o = wv * 32;
      const f32x4 c = mm16(sA, o + 16, o, sTf, o, o, 16, fr, fq);
#pragma unroll
      for (int r = 0; r < 4; ++r) sY[(o + 16 + fq * 4 + r) * 68 + o + fr] = c[r];
    }
    __syncthreads();
    if (wv < 2) {
      const int o = wv * 32;
      const f32x4 c = mm16(sTf, o + 16, o + 16, sY, o + 16, o, 16, fr, fq);
#pragma unroll
      for (int r = 0; r < 4; ++r) sTf[(o + 16 + fq * 4 + r) * 68 + o + fr] = -c[r];
    }
    __syncthreads();
    if (wv < 4) {
      const int bi = wv >> 1, bj = wv & 1;
      const f32x4 c = mm16(sA, 32 + bi * 16, 0, sTf, 0, bj * 16, 32, fr, fq);
#pragma unroll
      for (int r = 0; r < 4; ++r) sY[(32 + bi * 16 + fq * 4 + r) * 68 + bj * 16 + fr] = c[r];
    }
    __syncthreads();
    if (wv < 4) {
      const int bi = wv >> 1, bj = wv & 1;
      const f32x4 c = mm16(sTf, 32 + bi * 16, 32, sY, 32, bj * 16, 32, fr, fq);
#pragma unroll
      for (int r = 0; r < 4; ++r) sTf[(32 + bi * 16 + fq * 4 + r) * 68 + bj * 16 + fr] = -c[r];
    }
    __syncthreads();
    {
      const int i = tid >> 3, j0 = (tid & 7) * 8;
      float v[8];
#pragma unroll
      for (int e = 0; e < 8; ++e) v[e] = sTf[i * 68 + j0 + e];
      uint4 o;
      o.x = pack2(v[0], v[1]); o.y = pack2(v[2], v[3]); o.z = pack2(v[4], v[5]); o.w = pack2(v[6], v[7]);
      *reinterpret_cast<uint4*>(sT + i * 72 + j0) = o;
    }
  }
  __syncthreads();
  {
    const int ib = wv >> 1;
#pragma unroll
    for (int x = 0; x < 4; ++x) {
      const int dvb = (wv & 1) * 4 + x;
      f32x4 c = {0.f, 0.f, 0.f, 0.f};
#pragma unroll
      for (int kk = 0; kk < 2; ++kk)
        c = mfma16(ldfrag(sT, 72, ib * 16 + fr, kk * 32 + fq * 8), ldfrag(sVBT, 72, dvb * 16 + fr, kk * 32 + fq * 8), c);
      *reinterpret_cast<uint2*>(UTd + (dvb * 16 + fr) * 64 + ib * 16 + fq * 4) = pack4(c[0], c[1], c[2], c[3]);
    }
#pragma unroll
    for (int ib2 = 0; ib2 < 4; ++ib2) {
      f32x4 c = {0.f, 0.f, 0.f, 0.f};
#pragma unroll
      for (int kk = 0; kk < 2; ++kk)
        c = mfma16(ldfrag(sKBGT, 72, wv * 16 + fr, kk * 32 + fq * 8), ldfrag(sT, 72, ib2 * 16 + fr, kk * 32 + fq * 8), c);
      *reinterpret_cast<uint2*>(Wd + (ib2 * 16 + fr) * 128 + wv * 16 + fq * 4) = pack4(c[0], c[1], c[2], c[3]);
    }
  }
  __syncthreads();
  {
    unsigned tacc = 0;
    touch_use(tacc, tch);
    if (tacc == 0x9e3779b9u) ((volatile float*)EGL)[NITEM + 9] = 1.f;
  }
}

__device__ __forceinline__ void gdn_scan(const Params& p, int layer, int widx, unsigned char* smem) {
  const int tid = opaque_tid() & 511, wv = __builtin_amdgcn_readfirstlane(tid >> 6), lane = tid & 63, fr = lane & 15, fq = lane >> 4;
  const bool is_prompt = widx < 128;
  int s, h, sl, nsteps, cid0;
  if (is_prompt) { s = widx >> 5; h = (widx >> 2) & 7; sl = widx & 3; nsteps = 129; cid0 = s * 129; }
  else { const int j = widx - 128; s = j >> 5; h = (j >> 2) & 7; sl = j & 3; nsteps = 1; cid0 = 516 + s; }
  const int dv0 = sl * 32;
  u16* sST = (u16*)smem;
  u16* sVT = sST + 32 * 136;
  u16* sO = sVT + 32 * 72;
  const u16* R1g = (const u16*)((const unsigned char*)p.out);
  const u16* R2g = (const u16*)(p.ws + OFF_QK);
  const float* EGL = (const float*)(p.ws + OFF_EGL);
  const long slot0 = item_slot(cid0, h);
  const int rowbase = is_prompt ? s * TP : ROWS_P + s * 64;
  u16* ymix = (u16*)(p.ws + OFF_YMIX);

  f32x4 accS[2];
#pragma unroll
  for (int nb = 0; nb < 2; ++nb) {
    if (is_prompt) { accS[nb][0] = 0.f; accS[nb][1] = 0.f; accS[nb][2] = 0.f; accS[nb][3] = 0.f; }
    else {
      const float4 v = *reinterpret_cast<const float4*>(p.sdel + ((long)(layer * 8 + s) * 8 + h) * 16384 + (wv * 16 + fr) * 128 + dv0 + nb * 16 + fq * 4);
      accS[nb][0] = v.x; accS[nb][1] = v.y; accS[nb][2] = v.z; accS[nb][3] = v.w;
    }
#pragma unroll
    for (int r = 0; r < 4; ++r) sST[(nb * 16 + fq * 4 + r) * 136 + wv * 16 + fr] = f2bf(accS[nb][r]);
  }
  __syncthreads();
  const int part = wv >> 2;
  const int ib = wv & 3;
  int zoff;
  asm volatile("v_mov_b32 %0, 0" : "=v"(zoff));
#define LDS_BAR() asm volatile("s_waitcnt lgkmcnt(0)\n\ts_barrier" ::: "memory")
#define SCAN_LOAD(IT, F, G, KPF, UU0, UU1, EG) do { \
    const u16* R1p = R1g + (IT) * 24576; const u16* R2p = R2g + (IT) * 12288; \
    _Pragma("unroll") for (int kk = 0; kk < 2; ++kk) \
      KPF[kk] = *reinterpret_cast<const bf16x8*>(R1p + 16384 + (wv * 16 + fr) * 64 + kk * 32 + fq * 8); \
    EG = EGL[(IT) + zoff]; \
    { const u16* Fp = R1p + part * 8192;     \
      _Pragma("unroll") for (int kk = 0; kk < 4; ++kk) \
        F[kk] = *reinterpret_cast<const bf16x8*>(Fp + (ib * 16 + fr) * 128 + kk * 32 + fq * 8); } \
    if (part == 0) { \
      UU0 = *reinterpret_cast<const uint2*>(R2p + (dv0 + fr) * 64 + ib * 16 + fq * 4); \
      UU1 = *reinterpret_cast<const uint2*>(R2p + (dv0 + 16 + fr) * 64 + ib * 16 + fq * 4); \
    } else { \
      _Pragma("unroll") for (int kk = 0; kk < 2; ++kk) \
        G[kk] = *reinterpret_cast<const bf16x8*>(R2p + 8192 + (ib * 16 + fr) * 64 + kk * 32 + fq * 8); } } while (0)
#define SCAN_FLUSH(PROW0, PNV) do { \
    if (tid < 256) { const int i_ = tid >> 2, sg_ = tid & 3; \
      if (i_ < (PNV)) *reinterpret_cast<uint4*>(ymix + (long)((PROW0) + i_) * DM + 1024 + h * 128 + dv0 + sg_ * 8) = \
          *reinterpret_cast<const uint4*>(sO + i_ * 40 + sg_ * 8); } } while (0)
#define SCAN_STEP(STEP, F, G, KPF, UU0, UU1, EGLV, FN, GN, KPFN, UU0N, UU1N, EGLN) do { \
    const int row0 = (is_prompt && (STEP) > 0) ? rowbase + 16 + ((STEP) - 1) * 64 : rowbase; \
    const int nvalid = (is_prompt && (STEP) == 0) ? 16 : 64; \
    { const long itn = slot0 + min((STEP) + 2, nsteps - 1); \
      SCAN_LOAD(itn, FN, GN, KPFN, UU0N, UU1N, EGLN); } \
    if ((STEP) > 0) SCAN_FLUSH(prow0, pnv); \
    f32x4 c0 = {0.f, 0.f, 0.f, 0.f}, c1 = {0.f, 0.f, 0.f, 0.f}; \
    _Pragma("unroll") for (int kk = 0; kk < 4; ++kk) { \
      c0 = mfma16(F[kk], ldfrag(sST, 136, fr, kk * 32 + fq * 8), c0); \
      c1 = mfma16(F[kk], ldfrag(sST, 136, 16 + fr, kk * 32 + fq * 8), c1); } \
    if (part == 0) { \
      float u0[4], u1[4]; \
      unpack4(UU0, u0); unpack4(UU1, u1); \
      *reinterpret_cast<uint2*>(sVT + fr * 72 + ib * 16 + fq * 4) = pack4(u0[0] - c0[0], u0[1] - c0[1], u0[2] - c0[2], u0[3] - c0[3]); \
      *reinterpret_cast<uint2*>(sVT + (16 + fr) * 72 + ib * 16 + fq * 4) = pack4(u1[0] - c1[0], u1[1] - c1[1], u1[2] - c1[2], u1[3] - c1[3]); } \
    LDS_BAR(); \
    _Pragma("unroll") for (int nb = 0; nb < 2; ++nb) { \
      f32x4 c = accS[nb]; \
      c[0] *= EGLV; c[1] *= EGLV; c[2] *= EGLV; c[3] *= EGLV; \
      _Pragma("unroll") for (int kk = 0; kk < 2; ++kk) \
        c = mfma16(ldfrag(sVT, 72, nb * 16 + fr, kk * 32 + fq * 8), KPF[kk], c); \
      accS[nb] = c; \
      _Pragma("unroll") for (int r = 0; r < 4; ++r) sST[(nb * 16 + fq * 4 + r) * 136 + wv * 16 + fr] = f2bf(c[r]); } \
    if (part == 1) { \
      _Pragma("unroll") for (int kk = 0; kk < 2; ++kk) { \
        c0 = mfma16(G[kk], ldfrag(sVT, 72, fr, kk * 32 + fq * 8), c0); \
        c1 = mfma16(G[kk], ldfrag(sVT, 72, 16 + fr, kk * 32 + fq * 8), c1); } \
      _Pragma("unroll") for (int r = 0; r < 4; ++r) { \
        sO[(ib * 16 + fq * 4 + r) * 40 + fr] = f2bf(c0[r]); \
        sO[(ib * 16 + fq * 4 + r) * 40 + 16 + fr] = f2bf(c1[r]); } } \
    LDS_BAR(); \
    prow0 = row0; pnv = nvalid; } while (0)
  bf16x8 fA[4], gA[2], kpfA[2]; uint2 u0A, u1A; float eglA;
  bf16x8 fB[4], gB[2], kpfB[2]; uint2 u0B, u1B; float eglB;
  bf16x8 fC[4], gC[2], kpfC[2]; uint2 u0C, u1C; float eglC;
  int prow0 = 0, pnv = 0;
  SCAN_LOAD(slot0, fA, gA, kpfA, u0A, u1A, eglA);
  SCAN_LOAD(slot0 + min(1, nsteps - 1), fB, gB, kpfB, u0B, u1B, eglB);
  for (int step = 0; step < nsteps; step += 3) {
    SCAN_STEP(step, fA, gA, kpfA, u0A, u1A, eglA, fC, gC, kpfC, u0C, u1C, eglC);
    if (step + 1 < nsteps) SCAN_STEP(step + 1, fB, gB, kpfB, u0B, u1B, eglB, fA, gA, kpfA, u0A, u1A, eglA);
    if (step + 2 < nsteps) SCAN_STEP(step + 2, fC, gC, kpfC, u0C, u1C, eglC, fB, gB, kpfB, u0B, u1B, eglB);
  }
  SCAN_FLUSH(prow0, pnv);
#undef SCAN_STEP
#undef SCAN_FLUSH
#undef SCAN_LOAD
  float* dst = p.out + (is_prompt ? PD_OFF + ((long)(layer * 4 + s) * 8 + h) * 16384 : SD_OFF + ((long)(layer * 8 + s) * 8 + h) * 16384);
#pragma unroll
  for (int nb = 0; nb < 2; ++nb)
    *reinterpret_cast<float4*>(dst + (wv * 16 + fr) * 128 + dv0 + nb * 16 + fq * 4) = make_float4(accS[nb][0], accS[nb][1], accS[nb][2], accS[nb][3]);
  __syncthreads();
}

constexpr int NUNIT = 4 * 513 + 32;
__device__ __forceinline__ void mixer_a_group(const Params& p, int layer, int ug) {
  const int tid = opaque_tid() & 511;
  const int uid = ug * 4 + (tid >> 7);
  if (uid >= NUNIT) return;
  const int c0 = (tid & 127) * 8;
  int row0, sidx; bool first, last, samp;
  if (uid < 2052) { sidx = uid / 513; const int k = uid - sidx * 513; row0 = sidx * TP + 16 * k; first = (k == 0); last = (k == 512); samp = false; }
  else { const int v = uid - 2052; sidx = v >> 2; const int k = v & 3; row0 = ROWS_P + sidx * 64 + 16 * k; first = (k == 0); last = (k == 3); samp = true; }
  const u16* proj = (const u16*)(p.ws + OFF_PROJ);
  u16* ymix = (u16*)(p.ws + OFF_YMIX);
  float w0[8], w1[8], w2[8], um2[8], um1[8];
  {
    const float* cw = p.cvaw + (long)layer * 3 * 1024 + c0;
#pragma unroll
    for (int e = 0; e < 8; ++e) { w0[e] = cw[e]; w1[e] = cw[1024 + e]; w2[e] = cw[2048 + e]; }
  }
  if (first) {
    if (samp) {
      const float* st = p.sca + (long)(layer * 8 + sidx) * 2 * 1024 + c0;
#pragma unroll
      for (int e = 0; e < 8; ++e) { um2[e] = st[e]; um1[e] = st[1024 + e]; }
    } else {
#pragma unroll
      for (int e = 0; e < 8; ++e) { um2[e] = 0.f; um1[e] = 0.f; }
    }
  } else {
    float c[8], x[8];
    unpack8(*reinterpret_cast<const uint4*>(proj + (long)(row0 - 2) * NP + 1024 + c0), c);
    unpack8(*reinterpret_cast<const uint4*>(proj + (long)(row0 - 2) * NP + 2048 + c0), x);
#pragma unroll
    for (int e = 0; e < 8; ++e) um2[e] = c[e] * x[e];
    unpack8(*reinterpret_cast<const uint4*>(proj + (long)(row0 - 1) * NP + 1024 + c0), c);
    unpack8(*reinterpret_cast<const uint4*>(proj + (long)(row0 - 1) * NP + 2048 + c0), x);
#pragma unroll
    for (int e = 0; e < 8; ++e) um1[e] = c[e] * x[e];
  }
  for (int t0 = 0; t0 < 16; t0 += 4) {
    uint4 rbv[4], rcv[4], rxv[4], rzv[4];
#pragma unroll
    for (int q = 0; q < 4; ++q) {
      const long rb = (long)(row0 + t0 + q) * NP + c0;
      rbv[q] = *reinterpret_cast<const uint4*>(proj + rb);
      rcv[q] = *reinterpret_cast<const uint4*>(proj + rb + 1024);
      rxv[q] = *reinterpret_cast<const uint4*>(proj + rb + 2048);
      rzv[q] = *reinterpret_cast<const uint4*>(proj + rb + 3072);
    }
#pragma unroll
    for (int q = 0; q < 4; ++q) {
      float b[8], c[8], x[8], z[8], y[8];
      unpack8(rbv[q], b); unpack8(rcv[q], c); unpack8(rxv[q], x); unpack8(rzv[q], z);
#pragma unroll
      for (int e = 0; e < 8; ++e) {
        const float u = c[e] * x[e];
        const float cv = w0[e] * um2[e] + w1[e] * um1[e] + w2[e] * u;
        y[e] = b[e] * cv * silu_f(z[e]);
        um2[e] = um1[e]; um1[e] = u;
      }
      uint4 o;
      o.x = pack2(y[0], y[1]); o.y = pack2(y[2], y[3]); o.z = pack2(y[4], y[5]); o.w = pack2(y[6], y[7]);
      *reinterpret_cast<uint4*>(ymix + (long)(row0 + t0 + q) * DM + c0) = o;
    }
  }
  if (last) {
    float* dst = p.out + (samp ? SCA_OFF + (long)(layer * 8 + sidx) * 2 * 1024 : PCA_OFF + (long)(layer * 4 + sidx) * 2 * 1024) + c0;
#pragma unroll
    for (int e = 0; e < 8; ++e) { dst[e] = um2[e]; dst[1024 + e] = um1[e]; }
  }
}

__device__ __forceinline__ void phase_post(const Params& p, int layer) {
  const int tid = opaque_tid() & 511;
  const u16* proj = (const u16*)(p.ws + OFF_PROJ);
  u16* ymix = (u16*)(p.ws + OFF_YMIX);
  const int hh = (tid >> 4) & 7, d = (tid & 15) * 8;
  float w[8];
#pragma unroll
  for (int e = 0; e < 8; ++e) w[e] = p.onw[layer * 128 + d + e];
  for (int g = blockIdx.x; g < ROWS / 4; g += gridDim.x) {
    const int row = g * 4 + (tid >> 7);
    u16* op = ymix + (long)row * DM + 1024 + hh * 128 + d;
    float o[8], z[8];
    unpack8(*reinterpret_cast<const uint4*>(op), o);
    unpack8(*reinterpret_cast<const uint4*>(proj + (long)row * NP + 7168 + hh * 128 + d), z);
    float ss = 0.f;
#pragma unroll
    for (int e = 0; e < 8; ++e) ss += o[e] * o[e];
    ss += __shfl_xor(ss, 1); ss += __shfl_xor(ss, 2); ss += __shfl_xor(ss, 4); ss += __shfl_xor(ss, 8);
    const float rs = rsqrtf(ss * (1.f / 128.f) + EPS);
    float y[8];
#pragma unroll
    for (int e = 0; e < 8; ++e) y[e] = o[e] * rs * w[e] * silu_f(z[e]);
    uint4 ov;
    ov.x = pack2(y[0], y[1]); ov.y = pack2(y[2], y[3]); ov.z = pack2(y[4], y[5]); ov.w = pack2(y[6], y[7]);
    *reinterpret_cast<uint4*>(op) = ov;
  }
}

__device__ __forceinline__ void phase_final(const Params& p) {
  const int tid = opaque_tid() & 511, wv = tid >> 6, lane = tid & 63;
  const float* sumsq = (const float*)(p.ws + OFF_SUMSQ) + 2L * ROWSP;
  for (int r = blockIdx.x * 8 + wv; r < ROWS; r += gridDim.x * 8) {
    float* dst;
    if (r < ROWS_P) {
      const int b = r / TP, t = r - b * TP;
      if (t < 16) continue;
      dst = p.out + ((long)b * 8192 + (t - 16)) * DM;
    } else {
      dst = p.out + YS_OFF + (long)(r - ROWS_P) * DM;
    }
    const float rs = rsqrtf(sumsq[r] * (1.f / DM) + EPS);
#pragma unroll
    for (int i = 0; i < 8; ++i) {
      const int c = (i * 64 + lane) * 4;
      float4 v = *reinterpret_cast<const float4*>(dst + c);
      const float4 w = *reinterpret_cast<const float4*>(p.fnw + c);
      v.x *= rs * w.x; v.y *= rs * w.y; v.z *= rs * w.z; v.w *= rs * w.w;
      *reinterpret_cast<float4*>(dst + c) = v;
    }
  }
}

typedef const __attribute__((address_space(4))) Params* CParamsPtr;
__device__ __forceinline__ Params ldparams(CParamsPtr q) {
#if defined(__HIP_DEVICE_COMPILE__)
  asm volatile("" : "+s"(q));
  Params r;
  r.xp = q->xp; r.xs = q->xs; r.sca = q->sca; r.scq = q->scq; r.sdel = q->sdel; r.meta = q->meta; r.normw = q->normw; r.win = q->win;
  r.cvaw = q->cvaw; r.cvqw = q->cvqw; r.alog = q->alog; r.dtb = q->dtb; r.onw = q->onw; r.wout = q->wout; r.fnw = q->fnw;
  r.out = q->out; r.ws = q->ws;
  return r;
#else
  return Params{};
#endif
}

__global__ void __launch_bounds__(512) mega(Params p_unused) {
  extern __shared__ __attribute__((aligned(16))) unsigned char smem[];
  cg::grid_group grid = cg::this_grid();
  CParamsPtr kp = (CParamsPtr)__builtin_amdgcn_kernarg_segment_ptr();
  { const Params p = ldparams(kp); phase_prep(p, smem); }
  grid.sync();
  for (int layer = 0; layer < 2; ++layer) {
    { const Params p = ldparams(kp); gemm_phase<1>(p, layer, smem); }
    grid.sync();
    { const Params p = ldparams(kp); for (int item = blockIdx.x; item < NITEM; item += gridDim.x) chunk_prep(p, layer, item, smem); }
    grid.sync();
    {
      const Params p = ldparams(kp);
      const int G = gridDim.x, b = blockIdx.x;
      if (G >= 256) {
        if (b < 128) gdn_scan(p, layer, (((b & 7) + 8 * (b >> 5)) << 2) + ((b >> 3) & 3), smem);
        else {
          if (b < 256) { gdn_scan(p, layer, b, smem); gdn_scan(p, layer, b + 128, smem); }
          for (int ug = b - 128; ug < (NUNIT + 3) / 4; ug += G - 128) mixer_a_group(p, layer, ug);
        }
      } else {
        for (int w = b; w < 384; w += G) gdn_scan(p, layer, w, smem);
        for (int ug = b; ug < (NUNIT + 3) / 4; ug += G) mixer_a_group(p, layer, ug);
      }
    }
    grid.sync();
    { const Params p = ldparams(kp); phase_post(p, layer); }
    grid.sync();
    { const Params p = ldparams(kp); if (layer == 0) gemm_phase<2>(p, layer, smem); else gemm_phase<3>(p, layer, smem); }
    grid.sync();
  }
  { const Params p = ldparams(kp); phase_final(p); }
}

extern "C" void kernel_launch(void* const* d_in, const int* in_sizes, int n_in,
                              void* d_out, int out_size, void* d_ws, size_t ws_size,
                              hipStream_t stream) {
  constexpr size_t kLds = 131072;
  static int grid_blocks = 0;
  if (!grid_blocks) {
    int dev = 0, cus = 0, per_cu = 0;
    (void)hipGetDevice(&dev);
    (void)hipDeviceGetAttribute(&cus, hipDeviceAttributeMultiprocessorCount, dev);
    (void)hipFuncSetAttribute((const void*)mega, hipFuncAttributeMaxDynamicSharedMemorySize, (int)kLds);
    (void)hipOccupancyMaxActiveBlocksPerMultiprocessor(&per_cu, (const void*)mega, 512, kLds);
    if (per_cu < 1) per_cu = 1;
    grid_blocks = cus * per_cu;
    if (ws_size < (size_t)WS_END) fprintf(stderr, "workspace too small: %zu < %ld\n", ws_size, WS_END);
  }
  Params p{};
  p.xp = (const float*)d_in[0]; p.xs = (const float*)d_in[1]; p.sca = (const float*)d_in[2]; p.scq = (const float*)d_in[3];
  p.sdel = (const float*)d_in[4]; p.meta = (const float*)d_in[5]; p.normw = (const float*)d_in[6]; p.win = (const float*)d_in[7];
  p.cvaw = (const float*)d_in[8]; p.cvqw = (const float*)d_in[9]; p.alog = (const float*)d_in[10]; p.dtb = (const float*)d_in[11];
  p.onw = (const float*)d_in[12]; p.wout = (const float*)d_in[13]; p.fnw = (const float*)d_in[14];
  p.out = (float*)d_out; p.ws = (unsigned char*)d_ws;
  void* args[] = {&p};
  hipError_t e = hipLaunchCooperativeKernel((void*)mega, dim3(grid_blocks), dim3(512), args, kLds, stream);
  if (e != hipSuccess) fprintf(stderr, "cooperative launch failed: %s (grid %d)\n", hipGetErrorString(e), grid_blocks);
}
```

```cpp
#include <hip/hip_runtime.h>
#include <hip/hip_bf16.h>
#include <hip/hip_cooperative_groups.h>
#include <cstdio>
namespace cg = cooperative_groups;

typedef unsigned short u16;
using bf16x8 = __attribute__((ext_vector_type(8))) short;
using f32x4 = __attribute__((ext_vector_type(4))) float;

constexpr int DM = 2048;
constexpr int NP = 8208;
constexpr int NPP = 8448;
constexpr int TP = 8208;
constexpr int ROWS_P = 4 * TP;
constexpr int ROWS = ROWS_P + 512;
constexpr int ROWSP = 33536;
constexpr int NCHUNK = 524;
constexpr int NITEM = NCHUNK * 8;
constexpr float EPS = 1e-6f;

constexpr long OFF_WTIN = 0;
constexpr long OFF_WTOUT = OFF_WTIN + 2L * NPP * DM * 2;
constexpr long OFF_HB = OFF_WTOUT + 2L * DM * DM * 2;
constexpr long OFF_PROJ = OFF_HB + (long)ROWSP * DM * 2;
constexpr long OFF_YMIX = OFF_PROJ + (long)ROWS * NP * 2;
constexpr long OFF_SUMSQ = OFF_YMIX + (long)ROWSP * DM * 2;
constexpr long OFF_EGL = OFF_SUMSQ + 3L * ROWSP * 4;
constexpr long OFF_QK = OFF_EGL + 16896;
constexpr long OFF_UT = OFF_QK + (long)NITEM * 4096 * 2;
constexpr long OFF_BAR = OFF_UT + (long)NITEM * 8192 * 2;
constexpr long WS_END = OFF_BAR + 16384;
constexpr long OOFF_W = 0;
constexpr long OOFF_QG = OOFF_W + (long)NITEM * 8192 * 2;
constexpr long OOFF_KPT = OOFF_QG + (long)NITEM * 8192 * 2;
constexpr long YS_OFF = 67108864L;
constexpr long PCA_OFF = YS_OFF + 1048576L;
constexpr long PCQ_OFF = PCA_OFF + 16384L;
constexpr long PD_OFF = PCQ_OFF + 73728L;
constexpr long SCA_OFF = PD_OFF + 1048576L;
constexpr long SCQ_OFF = SCA_OFF + 32768L;
constexpr long SD_OFF = SCQ_OFF + 147456L;

struct Params {
  const float *xp, *xs, *sca, *scq, *sdel, *meta, *normw, *win, *cvaw, *cvqw, *alog, *dtb, *onw, *wout, *fnw;
  float* out;
  unsigned char* ws;
};

typedef __bf16 bf16x2_t __attribute__((ext_vector_type(2)));
typedef float f32x2_t __attribute__((ext_vector_type(2)));
__device__ __forceinline__ unsigned pack2(float a, float b) {
#if defined(__HIP_DEVICE_COMPILE__)
  f32x2_t v = {a, b};
  return __builtin_bit_cast(unsigned, __builtin_convertvector(v, bf16x2_t));
#else
  return 0u;
#endif
}
__device__ __forceinline__ u16 f2bf(float f) { return (u16)(pack2(f, 0.f) & 0xffffu); }
__device__ __forceinline__ int opaque_tid() { int t; asm volatile("v_mov_b32 %0, %1" : "=v"(t) : "v"((int)threadIdx.x)); return t; }
__device__ __forceinline__ float bf2f(u16 h) { return __uint_as_float(((unsigned)h) << 16); }
__device__ __forceinline__ uint2 pack4(float a, float b, float c, float d) { return make_uint2(pack2(a, b), pack2(c, d)); }
__device__ __forceinline__ void unpack4(uint2 v, float* o) {
  o[0] = __uint_as_float(v.x << 16); o[1] = __uint_as_float(v.x & 0xffff0000u);
  o[2] = __uint_as_float(v.y << 16); o[3] = __uint_as_float(v.y & 0xffff0000u);
}
__device__ __forceinline__ void unpack8(uint4 v, float* o) {
  o[0] = __uint_as_float(v.x << 16); o[1] = __uint_as_float(v.x & 0xffff0000u);
  o[2] = __uint_as_float(v.y << 16); o[3] = __uint_as_float(v.y & 0xffff0000u);
  o[4] = __uint_as_float(v.z << 16); o[5] = __uint_as_float(v.z & 0xffff0000u);
  o[6] = __uint_as_float(v.w << 16); o[7] = __uint_as_float(v.w & 0xffff0000u);
}
__device__ __forceinline__ float silu_f(float x) { return x * __frcp_rn(1.f + __expf(-x)); }
__device__ __forceinline__ f32x4 mfma16(bf16x8 a, bf16x8 b, f32x4 c) {
  return __builtin_amdgcn_mfma_f32_16x16x32_bf16(a, b, c, 0, 0, 0);
}
__device__ __forceinline__ bf16x8 ldfrag(const u16* base, int stride, int row, int k) {
  return *reinterpret_cast<const bf16x8*>(base + row * stride + k);
}

__device__ __forceinline__ void l2_touch(const void* ptr) {
  (void)ptr;
}
__device__ __forceinline__ unsigned touch_ld(const void* ptr) { return *reinterpret_cast<const unsigned*>(ptr); }
__device__ __forceinline__ void touch_use(unsigned& acc, unsigned v) { asm volatile("v_add_u32 %0, %0, %1" : "+v"(acc) : "v"(v)); }

__device__ __forceinline__ f32x4 mm16(const float* X, int xr, int xc, const float* Y, int yr, int yc, int kn, int fr, int fq) {
  f32x4 c = {0.f, 0.f, 0.f, 0.f};
  for (int k0 = 0; k0 < kn; k0 += 4) {
    const float a = X[(xr + fr) * 68 + xc + k0 + fq];
    const float b = Y[(yr + k0 + fq) * 68 + yc + fr];
    c = __builtin_amdgcn_mfma_f32_16x16x4f32(a, b, c, 0, 0, 0);
  }
  return c;
}

__device__ __forceinline__ void transpose_tiles(const float* __restrict__ src, u16* __restrict__ dst, const float* __restrict__ scale,
                                                int nsrc, int ntile_n, unsigned char* smem) {
  float* tile = (float*)smem;
  const int tid = opaque_tid();
  const int ntiles = 32 * ntile_n;
  for (int t = blockIdx.x; t < ntiles; t += gridDim.x) {
    const int kt = t & 31, nt = t >> 5;
    const int k0 = kt * 64, n0 = nt * 64;
    {
      const int nl = tid & 63, kb = tid >> 6;
#pragma unroll
      for (int it = 0; it < 8; ++it) {
        const int kl = kb + it * 8;
        const int n = n0 + nl;
        float v = 0.f;
        if (n < nsrc) v = src[(long)(k0 + kl) * nsrc + n] * (scale ? scale[k0 + kl] : 1.f);
        tile[kl * 65 + nl] = v;
      }
    }
    __syncthreads();
    {
      const int nl = tid >> 3, kg = tid & 7;
      float v[8];
#pragma unroll
      for (int e = 0; e < 8; ++e) v[e] = tile[(kg * 8 + e) * 65 + nl];
      uint4 o;
      o.x = pack2(v[0], v[1]); o.y = pack2(v[2], v[3]); o.z = pack2(v[4], v[5]); o.w = pack2(v[6], v[7]);
      *reinterpret_cast<uint4*>(dst + (long)(n0 + nl) * DM + k0 + kg * 8) = o;
    }
    __syncthreads();
  }
}

__device__ __forceinline__ void phase_prep(const Params& p, unsigned char* smem) {
  const int tid = opaque_tid(), wv = tid >> 6, lane = tid & 63;
  u16* hb = (u16*)(p.ws + OFF_HB);
  float* sumsq = (float*)(p.ws + OFF_SUMSQ);
  for (int r = blockIdx.x * 8 + wv; r < ROWSP; r += gridDim.x * 8) {
    const float* src = nullptr;
    if (r < ROWS_P) {
      const int b = r / TP, t = r - b * TP;
      src = (t < 16) ? (p.meta + (long)t * DM) : (p.xp + ((long)b * 8192 + (t - 16)) * DM);
    } else if (r < ROWS) {
      src = p.xs + (long)(r - ROWS_P) * DM;
    }
    float ss = 0.f;
#pragma unroll
    for (int i = 0; i < 8; ++i) {
      const int c = (i * 64 + lane) * 4;
      float4 v = make_float4(0.f, 0.f, 0.f, 0.f);
      if (src) v = *reinterpret_cast<const float4*>(src + c);
      ss += v.x * v.x + v.y * v.y + v.z * v.z + v.w * v.w;
      *reinterpret_cast<uint2*>(hb + (long)r * DM + c) = pack4(v.x, v.y, v.z, v.w);
    }
#pragma unroll
    for (int o = 32; o > 0; o >>= 1) ss += __shfl_xor(ss, o);
    if (lane == 0) sumsq[r] = ss;
  }
  for (long i = (long)blockIdx.x * 512 + tid; i < 2L * ROWSP; i += (long)gridDim.x * 512) sumsq[ROWSP + i] = 0.f;
  for (int l = 0; l < 2; ++l) {
    transpose_tiles(p.win + (long)l * DM * NP, (u16*)(p.ws + OFF_WTIN) + (long)l * NPP * DM, p.normw + l * DM, NP, NPP / 64, smem);
    transpose_tiles(p.wout + (long)l * DM * DM, (u16*)(p.ws + OFF_WTOUT) + (long)l * DM * DM, nullptr, DM, DM / 64, smem);
  }
}

constexpr int BM = 256, BK = 64, HALF = 128, HT = HALF * BK;

__device__ __forceinline__ int lds_byte(int r, int c) {
  int st = (r >> 4) * 2 + (c >> 5), rr = r & 15, cc = c & 31, ob = rr * 64 + cc * 2;
  return st * 1024 + (ob ^ (((ob >> 9) & 1) << 5));
}
__device__ __forceinline__ void stage_rc(int b, int& R, int& C) {
  int st = b / 1024, sb = b % 1024, swz = sb ^ (((sb >> 9) & 1) << 5);
  R = (st >> 1) * 16 + swz / 64; C = (st & 1) * 32 + (swz % 64) / 2;
}

template <int EPI>
__device__ __forceinline__ void gemm_phase(const Params& p, int layer, unsigned char* smem) {
  typedef __hip_bfloat16 bf16;
  bf16* shm = (bf16*)smem;
  const bf16* A = (const bf16*)(p.ws + (EPI == 1 ? OFF_HB : OFF_YMIX));
  const bf16* Bt = (EPI == 1) ? (const bf16*)(p.ws + OFF_WTIN) + (long)layer * NPP * DM
                              : (const bf16*)(p.ws + OFF_WTOUT) + (long)layer * DM * DM;
  constexpr int K = DM;
  constexpr int nM = ROWSP / BM;
  constexpr int nN = (EPI == 1) ? NPP / BM : DM / BM;
  constexpr int WGM = 4;
  constexpr int nwg = nM * nN;
#define SA(b, h) (shm + ((b) * 2 + (h)) * HT)
#define SB(b, h) (shm + (4 + (b) * 2 + (h)) * HT)
#define OA(b, h) ((((b) * 2 + (h)) * HT) * 2)
#define OB(b, h) (((4 + (b) * 2 + (h)) * HT) * 2)
#define STAGE(PO, BASE, br, kt) do { const char* _ub = (const char*)(BASE) + ((long)(br) * K + (long)(kt) * BK) * 2; \
      asm volatile("s_add_u32 m0, %0, %3\n\ts_nop 0\n\tglobal_load_lds_dwordx4 %1, %2" :: "s"(ldsw), "v"(soff0), "s"(_ub), "n"(PO) : "memory", "scc"); \
      asm volatile("s_add_u32 m0, %0, %3\n\ts_nop 0\n\tglobal_load_lds_dwordx4 %1, %2" :: "s"(ldsw), "v"(soff1), "s"(_ub), "n"((PO) + 8192) : "memory", "scc"); } while (0)
#define LDA(dst, b, h) for (int m = 0; m < 4; ++m) for (int k = 0; k < 2; ++k) \
    dst[m][k] = *reinterpret_cast<const bf16x8*>((char*)SA(b, h) + lds_byte(wr * 64 + m * 16 + fr, k * 32 + fq * 8))
#define LDB(dst, b, h) for (int n = 0; n < 2; ++n) for (int k = 0; k < 2; ++k) \
    dst[n][k] = *reinterpret_cast<const bf16x8*>((char*)SB(b, h) + lds_byte(wc * 32 + n * 16 + fr, k * 32 + fq * 8))
#define MMA(ai, bj, At, Bt_) do { __builtin_amdgcn_s_setprio(1); \
    for (int m = 0; m < 4; ++m) for (int n = 0; n < 2; ++n) for (int k = 0; k < 2; ++k) \
      acc[ai][bj][m][n] = __builtin_amdgcn_mfma_f32_16x16x32_bf16(At[m][k], Bt_[n][k], acc[ai][bj][m][n], 0, 0, 0); \
    __builtin_amdgcn_s_setprio(0); } while (0)
#define WAIT_V(n) asm volatile("s_waitcnt vmcnt(" #n ")" ::: "memory")
#define WAIT_L(n) asm volatile("s_waitcnt lgkmcnt(" #n ")" ::: "memory")
#define BAR __builtin_amdgcn_s_barrier()
#define SCHED __builtin_amdgcn_sched_barrier(0)

  const int gtid = opaque_tid() & 511;
  const int wid = __builtin_amdgcn_readfirstlane(gtid >> 6), lane = gtid & 63, wr = wid >> 2, wc = wid & 3, fr = lane & 15, fq = lane >> 4;
  unsigned soff0, soff1;
  { int _r, _c; stage_rc(gtid * 16, _r, _c); soff0 = (unsigned)(_r * K + _c) * 2u;
    stage_rc(gtid * 16 + 8192, _r, _c); soff1 = (unsigned)(_r * K + _c) * 2u; }
  const unsigned ldsw = (unsigned)(size_t)((__attribute__((address_space(3))) unsigned char*)smem) + (unsigned)wid * 1024u;
  int gdim = (int)gridDim.x;
  asm volatile("" : "+s"(gdim));
  int vb = blockIdx.x;
  if ((gdim & 7) == 0) vb = (blockIdx.x & 7) * (gdim >> 3) + (blockIdx.x >> 3);
  constexpr int nig = WGM * nN;
#define TILE_RC(wg, BR, BC) do { const int gid_ = (wg) / nig, fm_ = gid_ * WGM, gsz_ = min(nM - fm_, WGM); \
    BC = (fm_ + (((wg) % nig) % gsz_)) * BM; BR = (((wg) % nig) / gsz_) * BM; } while (0)
  int brow = 0, bcol = 0;
  if (vb < nwg) {
    TILE_RC(vb, brow, bcol);
    STAGE(OB(0, 0), A, bcol, 0); STAGE(OA(0, 0), Bt, brow, 0);
    STAGE(OB(0, 1), A, bcol + HALF, 0); STAGE(OA(0, 1), Bt, brow + HALF, 0);
  }
  for (int wgid = vb; wgid < nwg; wgid += gdim) {
    f32x4 acc[2][2][4][2] = {};
    bf16x8 At[4][2], B0[2][2], B1[2][2];
    constexpr int nt = K / BK;
    if (wr == 1) BAR;
    WAIT_V(4); BAR;
    STAGE(OB(1, 0), A, bcol, 1); STAGE(OA(1, 0), Bt, brow, 1); STAGE(OB(1, 1), A, bcol + HALF, 1);
    WAIT_V(6); BAR;
    for (int t = 0; t < nt - 2; t += 2) {
      LDB(B0, 0, 0); SCHED; LDA(At, 0, 0); STAGE(OA(1, 1), Bt, brow + HALF, t + 1);
      WAIT_L(8); BAR; WAIT_L(0); MMA(0, 0, At, B0); BAR; SCHED;
      LDB(B1, 0, 1); STAGE(OB(0, 0), A, bcol, t + 2);
      BAR; WAIT_L(0); MMA(0, 1, At, B1); BAR;
      LDA(At, 0, 1); STAGE(OA(0, 0), Bt, brow, t + 2);
      BAR; WAIT_L(0); MMA(1, 0, At, B0); BAR; SCHED;
      STAGE(OB(0, 1), A, bcol + HALF, t + 2);
      WAIT_V(6); BAR; MMA(1, 1, At, B1); BAR;
      LDB(B0, 1, 0); SCHED; LDA(At, 1, 0); STAGE(OA(0, 1), Bt, brow + HALF, t + 2);
      WAIT_L(8); BAR; WAIT_L(0); MMA(0, 0, At, B0); BAR; SCHED;
      LDB(B1, 1, 1); STAGE(OB(1, 0), A, bcol, t + 3);
      BAR; WAIT_L(0); MMA(0, 1, At, B1); BAR;
      LDA(At, 1, 1); STAGE(OA(1, 0), Bt, brow, t + 3);
      BAR; WAIT_L(0); MMA(1, 0, At, B0); BAR; SCHED;
      STAGE(OB(1, 1), A, bcol + HALF, t + 3);
      WAIT_V(6); BAR; MMA(1, 1, At, B1); BAR;
    }
    { LDB(B0, 0, 0); LDA(At, 0, 0); STAGE(OA(1, 1), Bt, brow + HALF, nt - 1);
      BAR; WAIT_L(0); MMA(0, 0, At, B0); BAR;
      LDB(B1, 0, 1); BAR; WAIT_L(0); MMA(0, 1, At, B1); BAR;
      LDA(At, 0, 1); WAIT_V(4); BAR; WAIT_L(0); MMA(1, 0, At, B0); MMA(1, 1, At, B1); BAR; }
    { LDB(B0, 1, 0); LDA(At, 1, 0); WAIT_V(2); BAR; WAIT_L(0); MMA(0, 0, At, B0); BAR;
      LDB(B1, 1, 1); WAIT_V(0); BAR; WAIT_L(0); MMA(0, 1, At, B1); BAR;
      LDA(At, 1, 1); BAR; WAIT_L(0); MMA(1, 0, At, B0); MMA(1, 1, At, B1); BAR; }
    if (wr == 0) BAR;
    const int erow = brow, ecol = bcol;
    if (wgid + gdim < nwg) {
      TILE_RC(wgid + gdim, brow, bcol);
      STAGE(OB(0, 0), A, bcol, 0); STAGE(OA(0, 0), Bt, brow, 0);
      STAGE(OB(0, 1), A, bcol + HALF, 0); STAGE(OA(0, 1), Bt, brow + HALF, 0);
    }
    if (EPI == 1) {
      u16* proj = (u16*)(p.ws + OFF_PROJ);
      const float* sumsq = (const float*)(p.ws + OFF_SUMSQ) + (long)layer * ROWSP;
#pragma unroll
      for (int bj = 0; bj < 2; ++bj)
#pragma unroll
        for (int n = 0; n < 2; ++n) {
          const int tok = ecol + bj * HALF + wc * 32 + n * 16 + fr;
          if (tok < ROWS) {
            const float rs = rsqrtf(sumsq[tok] * (1.f / DM) + EPS);
            u16* prow = proj + (long)tok * NP;
#pragma unroll
            for (int ai = 0; ai < 2; ++ai)
#pragma unroll
              for (int m = 0; m < 4; ++m) {
                const int n0 = erow + ai * HALF + wr * 64 + m * 16 + fq * 4;
                if (n0 < NP)
                  *reinterpret_cast<uint2*>(prow + n0) = pack4(acc[ai][bj][m][n][0] * rs, acc[ai][bj][m][n][1] * rs,
                                                                acc[ai][bj][m][n][2] * rs, acc[ai][bj][m][n][3] * rs);
              }
          }
        }
    } else {
      u16* hb = (u16*)(p.ws + OFF_HB);
      float* sumsq = (float*)(p.ws + OFF_SUMSQ) + (long)(EPI == 2 ? 1 : 2) * ROWSP;
#pragma unroll
      for (int bj = 0; bj < 2; ++bj)
#pragma unroll
        for (int n = 0; n < 2; ++n) {
          const int tok = ecol + bj * HALF + wc * 32 + n * 16 + fr;
          float* dst = nullptr;
          if (EPI == 3) {
            if (tok < ROWS_P) {
              const int b = tok / TP, t = tok - b * TP;
              if (t >= 16) dst = p.out + ((long)b * 8192 + (t - 16)) * DM;
            } else if (tok < ROWS) {
              dst = p.out + YS_OFF + (long)(tok - ROWS_P) * DM;
            }
          }
          u16* hrow = hb + (long)tok * DM;
          float rsum = 0.f;
#pragma unroll
          for (int ai = 0; ai < 2; ++ai)
#pragma unroll
            for (int m = 0; m < 4; ++m) {
              const int n0 = erow + ai * HALF + wr * 64 + m * 16 + fq * 4;
              float r4[4];
              unpack4(*reinterpret_cast<const uint2*>(hrow + n0), r4);
              float v[4];
#pragma unroll
              for (int j = 0; j < 4; ++j) { v[j] = acc[ai][bj][m][n][j] + r4[j]; rsum += v[j] * v[j]; }
              if (EPI == 2) *reinterpret_cast<uint2*>(hrow + n0) = pack4(v[0], v[1], v[2], v[3]);
              else if (dst) *reinterpret_cast<float4*>(dst + n0) = make_float4(v[0], v[1], v[2], v[3]);
            }
          rsum += __shfl_xor(rsum, 16); rsum += __shfl_xor(rsum, 32);
          if (fq == 0) atomicAdd(&sumsq[tok], rsum);
        }
    }
  }
  __syncthreads();
#undef TILE_RC
#undef SA
#undef SB
#undef OA
#undef OB
#undef STAGE
#undef LDA
#undef LDB
#undef MMA
}

__device__ __forceinline__ void chunk_geom(int cid, int& row0, int& nvalid, int& prevmode, int& sidx, bool& lastc) {
  if (cid < 516) {
    const int s = cid / 129, c = cid - s * 129;
    sidx = s; lastc = (c == 128);
    if (c == 0) { row0 = s * TP; nvalid = 16; prevmode = 0; }
    else { row0 = s * TP + 16 + (c - 1) * 64; nvalid = 64; prevmode = 1; }
  } else {
    sidx = cid - 516; row0 = ROWS_P + sidx * 64; nvalid = 64; prevmode = 2; lastc = true;
  }
}

__device__ __forceinline__ long item_slot(int cid, int h) {
  if (cid < 516) { const int s = cid / 129, c = cid - s * 129; return (long)((s * 8 + h) * 129 + c); }
  return (long)(4128 + (cid - 516) * 8 + h);
}

__device__ __forceinline__ void chunk_prep(const Params& p, int layer, int item, unsigned char* smem) {
  const int tid = opaque_tid() & 511, wv = __builtin_amdgcn_readfirstlane(tid >> 6), lane = tid & 63, fr = lane & 15, fq = lane >> 4;
  const int cid = item >> 3, h = item & 7;
  int row0, nvalid, prevmode, sidx; bool lastc;
  chunk_geom(cid, row0, nvalid, prevmode, sidx, lastc);
  u16* sKB = (u16*)smem;
  u16* sK = sKB + 64 * 136;
  u16* sQ = sK + 64 * 136;
  u16* sVBT = sQ + 64 * 136;
  u16* sKBGT = sVBT + 128 * 72;
  u16* sT = sKBGT + 128 * 72;
  float* sA = (float*)(sT + 64 * 72);
  float* sBeta = sA + 64 * 68;
  float* sGc = sBeta + 64;
  u16* sKPT = (u16*)(sGc + 64);
  float* sTf = (float*)smem;
  float* sY = sTf + 64 * 68;
  int zoff;
  asm volatile("v_mov_b32 %0, 0" : "=v"(zoff));
  const u16* proj = (const u16*)(p.ws + OFF_PROJ);
  const long slot = item_slot(cid, h);
  u16* Wd = (u16*)((unsigned char*)p.out) + slot * 24576;
  u16* QG = Wd + 8192;
  u16* KPT = Wd + 16384;
  u16* UTd = (u16*)(p.ws + OFF_QK) + slot * 12288;
  u16* QKd = UTd + 8192;
  float* EGL = (float*)(p.ws + OFF_EGL);

  unsigned tch = 0;
  {
    const int nitem = item + gridDim.x;
    if (nitem < NITEM) {
      int nrow0, nnv, npm, nsi; bool nl;
      chunk_geom(nitem >> 3, nrow0, nnv, npm, nsi, nl);
      const int nh = nitem & 7;
      if (tid < 402) {
        const int r = tid / 6, m6 = tid - r * 6;
        tch = touch_ld(proj + (long)(nrow0 - 3 + r) * NP + 4096 + (m6 >> 1) * 1024 + nh * 128 + (m6 & 1) * 64);
      } else if (tid >= 448) {
        tch = touch_ld(proj + (long)(nrow0 + (tid - 448)) * NP + 8192 + nh);
      }
    }
  }
  if (wv == 0) {
    float beta = 0.f, g = 0.f;
    if (lane < nvalid) {
      const long rb = (long)(row0 + lane) * NP;
      const float bl = bf2f(proj[rb + 8192 + h]);
      const float al = bf2f(proj[rb + 8200 + h]) + p.dtb[layer * 8 + h];
      beta = 1.f / (1.f + expf(-bl));
      const float sp = (al > 20.f) ? al : log1pf(expf(al));
      g = -expf(p.alog[layer * 8 + h]) * sp;
    }
    float gc = g;
#pragma unroll
    for (int o = 1; o < 64; o <<= 1) { const float t = __shfl_up(gc, o); if (lane >= o) gc += t; }
    sBeta[lane] = beta; sGc[lane] = gc;
  }

  const int rg = tid >> 5, cg = tid & 31, i0 = rg * 4, d0 = cg * 4;
  float qv[4][4], kv[4][4], vv[4][4];
#pragma unroll
  for (int mat = 0; mat < 3; ++mat) {
    const int ch = mat * 1024 + h * 128 + d0;
    const int colbase = 4096 + ch;
    float xr[7][4];
#pragma unroll
    for (int a = 0; a < 7; ++a) {
      const int ri = i0 - 3 + a;
      if (ri >= 0 || prevmode == 1) {
        uint2 raw = *reinterpret_cast<const uint2*>(proj + (long)(row0 + ri) * NP + colbase);
        unpack4(raw, xr[a]);
      } else if (prevmode == 2) {
        const float4 v = *reinterpret_cast<const float4*>(p.scq + ((long)(layer * 8 + sidx) * 3 + (3 + ri)) * 3072 + ch);
        xr[a][0] = v.x; xr[a][1] = v.y; xr[a][2] = v.z; xr[a][3] = v.w;
      } else {
        xr[a][0] = xr[a][1] = xr[a][2] = xr[a][3] = 0.f;
      }
    }
    if (lastc && rg == 15) {
      float* dst = p.out + (prevmode == 2 ? SCQ_OFF + (long)(layer * 8 + sidx) * 3 * 3072 : PCQ_OFF + (long)(layer * 4 + sidx) * 3 * 3072) + ch;
#pragma unroll
      for (int a = 4; a < 7; ++a)
        *reinterpret_cast<float4*>(dst + (a - 4) * 3072) = make_float4(xr[a][0], xr[a][1], xr[a][2], xr[a][3]);
    }
    float cw[4][4];
#pragma unroll
    for (int j = 0; j < 4; ++j) {
      const float4 v = *reinterpret_cast<const float4*>(p.cvqw + (long)(layer * 4 + j) * 3072 + ch);
      cw[j][0] = v.x; cw[j][1] = v.y; cw[j][2] = v.z; cw[j][3] = v.w;
    }
#pragma unroll
    for (int ii = 0; ii < 4; ++ii)
#pragma unroll
      for (int e = 0; e < 4; ++e) {
        float o = 0.f;
#pragma unroll
        for (int j = 0; j < 4; ++j) o += cw[j][e] * xr[ii + j][e];
        o = silu_f(o);
        if (mat == 0) qv[ii][e] = o; else if (mat == 1) kv[ii][e] = o; else vv[ii][e] = o;
      }
  }
#pragma unroll
  for (int ii = 0; ii < 4; ++ii) {
    float sq = 0.f, sk = 0.f;
#pragma unroll
    for (int e = 0; e < 4; ++e) { sq += qv[ii][e] * qv[ii][e]; sk += kv[ii][e] * kv[ii][e]; }
#pragma unroll
    for (int o = 1; o < 32; o <<= 1) { sq += __shfl_xor(sq, o); sk += __shfl_xor(sk, o); }
    const float rq = rsqrtf(sq + EPS) * 0.08838834764831845f, rk = rsqrtf(sk + EPS);
    const bool valid = (i0 + ii) < nvalid;
#pragma unroll
    for (int e = 0; e < 4; ++e) {
      qv[ii][e] = valid ? qv[ii][e] * rq : 0.f;
      kv[ii][e] = valid ? kv[ii][e] * rk : 0.f;
      vv[ii][e] = valid ? vv[ii][e] : 0.f;
    }
  }
  __syncthreads();
  float beta[4], gcv[4];
#pragma unroll
  for (int ii = 0; ii < 4; ++ii) { beta[ii] = sBeta[i0 + ii]; gcv[ii] = sGc[i0 + ii]; }
  const float glast = sGc[63];
  if (tid == 0) EGL[slot] = expf(glast);

#pragma unroll
  for (int ii = 0; ii < 4; ++ii) {
    const int i = i0 + ii;
    const float b = beta[ii];
    *reinterpret_cast<uint2*>(sKB + i * 136 + d0) = pack4(kv[ii][0] * b, kv[ii][1] * b, kv[ii][2] * b, kv[ii][3] * b);
    *reinterpret_cast<uint2*>(sK + i * 136 + d0) = pack4(kv[ii][0], kv[ii][1], kv[ii][2], kv[ii][3]);
    *reinterpret_cast<uint2*>(sQ + i * 136 + d0) = pack4(qv[ii][0], qv[ii][1], qv[ii][2], qv[ii][3]);

  }
  {
    float bg[4], kd[4];
#pragma unroll
    for (int ii = 0; ii < 4; ++ii) { bg[ii] = beta[ii] * __expf(gcv[ii]); kd[ii] = __expf(glast - gcv[ii]); }
#pragma unroll
    for (int e = 0; e < 4; ++e) {
      const int d = d0 + e;
      *reinterpret_cast<uint2*>(sVBT + d * 72 + i0) = pack4(vv[0][e] * beta[0], vv[1][e] * beta[1], vv[2][e] * beta[2], vv[3][e] * beta[3]);
      *reinterpret_cast<uint2*>(sKBGT + d * 72 + i0) = pack4(kv[0][e] * bg[0], kv[1][e] * bg[1], kv[2][e] * bg[2], kv[3][e] * bg[3]);
      *reinterpret_cast<uint2*>(sKPT + d * 72 + i0) = pack4(kv[0][e] * kd[0], kv[1][e] * kd[1], kv[2][e] * kd[2], kv[3][e] * kd[3]);
    }
  }
  __syncthreads();
#pragma unroll
  for (int t2 = 0; t2 < 2; ++t2) {
    {
      const int qib = wv >> 1, qkk = (wv & 1) * 2 + t2;
      const bf16x8 qf = ldfrag(sQ, 136, qib * 16 + fr, qkk * 32 + fq * 8);
      const float eg = __expf(sGc[qib * 16 + fr]);
      float qx[8];
      unpack8(__builtin_bit_cast(uint4, qf), qx);
      uint4 o;
      o.x = pack2(qx[0] * eg, qx[1] * eg); o.y = pack2(qx[2] * eg, qx[3] * eg);
      o.z = pack2(qx[4] * eg, qx[5] * eg); o.w = pack2(qx[6] * eg, qx[7] * eg);
      *reinterpret_cast<uint4*>(QG + (((qib * 4 + qkk) * 64 + lane) << 3)) = o;
    }
    *reinterpret_cast<bf16x8*>(KPT + (((wv * 2 + t2) * 64 + lane) << 3)) = ldfrag(sKPT, 72, wv * 16 + fr, t2 * 32 + fq * 8);
  }
  {
    const int ib = wv >> 1;
#pragma unroll
    for (int jj = 0; jj < 2; ++jj) {
      const int jb = (wv & 1) * 2 + jj;
      f32x4 c = {0.f, 0.f, 0.f, 0.f}, c2 = {0.f, 0.f, 0.f, 0.f};
#pragma unroll
      for (int kk = 0; kk < 4; ++kk) {
        const bf16x8 a = ldfrag(sKB, 136, ib * 16 + fr, kk * 32 + fq * 8);
        const bf16x8 b = ldfrag(sK, 136, jb * 16 + fr, kk * 32 + fq * 8);
        c = mfma16(a, b, c);
        const bf16x8 b2 = ldfrag(sQ, 136, ib * 16 + fr, kk * 32 + fq * 8);
        c2 = mfma16(b, b2, c2);
      }
      {
        const int j = jb * 16 + fr;
        const float gj = sGc[j];
#pragma unroll
        for (int r = 0; r < 4; ++r) {
          const int i = ib * 16 + fq * 4 + r;
          sA[i * 68 + j] = (i > j) ? c[r] * __expf(sGc[i] - gj) : 0.f;
        }
      }
      {
        const int i = ib * 16 + fr;
        const float gi = sGc[i];
        float o[4];
#pragma unroll
        for (int r = 0; r < 4; ++r) {
          const int j = jb * 16 + fq * 4 + r;
          o[r] = (i >= j) ? c2[r] * __expf(gi - sGc[j]) : 0.f;
        }
        *reinterpret_cast<uint2*>(QKd + ((((ib * 2 + (jb >> 1)) * 64) + ((jb & 1) * 2 + (fq >> 1)) * 16 + fr) << 3) + (fq & 1) * 4) = pack4(o[0], o[1], o[2], o[3]);
      }
    }
  }
  __syncthreads();
  {
    for (int e = tid; e < 64 * 68; e += 512) sTf[e] = 0.f;
    __syncthreads();
    if (wv < 4 && lane < 16) {
      const float* Ab = sA + (wv * 16) * 68 + wv * 16 + zoff;
      float t[16], ac[16], an[16];
      t[0] = (lane == 0) ? 1.f : 0.f;
      sTf[(wv * 16) * 68 + wv * 16 + lane] = t[0];
      ac[0] = Ab[68];
#pragma unroll
      for (int i = 1; i < 16; ++i) {
        if (i + 1 < 16) {
#pragma unroll
          for (int j = 0; j <= i; ++j) an[j] = Ab[(i + 1) * 68 + j];
        }
        float a = (lane == i) ? 1.f : 0.f;
#pragma unroll
        for (int j = 0; j < i; ++j) a -= ac[j] * t[j];
        t[i] = a;
        sTf[(wv * 16 + i) * 68 + wv * 16 + lane] = a;
        if (i + 1 < 16) {
#pragma unroll
          for (int j = 0; j <= i; ++j) ac[j] = an[j];
        }
        __builtin_amdgcn_sched_barrier(0);
      }
    }
    __syncthreads();
    if (wv < 2) {
      const int o = wv * 32;
      const f32x4 c = mm16(sA, o + 16, o, sTf, o, o, 16, fr, fq);
#pragma unroll
      for (int r = 0; r < 4; ++r) sY[(o + 16 + fq * 4 + r) * 68 + o + fr] = c[r];
    }
    __syncthreads();
    if (wv < 2) {
      const int o = wv * 32;
      const f32x4 c = mm16(sTf, o + 16, o + 16, sY, o + 16, o, 16, fr, fq);
#pragma unroll
      for (int r = 0; r < 4; ++r) sTf[(o + 16 + fq * 4 + r) * 68 + o + fr] = -c[r];
    }
    __syncthreads();
    if (wv < 4) {
      const int bi = wv >> 1, bj = wv & 1;
      const f32x4 c = mm16(sA, 32 + bi * 16, 0, sTf, 0, bj * 16, 32, fr, fq);
#pragma unroll
      for (int r = 0; r < 4; ++r) sY[(32 + bi * 16 + fq * 4 + r) * 68 + bj * 16 + fr] = c[r];
    }
    __syncthreads();
    if (wv < 4) {
      const int bi = wv >> 1, bj = wv & 1;
      const f32x4 c = mm16(sTf, 32 + bi * 16, 32, sY, 32, bj * 16, 32, fr, fq);
#pragma unroll
      for (int r = 0; r < 4; ++r) sTf[(32 + bi * 16 + fq * 4 + r) * 68 + bj * 16 + fr] = -c[r];
    }
    __syncthreads();
    {
      const int i = tid >> 3, j0 = (tid & 7) * 8;
      float v[8];
#pragma unroll
      for (int e = 0; e < 8; ++e) v[e] = sTf[i * 68 + j0 + e];
      uint4 o;
      o.x = pack2(v[0], v[1]); o.y = pack2(v[2], v[3]); o.z = pack2(v[4], v[5]); o.w = pack2(v[6], v[7]);
      *reinterpret_cast<uint4*>(sT + i * 72 + j0) = o;
    }
  }
  __syncthreads();
  {
    const int ib = wv >> 1;
#pragma unroll
    for (int x = 0; x < 4; ++x) {
      const int dvb = (wv & 1) * 4 + x;
      f32x4 c = {0.f, 0.f, 0.f, 0.f};
#pragma unroll
      for (int kk = 0; kk < 2; ++kk)
        c = mfma16(ldfrag(sT, 72, ib * 16 + fr, kk * 32 + fq * 8), ldfrag(sVBT, 72, dvb * 16 + fr, kk * 32 + fq * 8), c);
      *reinterpret_cast<uint2*>(UTd + (((dvb * 4 + ib) * 64 + lane) << 2)) = pack4(c[0], c[1], c[2], c[3]);
    }
#pragma unroll
    for (int ib2 = 0; ib2 < 4; ++ib2) {
      f32x4 c = {0.f, 0.f, 0.f, 0.f};
#pragma unroll
      for (int kk = 0; kk < 2; ++kk)
        c = mfma16(ldfrag(sKBGT, 72, wv * 16 + fr, kk * 32 + fq * 8), ldfrag(sT, 72, ib2 * 16 + fr, kk * 32 + fq * 8), c);
      *reinterpret_cast<uint2*>(Wd + ((((ib2 * 4 + (wv >> 1)) * 64) + ((wv & 1) * 2 + (fq >> 1)) * 16 + fr) << 3) + (fq & 1) * 4) = pack4(c[0], c[1], c[2], c[3]);
    }
  }
  __syncthreads();
  {
    unsigned tacc = 0;
    touch_use(tacc, tch);
    if (tacc == 0x9e3779b9u) ((volatile float*)EGL)[NITEM + 9] = 1.f;
  }
}

__device__ __forceinline__ void gdn_scan(const Params& p, int layer, int widx, unsigned char* smem) {
  const int tid = opaque_tid() & 511, wv = __builtin_amdgcn_readfirstlane(tid >> 6), lane = tid & 63, fr = lane & 15, fq = lane >> 4;
  const bool is_prompt = widx < 128;
  int s, h, sl, nsteps, cid0;
  if (is_prompt) { s = widx >> 5; h = (widx >> 2) & 7; sl = widx & 3; nsteps = 129; cid0 = s * 129; }
  else { const int j = widx - 128; s = j >> 5; h = (j >> 2) & 7; sl = j & 3; nsteps = 1; cid0 = 516 + s; }
  const int dv0 = sl * 32;
  u16* sST = (u16*)smem;
  u16* sVT = sST + 32 * 136;
  u16* sO = sVT + 32 * 72;
  const u16* R1g = (const u16*)((const unsigned char*)p.out);
  const u16* R2g = (const u16*)(p.ws + OFF_QK);
  const float* EGL = (const float*)(p.ws + OFF_EGL);
  const long slot0 = item_slot(cid0, h);
  const int rowbase = is_prompt ? s * TP : ROWS_P + s * 64;
  u16* ymix = (u16*)(p.ws + OFF_YMIX);

  f32x4 accS[2];
#pragma unroll
  for (int nb = 0; nb < 2; ++nb) {
    if (is_prompt) { accS[nb][0] = 0.f; accS[nb][1] = 0.f; accS[nb][2] = 0.f; accS[nb][3] = 0.f; }
    else {
      const float4 v = *reinterpret_cast<const float4*>(p.sdel + ((long)(layer * 8 + s) * 8 + h) * 16384 + (wv * 16 + fr) * 128 + dv0 + nb * 16 + fq * 4);
      accS[nb][0] = v.x; accS[nb][1] = v.y; accS[nb][2] = v.z; accS[nb][3] = v.w;
    }
#pragma unroll
    for (int r = 0; r < 4; ++r) sST[(nb * 16 + fq * 4 + r) * 136 + wv * 16 + fr] = f2bf(accS[nb][r]);
  }
  __syncthreads();
  const int part = wv >> 2;
  const int ib = wv & 3;
  int zoff;
  asm volatile("v_mov_b32 %0, 0" : "=v"(zoff));
#define LDS_BAR() asm volatile("s_waitcnt lgkmcnt(0)\n\ts_barrier" ::: "memory")
#define SCAN_LOAD(IT, F, G, KPF, UU0, UU1, EG) do { \
    const u16* R1p = R1g + (IT) * 24576; const u16* R2p = R2g + (IT) * 12288; \
    _Pragma("unroll") for (int kk = 0; kk < 2; ++kk) \
      KPF[kk] = *reinterpret_cast<const bf16x8*>(R1p + 16384 + (((wv * 2 + kk) * 64 + lane) << 3)); \
    EG = EGL[(IT) + zoff]; \
    { const u16* Fp = R1p + part * 8192;     \
      _Pragma("unroll") for (int kk = 0; kk < 4; ++kk) \
        F[kk] = *reinterpret_cast<const bf16x8*>(Fp + (((ib * 4 + kk) * 64 + lane) << 3)); } \
    if (part == 0) { \
      UU0 = *reinterpret_cast<const uint2*>(R2p + ((((sl * 2) * 4 + ib) * 64 + lane) << 2)); \
      UU1 = *reinterpret_cast<const uint2*>(R2p + ((((sl * 2 + 1) * 4 + ib) * 64 + lane) << 2)); \
    } else { \
      _Pragma("unroll") for (int kk = 0; kk < 2; ++kk) \
        G[kk] = *reinterpret_cast<const bf16x8*>(R2p + 8192 + (((ib * 2 + kk) * 64 + lane) << 3)); } } while (0)
#define SCAN_FLUSH(PROW0, PNV) do { \
    if (tid < 256) { const int i_ = tid >> 2, sg_ = tid & 3; \
      if (i_ < (PNV)) *reinterpret_cast<uint4*>(ymix + (long)((PROW0) + i_) * DM + 1024 + h * 128 + dv0 + sg_ * 8) = \
          *reinterpret_cast<const uint4*>(sO + i_ * 40 + sg_ * 8); } } while (0)
#define SCAN_STEP(STEP, F, G, KPF, UU0, UU1, EGLV, FN, GN, KPFN, UU0N, UU1N, EGLN) do { \
    const int row0 = (is_prompt && (STEP) > 0) ? rowbase + 16 + ((STEP) - 1) * 64 : rowbase; \
    const int nvalid = (is_prompt && (STEP) == 0) ? 16 : 64; \
    { const long itn = slot0 + min((STEP) + 2, nsteps - 1); \
      SCAN_LOAD(itn, FN, GN, KPFN, UU0N, UU1N, EGLN); } \
    if ((STEP) > 0) SCAN_FLUSH(prow0, pnv); \
    f32x4 c0 = {0.f, 0.f, 0.f, 0.f}, c1 = {0.f, 0.f, 0.f, 0.f}; \
    _Pragma("unroll") for (int kk = 0; kk < 4; ++kk) { \
      c0 = mfma16(F[kk], ldfrag(sST, 136, fr, kk * 32 + fq * 8), c0); \
      c1 = mfma16(F[kk], ldfrag(sST, 136, 16 + fr, kk * 32 + fq * 8), c1); } \
    if (part == 0) { \
      float u0[4], u1[4]; \
      unpack4(UU0, u0); unpack4(UU1, u1); \
      *reinterpret_cast<uint2*>(sVT + fr * 72 + ib * 16 + fq * 4) = pack4(u0[0] - c0[0], u0[1] - c0[1], u0[2] - c0[2], u0[3] - c0[3]); \
      *reinterpret_cast<uint2*>(sVT + (16 + fr) * 72 + ib * 16 + fq * 4) = pack4(u1[0] - c1[0], u1[1] - c1[1], u1[2] - c1[2], u1[3] - c1[3]); } \
    LDS_BAR(); \
    _Pragma("unroll") for (int nb = 0; nb < 2; ++nb) { \
      f32x4 c = accS[nb]; \
      c[0] *= EGLV; c[1] *= EGLV; c[2] *= EGLV; c[3] *= EGLV; \
      _Pragma("unroll") for (int kk = 0; kk < 2; ++kk) \
        c = mfma16(ldfrag(sVT, 72, nb * 16 + fr, kk * 32 + fq * 8), KPF[kk], c); \
      accS[nb] = c; \
      _Pragma("unroll") for (int r = 0; r < 4; ++r) sST[(nb * 16 + fq * 4 + r) * 136 + wv * 16 + fr] = f2bf(c[r]); } \
    if (part == 1) { \
      _Pragma("unroll") for (int kk = 0; kk < 2; ++kk) { \
        c0 = mfma16(G[kk], ldfrag(sVT, 72, fr, kk * 32 + fq * 8), c0); \
        c1 = mfma16(G[kk], ldfrag(sVT, 72, 16 + fr, kk * 32 + fq * 8), c1); } \
      _Pragma("unroll") for (int r = 0; r < 4; ++r) { \
        sO[(ib * 16 + fq * 4 + r) * 40 + fr] = f2bf(c0[r]); \
        sO[(ib * 16 + fq * 4 + r) * 40 + 16 + fr] = f2bf(c1[r]); } } \
    LDS_BAR(); \
    prow0 = row0; pnv = nvalid; } while (0)
  bf16x8 fA[4], gA[2], kpfA[2]; uint2 u0A, u1A; float eglA;
  bf16x8 fB[4], gB[2], kpfB[2]; uint2 u0B, u1B; float eglB;
  bf16x8 fC[4], gC[2], kpfC[2]; uint2 u0C, u1C; float eglC;
  int prow0 = 0, pnv = 0;
  SCAN_LOAD(slot0, fA, gA, kpfA, u0A, u1A, eglA);
  SCAN_LOAD(slot0 + min(1, nsteps - 1), fB, gB, kpfB, u0B, u1B, eglB);
  for (int step = 0; step < nsteps; step += 3) {
    SCAN_STEP(step, fA, gA, kpfA, u0A, u1A, eglA, fC, gC, kpfC, u0C, u1C, eglC);
    if (step + 1 < nsteps) SCAN_STEP(step + 1, fB, gB, kpfB, u0B, u1B, eglB, fA, gA, kpfA, u0A, u1A, eglA);
    if (step + 2 < nsteps) SCAN_STEP(step + 2, fC, gC, kpfC, u0C, u1C, eglC, fB, gB, kpfB, u0B, u1B, eglB);
  }
  SCAN_FLUSH(prow0, pnv);
#undef SCAN_STEP
#undef SCAN_FLUSH
#undef SCAN_LOAD
  float* dst = p.out + (is_prompt ? PD_OFF + ((long)(layer * 4 + s) * 8 + h) * 16384 : SD_OFF + ((long)(layer * 8 + s) * 8 + h) * 16384);
#pragma unroll
  for (int nb = 0; nb < 2; ++nb)
    *reinterpret_cast<float4*>(dst + (wv * 16 + fr) * 128 + dv0 + nb * 16 + fq * 4) = make_float4(accS[nb][0], accS[nb][1], accS[nb][2], accS[nb][3]);
  __syncthreads();
}

constexpr int NUNIT = 4 * 513 + 32;
__device__ __forceinline__ void mixer_a_group(const Params& p, int layer, int ug) {
  const int tid = opaque_tid() & 511;
  const int uid = ug * 4 + (tid >> 7);
  if (uid >= NUNIT) return;
  const int c0 = (tid & 127) * 8;
  int row0, sidx; bool first, last, samp;
  if (uid < 2052) { sidx = uid / 513; const int k = uid - sidx * 513; row0 = sidx * TP + 16 * k; first = (k == 0); last = (k == 512); samp = false; }
  else { const int v = uid - 2052; sidx = v >> 2; const int k = v & 3; row0 = ROWS_P + sidx * 64 + 16 * k; first = (k == 0); last = (k == 3); samp = true; }
  const u16* proj = (const u16*)(p.ws + OFF_PROJ);
  u16* ymix = (u16*)(p.ws + OFF_YMIX);
  float w0[8], w1[8], w2[8], um2[8], um1[8];
  {
    const float* cw = p.cvaw + (long)layer * 3 * 1024 + c0;
#pragma unroll
    for (int e = 0; e < 8; ++e) { w0[e] = cw[e]; w1[e] = cw[1024 + e]; w2[e] = cw[2048 + e]; }
  }
  if (first) {
    if (samp) {
      const float* st = p.sca + (long)(layer * 8 + sidx) * 2 * 1024 + c0;
#pragma unroll
      for (int e = 0; e < 8; ++e) { um2[e] = st[e]; um1[e] = st[1024 + e]; }
    } else {
#pragma unroll
      for (int e = 0; e < 8; ++e) { um2[e] = 0.f; um1[e] = 0.f; }
    }
  } else {
    float c[8], x[8];
    unpack8(*reinterpret_cast<const uint4*>(proj + (long)(row0 - 2) * NP + 1024 + c0), c);
    unpack8(*reinterpret_cast<const uint4*>(proj + (long)(row0 - 2) * NP + 2048 + c0), x);
#pragma unroll
    for (int e = 0; e < 8; ++e) um2[e] = c[e] * x[e];
    unpack8(*reinterpret_cast<const uint4*>(proj + (long)(row0 - 1) * NP + 1024 + c0), c);
    unpack8(*reinterpret_cast<const uint4*>(proj + (long)(row0 - 1) * NP + 2048 + c0), x);
#pragma unroll
    for (int e = 0; e < 8; ++e) um1[e] = c[e] * x[e];
  }
  for (int t0 = 0; t0 < 16; t0 += 4) {
    uint4 rbv[4], rcv[4], rxv[4], rzv[4];
#pragma unroll
    for (int q = 0; q < 4; ++q) {
      const long rb = (long)(row0 + t0 + q) * NP + c0;
      rbv[q] = *reinterpret_cast<const uint4*>(proj + rb);
      rcv[q] = *reinterpret_cast<const uint4*>(proj + rb + 1024);
      rxv[q] = *reinterpret_cast<const uint4*>(proj + rb + 2048);
      rzv[q] = *reinterpret_cast<const uint4*>(proj + rb + 3072);
    }
#pragma unroll
    for (int q = 0; q < 4; ++q) {
      float b[8], c[8], x[8], z[8], y[8];
      unpack8(rbv[q], b); unpack8(rcv[q], c); unpack8(rxv[q], x); unpack8(rzv[q], z);
#pragma unroll
      for (int e = 0; e < 8; ++e) {
        const float u = c[e] * x[e];
        const float cv = w0[e] * um2[e] + w1[e] * um1[e] + w2[e] * u;
        y[e] = b[e] * cv * silu_f(z[e]);
        um2[e] = um1[e]; um1[e] = u;
      }
      uint4 o;
      o.x = pack2(y[0], y[1]); o.y = pack2(y[2], y[3]); o.z = pack2(y[4], y[5]); o.w = pack2(y[6], y[7]);
      *reinterpret_cast<uint4*>(ymix + (long)(row0 + t0 + q) * DM + c0) = o;
    }
  }
  if (last) {
    float* dst = p.out + (samp ? SCA_OFF + (long)(layer * 8 + sidx) * 2 * 1024 : PCA_OFF + (long)(layer * 4 + sidx) * 2 * 1024) + c0;
#pragma unroll
    for (int e = 0; e < 8; ++e) { dst[e] = um2[e]; dst[1024 + e] = um1[e]; }
  }
}

__device__ __forceinline__ void phase_post(const Params& p, int layer) {
  const int tid = opaque_tid() & 511;
  const u16* proj = (const u16*)(p.ws + OFF_PROJ);
  u16* ymix = (u16*)(p.ws + OFF_YMIX);
  const int hh = (tid >> 4) & 7, d = (tid & 15) * 8;
  float w[8];
#pragma unroll
  for (int e = 0; e < 8; ++e) w[e] = p.onw[layer * 128 + d + e];
  for (int g = blockIdx.x; g < ROWS / 4; g += gridDim.x) {
    const int row = g * 4 + (tid >> 7);
    u16* op = ymix + (long)row * DM + 1024 + hh * 128 + d;
    float o[8], z[8];
    unpack8(*reinterpret_cast<const uint4*>(op), o);
    unpack8(*reinterpret_cast<const uint4*>(proj + (long)row * NP + 7168 + hh * 128 + d), z);
    float ss = 0.f;
#pragma unroll
    for (int e = 0; e < 8; ++e) ss += o[e] * o[e];
    ss += __shfl_xor(ss, 1); ss += __shfl_xor(ss, 2); ss += __shfl_xor(ss, 4); ss += __shfl_xor(ss, 8);
    const float rs = rsqrtf(ss * (1.f / 128.f) + EPS);
    float y[8];
#pragma unroll
    for (int e = 0; e < 8; ++e) y[e] = o[e] * rs * w[e] * silu_f(z[e]);
    uint4 ov;
    ov.x = pack2(y[0], y[1]); ov.y = pack2(y[2], y[3]); ov.z = pack2(y[4], y[5]); ov.w = pack2(y[6], y[7]);
    *reinterpret_cast<uint4*>(op) = ov;
  }
}

__device__ __forceinline__ void phase_final(const Params& p) {
  const int tid = opaque_tid() & 511, wv = tid >> 6, lane = tid & 63;
  const float* sumsq = (const float*)(p.ws + OFF_SUMSQ) + 2L * ROWSP;
  for (int r = blockIdx.x * 8 + wv; r < ROWS; r += gridDim.x * 8) {
    float* dst;
    if (r < ROWS_P) {
      const int b = r / TP, t = r - b * TP;
      if (t < 16) continue;
      dst = p.out + ((long)b * 8192 + (t - 16)) * DM;
    } else {
      dst = p.out + YS_OFF + (long)(r - ROWS_P) * DM;
    }
    const float rs = rsqrtf(sumsq[r] * (1.f / DM) + EPS);
#pragma unroll
    for (int i = 0; i < 8; ++i) {
      const int c = (i * 64 + lane) * 4;
      float4 v = *reinterpret_cast<const float4*>(dst + c);
      const float4 w = *reinterpret_cast<const float4*>(p.fnw + c);
      v.x *= rs * w.x; v.y *= rs * w.y; v.z *= rs * w.z; v.w *= rs * w.w;
      *reinterpret_cast<float4*>(dst + c) = v;
    }
  }
}

#define XB_TMO      128
#define XB_XCNT(j)  (256  + 64 * (j))
#define XB_XSUB(j)  (1280 + 64 * (j))
#define XB_XGEN(j)  (2304 + 64 * (j))
#define XB_TOP      3328
#define XB_TOPGEN   3392
#define XCD_BAR_WORDS 3456
#define XB_SPIN_CAP (1u << 18)
#define LAS __attribute__((address_space(3)))
__device__ __forceinline__ unsigned xb_ld(unsigned* p)              { return __hip_atomic_load(p, __ATOMIC_RELAXED, __HIP_MEMORY_SCOPE_AGENT); }
__device__ __forceinline__ unsigned xb_add(unsigned* p, unsigned v) { return __hip_atomic_fetch_add(p, v, __ATOMIC_RELAXED, __HIP_MEMORY_SCOPE_AGENT); }
__device__ __forceinline__ unsigned xb_xcc_id() { return (unsigned)__builtin_amdgcn_s_getreg((3 << 11) | 20) & 0xFu; }
#define XB_SPIN(cond, bar) do { unsigned _sp = 0; while (cond) { __builtin_amdgcn_s_sleep(1); \
    if ((++_sp & 255u) == 0u) { if (xb_ld(&(bar)[XB_TMO])) break; if (_sp > XB_SPIN_CAP) { atomicAdd(&(bar)[XB_TMO], 1u); break; } } } } while (0)
struct XcdBarrier { unsigned* bar; unsigned x; volatile LAS unsigned* st; };
__device__ __forceinline__ XcdBarrier xcd_barrier_post(unsigned* bar, volatile LAS unsigned* st) {
  XcdBarrier b; b.bar = bar; b.x = xb_xcc_id(); b.st = st;
  if (threadIdx.x == 0) (void)xb_add(&bar[XB_XCNT(b.x)], 1u);
  return b;
}
__device__ __forceinline__ void xcd_barrier_complete(unsigned* bar, unsigned x, unsigned& nloc, unsigned& nx) {
  const unsigned G = gridDim.x * gridDim.y * gridDim.z;
  unsigned sum, cnt, mine, sp = 0u;
  for (;;) {
    sum = 0u; cnt = 0u; mine = 0u;
#pragma unroll
    for (unsigned j = 0; j < 16; ++j) { const unsigned c = xb_ld(&bar[XB_XCNT(j)]); sum += c; cnt += (c > 0u) ? 1u : 0u; mine = (j == x) ? c : mine; }
    if (sum == G) break;
    __builtin_amdgcn_s_sleep(1);
    if ((++sp & 255u) == 0u) { if (xb_ld(&bar[XB_TMO])) break; if (sp > XB_SPIN_CAP) { atomicAdd(&bar[XB_TMO], 1u); break; } }
  }
  nloc = mine > 0u ? mine : 1u; nx = cnt > 0u ? cnt : 1u;
}
__device__ __forceinline__ void xcd_barrier(const XcdBarrier& b) {
  asm volatile("s_waitcnt vmcnt(0)" ::: "memory");
  __syncthreads();
  if (threadIdx.x == 0) {
    unsigned* bar = b.bar;
    __builtin_amdgcn_s_waitcnt(0);
    unsigned nloc = b.st[0], nx = b.st[1];
    if (nloc == 0u) { xcd_barrier_complete(bar, b.x, nloc, nx); b.st[0] = nloc; b.st[1] = nx; }
    const unsigned old = xb_add(&bar[XB_XSUB(b.x)], 1u);
    const unsigned gen = old / nloc;
    if (old + 1u == (gen + 1u) * nloc) {
      __builtin_amdgcn_fence(__ATOMIC_RELEASE, "agent");
      asm volatile("s_waitcnt vmcnt(0)" ::: "memory");
      const unsigned og = xb_add(&bar[XB_TOP], 1u);
      const unsigned tg = og / nx;
      if (og + 1u == (tg + 1u) * nx) xb_add(&bar[XB_TOPGEN], 1u);
      else XB_SPIN(xb_ld(&bar[XB_TOPGEN]) == tg, bar);
      __builtin_amdgcn_fence(__ATOMIC_ACQUIRE, "agent");
      xb_add(&bar[XB_XGEN(b.x)], 1u);
      asm volatile("s_waitcnt vmcnt(0)" ::: "memory");
    } else {
      XB_SPIN(xb_ld(&bar[XB_XGEN(b.x)]) == gen, bar);
      __builtin_amdgcn_fence(__ATOMIC_ACQUIRE, "agent");
      asm volatile("s_waitcnt vmcnt(0)" ::: "memory");
    }
  }
  __syncthreads();
}

typedef const __attribute__((address_space(4))) Params* CParamsPtr;
__device__ __forceinline__ Params ldparams(CParamsPtr q) {
#if defined(__HIP_DEVICE_COMPILE__)
  asm volatile("" : "+s"(q));
  Params r;
  r.xp = q->xp; r.xs = q->xs; r.sca = q->sca; r.scq = q->scq; r.sdel = q->sdel; r.meta = q->meta; r.normw = q->normw; r.win = q->win;
  r.cvaw = q->cvaw; r.cvqw = q->cvqw; r.alog = q->alog; r.dtb = q->dtb; r.onw = q->onw; r.wout = q->wout; r.fnw = q->fnw;
  r.out = q->out; r.ws = q->ws;
  return r;
#else
  return Params{};
#endif
}

__global__ void __launch_bounds__(512) mega(Params p_unused) {
  extern __shared__ __attribute__((aligned(16))) unsigned char smem[];
  cg::grid_group grid = cg::this_grid();
  CParamsPtr kp = (CParamsPtr)__builtin_amdgcn_kernarg_segment_ptr();
  volatile LAS unsigned* xst = (volatile LAS unsigned*)(smem + 147440);
  if (threadIdx.x < 2) xst[threadIdx.x] = 0u;
  __syncthreads();
  XcdBarrier xb;
  { const Params p = ldparams(kp); xb = xcd_barrier_post((unsigned*)(p.ws + OFF_BAR), xst); }
  { const Params p = ldparams(kp); phase_prep(p, smem); }
  grid.sync();
  for (int layer = 0; layer < 2; ++layer) {
    { const Params p = ldparams(kp); gemm_phase<1>(p, layer, smem); }
    xcd_barrier(xb);
    { const Params p = ldparams(kp); for (int item = blockIdx.x; item < NITEM; item += gridDim.x) chunk_prep(p, layer, item, smem); }
    xcd_barrier(xb);
    {
      const Params p = ldparams(kp);
      const int G = gridDim.x, b = blockIdx.x;
      if (G >= 256) {
        if (b < 128) gdn_scan(p, layer, (((b & 7) + 8 * (b >> 5)) << 2) + ((b >> 3) & 3), smem);
        else {
          if (b < 256) { gdn_scan(p, layer, b, smem); gdn_scan(p, layer, b + 128, smem); }
          for (int ug = b - 128; ug < (NUNIT + 3) / 4; ug += G - 128) mixer_a_group(p, layer, ug);
        }
      } else {
        for (int w = b; w < 384; w += G) gdn_scan(p, layer, w, smem);
        for (int ug = b; ug < (NUNIT + 3) / 4; ug += G) mixer_a_group(p, layer, ug);
      }
    }
    xcd_barrier(xb);
    { const Params p = ldparams(kp); phase_post(p, layer); }
    xcd_barrier(xb);
    { const Params p = ldparams(kp); if (layer == 0) gemm_phase<2>(p, layer, smem); else gemm_phase<3>(p, layer, smem); }
    xcd_barrier(xb);
  }
  { const Params p = ldparams(kp); phase_final(p); }
}

extern "C" void kernel_launch(void* const* d_in, const int* in_sizes, int n_in,
                              void* d_out, int out_size, void* d_ws, size_t ws_size,
                              hipStream_t stream) {
  constexpr size_t kLds = 147456;
  static int grid_blocks = 0;
  if (!grid_blocks) {
    int dev = 0, cus = 0, per_cu = 0;
    (void)hipGetDevice(&dev);
    (void)hipDeviceGetAttribute(&cus, hipDeviceAttributeMultiprocessorCount, dev);
    (void)hipFuncSetAttribute((const void*)mega, hipFuncAttributeMaxDynamicSharedMemorySize, (int)kLds);
    (void)hipOccupancyMaxActiveBlocksPerMultiprocessor(&per_cu, (const void*)mega, 512, kLds);
    if (per_cu < 1) per_cu = 1;
    grid_blocks = cus * per_cu;
    if (ws_size < (size_t)WS_END) fprintf(stderr, "workspace too small: %zu < %ld\n", ws_size, WS_END);
  }
  Params p{};
  p.xp = (const float*)d_in[0]; p.xs = (const float*)d_in[1]; p.sca = (const float*)d_in[2]; p.scq = (const float*)d_in[3];
  p.sdel = (const float*)d_in[4]; p.meta = (const float*)d_in[5]; p.normw = (const float*)d_in[6]; p.win = (const float*)d_in[7];
  p.cvaw = (const float*)d_in[8]; p.cvqw = (const float*)d_in[9]; p.alog = (const float*)d_in[10]; p.dtb = (const float*)d_in[11];
  p.onw = (const float*)d_in[12]; p.wout = (const float*)d_in[13]; p.fnw = (const float*)d_in[14];
  p.out = (float*)d_out; p.ws = (unsigned char*)d_ws;
  (void)hipMemsetAsync((unsigned char*)d_ws + OFF_BAR, 0, XCD_BAR_WORDS * sizeof(unsigned), stream);
  void* args[] = {&p};
  hipError_t e = hipLaunchCooperativeKernel((void*)mega, dim3(grid_blocks), dim3(512), args, kLds, stream);
  if (e != hipSuccess) fprintf(stderr, "cooperative launch failed: %s (grid %d)\n", hipGetErrorString(e), grid_blocks);
}
```

```cpp
#include <hip/hip_runtime.h>
#include <hip/hip_bf16.h>
#include <hip/hip_cooperative_groups.h>
#include <cstdio>
namespace cg = cooperative_groups;

typedef unsigned short u16;
using bf16x8 = __attribute__((ext_vector_type(8))) short;
using f32x4 = __attribute__((ext_vector_type(4))) float;

constexpr int DM = 2048;
constexpr int NP = 8208;
constexpr int NPP = 8448;
constexpr int TP = 8208;
constexpr int ROWS_P = 4 * TP;
constexpr int ROWS = ROWS_P + 512;
constexpr int ROWSP = 33536;
constexpr int NCHUNK = 524;
constexpr int NITEM = NCHUNK * 8;
constexpr float EPS = 1e-6f;

constexpr long OFF_WTIN = 0;
constexpr long OFF_WTOUT = OFF_WTIN + 2L * NPP * DM * 2;
constexpr long OFF_HB = OFF_WTOUT + 2L * DM * DM * 2;
constexpr long OFF_PROJ = OFF_HB + (long)ROWSP * DM * 2;
constexpr long OFF_YMIX = OFF_PROJ + (long)ROWS * NP * 2;
constexpr long OFF_SUMSQ = OFF_YMIX + (long)ROWSP * DM * 2;
constexpr long OFF_EGL = OFF_SUMSQ + 3L * ROWSP * 4;
constexpr long OFF_QK = OFF_EGL + 16896;
constexpr long OFF_UT = OFF_QK + (long)NITEM * 4096 * 2;
constexpr long OFF_BAR = OFF_UT + (long)NITEM * 8192 * 2;
constexpr long WS_END = OFF_BAR + 16384;
constexpr long OOFF_W = 0;
constexpr long OOFF_QG = OOFF_W + (long)NITEM * 8192 * 2;
constexpr long OOFF_KPT = OOFF_QG + (long)NITEM * 8192 * 2;
constexpr long YS_OFF = 67108864L;
constexpr long PCA_OFF = YS_OFF + 1048576L;
constexpr long PCQ_OFF = PCA_OFF + 16384L;
constexpr long PD_OFF = PCQ_OFF + 73728L;
constexpr long SCA_OFF = PD_OFF + 1048576L;
constexpr long SCQ_OFF = SCA_OFF + 32768L;
constexpr long SD_OFF = SCQ_OFF + 147456L;

struct Params {
  const float *xp, *xs, *sca, *scq, *sdel, *meta, *normw, *win, *cvaw, *cvqw, *alog, *dtb, *onw, *wout, *fnw;
  float* out;
  unsigned char* ws;
};

typedef __bf16 bf16x2_t __attribute__((ext_vector_type(2)));
typedef float f32x2_t __attribute__((ext_vector_type(2)));
__device__ __forceinline__ unsigned pack2(float a, float b) {
#if defined(__HIP_DEVICE_COMPILE__)
  f32x2_t v = {a, b};
  return __builtin_bit_cast(unsigned, __builtin_convertvector(v, bf16x2_t));
#else
  return 0u;
#endif
}
__device__ __forceinline__ u16 f2bf(float f) { return (u16)(pack2(f, 0.f) & 0xffffu); }
__device__ __forceinline__ int opaque_tid() { int t; asm volatile("v_mov_b32 %0, %1" : "=v"(t) : "v"((int)threadIdx.x)); return t; }
__device__ __forceinline__ float bf2f(u16 h) { return __uint_as_float(((unsigned)h) << 16); }
__device__ __forceinline__ uint2 pack4(float a, float b, float c, float d) { return make_uint2(pack2(a, b), pack2(c, d)); }
__device__ __forceinline__ void unpack4(uint2 v, float* o) {
  o[0] = __uint_as_float(v.x << 16); o[1] = __uint_as_float(v.x & 0xffff0000u);
  o[2] = __uint_as_float(v.y << 16); o[3] = __uint_as_float(v.y & 0xffff0000u);
}
__device__ __forceinline__ void unpack8(uint4 v, float* o) {
  o[0] = __uint_as_float(v.x << 16); o[1] = __uint_as_float(v.x & 0xffff0000u);
  o[2] = __uint_as_float(v.y << 16); o[3] = __uint_as_float(v.y & 0xffff0000u);
  o[4] = __uint_as_float(v.z << 16); o[5] = __uint_as_float(v.z & 0xffff0000u);
  o[6] = __uint_as_float(v.w << 16); o[7] = __uint_as_float(v.w & 0xffff0000u);
}
__device__ __forceinline__ float silu_f(float x) { return x * __frcp_rn(1.f + __expf(-x)); }
__device__ __forceinline__ f32x4 mfma16(bf16x8 a, bf16x8 b, f32x4 c) {
  return __builtin_amdgcn_mfma_f32_16x16x32_bf16(a, b, c, 0, 0, 0);
}
__device__ __forceinline__ bf16x8 ldfrag(const u16* base, int stride, int row, int k) {
  return *reinterpret_cast<const bf16x8*>(base + row * stride + k);
}

__device__ __forceinline__ void l2_touch(const void* ptr) {
  (void)ptr;
}
__device__ __forceinline__ unsigned touch_ld(const void* ptr) { return *reinterpret_cast<const unsigned*>(ptr); }
__device__ __forceinline__ void touch_use(unsigned& acc, unsigned v) { asm volatile("v_add_u32 %0, %0, %1" : "+v"(acc) : "v"(v)); }

__device__ __forceinline__ f32x4 mm16(const float* X, int xr, int xc, const float* Y, int yr, int yc, int kn, int fr, int fq) {
  f32x4 c = {0.f, 0.f, 0.f, 0.f};
  for (int k0 = 0; k0 < kn; k0 += 4) {
    const float a = X[(xr + fr) * 68 + xc + k0 + fq];
    const float b = Y[(yr + k0 + fq) * 68 + yc + fr];
    c = __builtin_amdgcn_mfma_f32_16x16x4f32(a, b, c, 0, 0, 0);
  }
  return c;
}

__device__ __forceinline__ void transpose_tiles(const float* __restrict__ src, u16* __restrict__ dst, const float* __restrict__ scale,
                                                int nsrc, int ntile_n, unsigned char* smem, int widx, int wcnt) {
  float* tile = (float*)smem;
  const int tid = opaque_tid();
  const int ntiles = 32 * ntile_n;
  for (int t = widx; t < ntiles; t += wcnt) {
    const int kt = t & 31, nt = t >> 5;
    const int k0 = kt * 64, n0 = nt * 64;
    {
      const int nl = tid & 63, kb = tid >> 6;
#pragma unroll
      for (int it = 0; it < 8; ++it) {
        const int kl = kb + it * 8;
        const int n = n0 + nl;
        float v = 0.f;
        if (n < nsrc) v = src[(long)(k0 + kl) * nsrc + n] * (scale ? scale[k0 + kl] : 1.f);
        tile[kl * 65 + nl] = v;
      }
    }
    __syncthreads();
    {
      const int nl = tid >> 3, kg = tid & 7;
      float v[8];
#pragma unroll
      for (int e = 0; e < 8; ++e) v[e] = tile[(kg * 8 + e) * 65 + nl];
      uint4 o;
      o.x = pack2(v[0], v[1]); o.y = pack2(v[2], v[3]); o.z = pack2(v[4], v[5]); o.w = pack2(v[6], v[7]);
      *reinterpret_cast<uint4*>(dst + (long)(n0 + nl) * DM + k0 + kg * 8) = o;
    }
    __syncthreads();
  }
}

__device__ __forceinline__ void phase_prep(const Params& p, unsigned char* smem) {
  const int tid = opaque_tid(), wv = tid >> 6, lane = tid & 63;
  u16* hb = (u16*)(p.ws + OFF_HB);
  float* sumsq = (float*)(p.ws + OFF_SUMSQ);
  for (int r = blockIdx.x * 8 + wv; r < ROWSP; r += gridDim.x * 8) {
    const float* src = nullptr;
    if (r < ROWS_P) {
      const int b = r / TP, t = r - b * TP;
      src = (t < 16) ? (p.meta + (long)t * DM) : (p.xp + ((long)b * 8192 + (t - 16)) * DM);
    } else if (r < ROWS) {
      src = p.xs + (long)(r - ROWS_P) * DM;
    }
    float ss = 0.f;
#pragma unroll
    for (int i = 0; i < 8; ++i) {
      const int c = (i * 64 + lane) * 4;
      float4 v = make_float4(0.f, 0.f, 0.f, 0.f);
      if (src) v = *reinterpret_cast<const float4*>(src + c);
      ss += v.x * v.x + v.y * v.y + v.z * v.z + v.w * v.w;
      *reinterpret_cast<uint2*>(hb + (long)r * DM + c) = pack4(v.x, v.y, v.z, v.w);
    }
#pragma unroll
    for (int o = 32; o > 0; o >>= 1) ss += __shfl_xor(ss, o);
    if (lane == 0) sumsq[r] = ss;
  }
  for (long i = (long)blockIdx.x * 512 + tid; i < 2L * ROWSP; i += (long)gridDim.x * 512) sumsq[ROWSP + i] = 0.f;
  transpose_tiles(p.win, (u16*)(p.ws + OFF_WTIN), p.normw, NP, NPP / 64, smem, blockIdx.x, gridDim.x);
  transpose_tiles(p.wout, (u16*)(p.ws + OFF_WTOUT), nullptr, DM, DM / 64, smem, blockIdx.x, gridDim.x);
}

constexpr int BM = 256, BK = 64, HALF = 128, HT = HALF * BK;

__device__ __forceinline__ int lds_byte(int r, int c) {
  int st = (r >> 4) * 2 + (c >> 5), rr = r & 15, cc = c & 31, ob = rr * 64 + cc * 2;
  return st * 1024 + (ob ^ (((ob >> 9) & 1) << 5));
}
__device__ __forceinline__ void stage_rc(int b, int& R, int& C) {
  int st = b / 1024, sb = b % 1024, swz = sb ^ (((sb >> 9) & 1) << 5);
  R = (st >> 1) * 16 + swz / 64; C = (st & 1) * 32 + (swz % 64) / 2;
}

template <int EPI>
__device__ __forceinline__ void gemm_phase(const Params& p, int layer, unsigned char* smem) {
  typedef __hip_bfloat16 bf16;
  bf16* shm = (bf16*)smem;
  const bf16* A = (const bf16*)(p.ws + (EPI == 1 ? OFF_HB : OFF_YMIX));
  const bf16* Bt = (EPI == 1) ? (const bf16*)(p.ws + OFF_WTIN) + (long)layer * NPP * DM
                              : (const bf16*)(p.ws + OFF_WTOUT) + (long)layer * DM * DM;
  constexpr int K = DM;
  constexpr int nM = ROWSP / BM;
  constexpr int nN = (EPI == 1) ? NPP / BM : DM / BM;
  constexpr int WGM = 4;
  constexpr int nwg = nM * nN;
#define SA(b, h) (shm + ((b) * 2 + (h)) * HT)
#define SB(b, h) (shm + (4 + (b) * 2 + (h)) * HT)
#define OA(b, h) ((((b) * 2 + (h)) * HT) * 2)
#define OB(b, h) (((4 + (b) * 2 + (h)) * HT) * 2)
#define STAGE(PO, BASE, br, kt) do { const char* _ub = (const char*)(BASE) + ((long)(br) * K + (long)(kt) * BK) * 2; \
      asm volatile("s_add_u32 m0, %0, %3\n\ts_nop 0\n\tglobal_load_lds_dwordx4 %1, %2" :: "s"(ldsw), "v"(soff0), "s"(_ub), "n"(PO) : "memory", "scc"); \
      asm volatile("s_add_u32 m0, %0, %3\n\ts_nop 0\n\tglobal_load_lds_dwordx4 %1, %2" :: "s"(ldsw), "v"(soff1), "s"(_ub), "n"((PO) + 8192) : "memory", "scc"); } while (0)
#define LDA(dst, b, h) for (int m = 0; m < 4; ++m) for (int k = 0; k < 2; ++k) \
    dst[m][k] = *reinterpret_cast<const bf16x8*>((char*)SA(b, h) + lds_byte(wr * 64 + m * 16 + fr, k * 32 + fq * 8))
#define LDB(dst, b, h) for (int n = 0; n < 2; ++n) for (int k = 0; k < 2; ++k) \
    dst[n][k] = *reinterpret_cast<const bf16x8*>((char*)SB(b, h) + lds_byte(wc * 32 + n * 16 + fr, k * 32 + fq * 8))
#define MMA(ai, bj, At, Bt_) do { __builtin_amdgcn_s_setprio(1); \
    for (int m = 0; m < 4; ++m) for (int n = 0; n < 2; ++n) for (int k = 0; k < 2; ++k) \
      acc[ai][bj][m][n] = __builtin_amdgcn_mfma_f32_16x16x32_bf16(At[m][k], Bt_[n][k], acc[ai][bj][m][n], 0, 0, 0); \
    __builtin_amdgcn_s_setprio(0); } while (0)
#define WAIT_V(n) asm volatile("s_waitcnt vmcnt(" #n ")" ::: "memory")
#define WAIT_L(n) asm volatile("s_waitcnt lgkmcnt(" #n ")" ::: "memory")
#define BAR __builtin_amdgcn_s_barrier()
#define SCHED __builtin_amdgcn_sched_barrier(0)

  const int gtid = opaque_tid() & 511;
  const int wid = __builtin_amdgcn_readfirstlane(gtid >> 6), lane = gtid & 63, wr = wid >> 2, wc = wid & 3, fr = lane & 15, fq = lane >> 4;
  unsigned soff0, soff1;
  { int _r, _c; stage_rc(gtid * 16, _r, _c); soff0 = (unsigned)(_r * K + _c) * 2u;
    stage_rc(gtid * 16 + 8192, _r, _c); soff1 = (unsigned)(_r * K + _c) * 2u; }
  const unsigned ldsw = (unsigned)(size_t)((__attribute__((address_space(3))) unsigned char*)smem) + (unsigned)wid * 1024u;
  int gdim = (int)gridDim.x;
  asm volatile("" : "+s"(gdim));
  int vb = blockIdx.x;
  if ((gdim & 7) == 0) vb = (blockIdx.x & 7) * (gdim >> 3) + (blockIdx.x >> 3);
  constexpr int nig = WGM * nN;
#define TILE_RC(wg, BR, BC) do { const int gid_ = (wg) / nig, fm_ = gid_ * WGM, gsz_ = min(nM - fm_, WGM); \
    BC = (fm_ + (((wg) % nig) % gsz_)) * BM; BR = (((wg) % nig) / gsz_) * BM; } while (0)
  int brow = 0, bcol = 0;
  if (vb < nwg) {
    TILE_RC(vb, brow, bcol);
    STAGE(OB(0, 0), A, bcol, 0); STAGE(OA(0, 0), Bt, brow, 0);
    STAGE(OB(0, 1), A, bcol + HALF, 0); STAGE(OA(0, 1), Bt, brow + HALF, 0);
  }
  for (int wgid = vb; wgid < nwg; wgid += gdim) {
    f32x4 acc[2][2][4][2] = {};
    bf16x8 At[4][2], B0[2][2], B1[2][2];
    constexpr int nt = K / BK;
    if (wr == 1) BAR;
    WAIT_V(4); BAR;
    STAGE(OB(1, 0), A, bcol, 1); STAGE(OA(1, 0), Bt, brow, 1); STAGE(OB(1, 1), A, bcol + HALF, 1);
    WAIT_V(6); BAR;
    for (int t = 0; t < nt - 2; t += 2) {
      LDB(B0, 0, 0); SCHED; LDA(At, 0, 0); STAGE(OA(1, 1), Bt, brow + HALF, t + 1);
      WAIT_L(8); BAR; WAIT_L(0); MMA(0, 0, At, B0); BAR; SCHED;
      LDB(B1, 0, 1); STAGE(OB(0, 0), A, bcol, t + 2);
      BAR; WAIT_L(0); MMA(0, 1, At, B1); BAR;
      LDA(At, 0, 1); STAGE(OA(0, 0), Bt, brow, t + 2);
      BAR; WAIT_L(0); MMA(1, 0, At, B0); BAR; SCHED;
      STAGE(OB(0, 1), A, bcol + HALF, t + 2);
      WAIT_V(6); BAR; MMA(1, 1, At, B1); BAR;
      LDB(B0, 1, 0); SCHED; LDA(At, 1, 0); STAGE(OA(0, 1), Bt, brow + HALF, t + 2);
      WAIT_L(8); BAR; WAIT_L(0); MMA(0, 0, At, B0); BAR; SCHED;
      LDB(B1, 1, 1); STAGE(OB(1, 0), A, bcol, t + 3);
      BAR; WAIT_L(0); MMA(0, 1, At, B1); BAR;
      LDA(At, 1, 1); STAGE(OA(1, 0), Bt, brow, t + 3);
      BAR; WAIT_L(0); MMA(1, 0, At, B0); BAR; SCHED;
      STAGE(OB(1, 1), A, bcol + HALF, t + 3);
      WAIT_V(6); BAR; MMA(1, 1, At, B1); BAR;
    }
    { LDB(B0, 0, 0); LDA(At, 0, 0); STAGE(OA(1, 1), Bt, brow + HALF, nt - 1);
      BAR; WAIT_L(0); MMA(0, 0, At, B0); BAR;
      LDB(B1, 0, 1); BAR; WAIT_L(0); MMA(0, 1, At, B1); BAR;
      LDA(At, 0, 1); WAIT_V(4); BAR; WAIT_L(0); MMA(1, 0, At, B0); MMA(1, 1, At, B1); BAR; }
    { LDB(B0, 1, 0); LDA(At, 1, 0); WAIT_V(2); BAR; WAIT_L(0); MMA(0, 0, At, B0); BAR;
      LDB(B1, 1, 1); WAIT_V(0); BAR; WAIT_L(0); MMA(0, 1, At, B1); BAR;
      LDA(At, 1, 1); BAR; WAIT_L(0); MMA(1, 0, At, B0); MMA(1, 1, At, B1); BAR; }
    if (wr == 0) BAR;
    const int erow = brow, ecol = bcol;
    if (wgid + gdim < nwg) {
      TILE_RC(wgid + gdim, brow, bcol);
      STAGE(OB(0, 0), A, bcol, 0); STAGE(OA(0, 0), Bt, brow, 0);
      STAGE(OB(0, 1), A, bcol + HALF, 0); STAGE(OA(0, 1), Bt, brow + HALF, 0);
    }
    if (EPI == 1) {
      u16* proj = (u16*)(p.ws + OFF_PROJ);
      const float* sumsq = (const float*)(p.ws + OFF_SUMSQ) + (long)layer * ROWSP;
#pragma unroll
      for (int bj = 0; bj < 2; ++bj)
#pragma unroll
        for (int n = 0; n < 2; ++n) {
          const int tok = ecol + bj * HALF + wc * 32 + n * 16 + fr;
          if (tok < ROWS) {
            const float rs = rsqrtf(sumsq[tok] * (1.f / DM) + EPS);
            u16* prow = proj + (long)tok * NP;
#pragma unroll
            for (int ai = 0; ai < 2; ++ai)
#pragma unroll
              for (int m = 0; m < 4; ++m) {
                const int n0 = erow + ai * HALF + wr * 64 + m * 16 + fq * 4;
                if (n0 < NP)
                  *reinterpret_cast<uint2*>(prow + n0) = pack4(acc[ai][bj][m][n][0] * rs, acc[ai][bj][m][n][1] * rs,
                                                                acc[ai][bj][m][n][2] * rs, acc[ai][bj][m][n][3] * rs);
              }
          }
        }
    } else {
      u16* hb = (u16*)(p.ws + OFF_HB);
      float* sumsq = (float*)(p.ws + OFF_SUMSQ) + (long)(EPI == 2 ? 1 : 2) * ROWSP;
#pragma unroll
      for (int bj = 0; bj < 2; ++bj)
#pragma unroll
        for (int n = 0; n < 2; ++n) {
          const int tok = ecol + bj * HALF + wc * 32 + n * 16 + fr;
          float* dst = nullptr;
          if (EPI == 3) {
            if (tok < ROWS_P) {
              const int b = tok / TP, t = tok - b * TP;
              if (t >= 16) dst = p.out + ((long)b * 8192 + (t - 16)) * DM;
            } else if (tok < ROWS) {
              dst = p.out + YS_OFF + (long)(tok - ROWS_P) * DM;
            }
          }
          u16* hrow = hb + (long)tok * DM;
          float rsum = 0.f;
#pragma unroll
          for (int ai = 0; ai < 2; ++ai)
#pragma unroll
            for (int m = 0; m < 4; ++m) {
              const int n0 = erow + ai * HALF + wr * 64 + m * 16 + fq * 4;
              float r4[4];
              unpack4(*reinterpret_cast<const uint2*>(hrow + n0), r4);
              float v[4];
#pragma unroll
              for (int j = 0; j < 4; ++j) { v[j] = acc[ai][bj][m][n][j] + r4[j]; rsum += v[j] * v[j]; }
              if (EPI == 2) *reinterpret_cast<uint2*>(hrow + n0) = pack4(v[0], v[1], v[2], v[3]);
              else if (dst) *reinterpret_cast<float4*>(dst + n0) = make_float4(v[0], v[1], v[2], v[3]);
            }
          rsum += __shfl_xor(rsum, 16); rsum += __shfl_xor(rsum, 32);
          if (fq == 0) atomicAdd(&sumsq[tok], rsum);
        }
    }
  }
  __syncthreads();
  if (EPI == 2) {
    const int rem = nwg % gdim;
    const int widx = (vb >= rem) ? vb - rem : -1, wcnt = gdim - rem;
    if (wcnt <= 0) {
      transpose_tiles(p.win + (long)DM * NP, (u16*)(p.ws + OFF_WTIN) + (long)NPP * DM, p.normw + DM, NP, NPP / 64, smem, vb, gdim);
      transpose_tiles(p.wout + (long)DM * DM, (u16*)(p.ws + OFF_WTOUT) + (long)DM * DM, nullptr, DM, DM / 64, smem, vb, gdim);
    } else if (widx >= 0) {
      transpose_tiles(p.win + (long)DM * NP, (u16*)(p.ws + OFF_WTIN) + (long)NPP * DM, p.normw + DM, NP, NPP / 64, smem, widx, wcnt);
      transpose_tiles(p.wout + (long)DM * DM, (u16*)(p.ws + OFF_WTOUT) + (long)DM * DM, nullptr, DM, DM / 64, smem, widx, wcnt);
    }
  }
#undef TILE_RC
#undef SA
#undef SB
#undef OA
#undef OB
#undef STAGE
#undef LDA
#undef LDB
#undef MMA
}

#define XB_TMO      128
#define XB_XCNT(j)  (256  + 64 * (j))
#define XB_XSUB(j)  (1280 + 64 * (j))
#define XB_XGEN(j)  (2304 + 64 * (j))
#define XB_TOP      3328
#define XB_TOPGEN   3392
#define XCD_BAR_WORDS 3456
#define XB_SPIN_CAP (1u << 18)
#define LAS __attribute__((address_space(3)))
__device__ __forceinline__ unsigned xb_ld(unsigned* p)              { return __hip_atomic_load(p, __ATOMIC_RELAXED, __HIP_MEMORY_SCOPE_AGENT); }
__device__ __forceinline__ unsigned xb_add(unsigned* p, unsigned v) { return __hip_atomic_fetch_add(p, v, __ATOMIC_RELAXED, __HIP_MEMORY_SCOPE_AGENT); }
__device__ __forceinline__ unsigned xb_xcc_id() { return (unsigned)__builtin_amdgcn_s_getreg((3 << 11) | 20) & 0xFu; }
#define XB_SPIN(cond, bar) do { unsigned _sp = 0; while (cond) { __builtin_amdgcn_s_sleep(1); \
    if ((++_sp & 255u) == 0u) { if (xb_ld(&(bar)[XB_TMO])) break; if (_sp > XB_SPIN_CAP) { atomicAdd(&(bar)[XB_TMO], 1u); break; } } } } while (0)
struct XcdBarrier { unsigned* bar; unsigned x; volatile LAS unsigned* st; };
__device__ __forceinline__ XcdBarrier xcd_barrier_post(unsigned* bar, volatile LAS unsigned* st) {
  XcdBarrier b; b.bar = bar; b.x = xb_xcc_id(); b.st = st;
  if (threadIdx.x == 0) (void)xb_add(&bar[XB_XCNT(b.x)], 1u);
  return b;
}
__device__ __forceinline__ void xcd_barrier_complete(unsigned* bar, unsigned x, unsigned& nloc, unsigned& nx) {
  const unsigned G = gridDim.x * gridDim.y * gridDim.z;
  unsigned sum, cnt, mine, sp = 0u;
  for (;;) {
    sum = 0u; cnt = 0u; mine = 0u;
#pragma unroll
    for (unsigned j = 0; j < 16; ++j) { const unsigned c = xb_ld(&bar[XB_XCNT(j)]); sum += c; cnt += (c > 0u) ? 1u : 0u; mine = (j == x) ? c : mine; }
    if (sum == G) break;
    __builtin_amdgcn_s_sleep(1);
    if ((++sp & 255u) == 0u) { if (xb_ld(&bar[XB_TMO])) break; if (sp > XB_SPIN_CAP) { atomicAdd(&bar[XB_TMO], 1u); break; } }
  }
  nloc = mine > 0u ? mine : 1u; nx = cnt > 0u ? cnt : 1u;
}
__device__ __forceinline__ void xcd_barrier(const XcdBarrier& b) {
  asm volatile("s_waitcnt vmcnt(0)" ::: "memory");
  __syncthreads();
  if (threadIdx.x == 0) {
    unsigned* bar = b.bar;
    __builtin_amdgcn_s_waitcnt(0);
    unsigned nloc = b.st[0], nx = b.st[1];
    if (nloc == 0u) { xcd_barrier_complete(bar, b.x, nloc, nx); b.st[0] = nloc; b.st[1] = nx; }
    const unsigned old = xb_add(&bar[XB_XSUB(b.x)], 1u);
    const unsigned gen = old / nloc;
    if (old + 1u == (gen + 1u) * nloc) {
      __builtin_amdgcn_fence(__ATOMIC_RELEASE, "agent");
      asm volatile("s_waitcnt vmcnt(0)" ::: "memory");
      const unsigned og = xb_add(&bar[XB_TOP], 1u);
      const unsigned tg = og / nx;
      if (og + 1u == (tg + 1u) * nx) xb_add(&bar[XB_TOPGEN], 1u);
      else XB_SPIN(xb_ld(&bar[XB_TOPGEN]) == tg, bar);
      __builtin_amdgcn_fence(__ATOMIC_ACQUIRE, "agent");
      xb_add(&bar[XB_XGEN(b.x)], 1u);
      asm volatile("s_waitcnt vmcnt(0)" ::: "memory");
    } else {
      XB_SPIN(xb_ld(&bar[XB_XGEN(b.x)]) == gen, bar);
      __builtin_amdgcn_fence(__ATOMIC_ACQUIRE, "agent");
      asm volatile("s_waitcnt vmcnt(0)" ::: "memory");
    }
  }
  __syncthreads();
}

__device__ __forceinline__ void chunk_geom(int cid, int& row0, int& nvalid, int& prevmode, int& sidx, bool& lastc) {
  if (cid < 516) {
    const int s = cid / 129, c = cid - s * 129;
    sidx = s; lastc = (c == 128);
    if (c == 0) { row0 = s * TP; nvalid = 16; prevmode = 0; }
    else { row0 = s * TP + 16 + (c - 1) * 64; nvalid = 64; prevmode = 1; }
  } else {
    sidx = cid - 516; row0 = ROWS_P + sidx * 64; nvalid = 64; prevmode = 2; lastc = true;
  }
}

__device__ __forceinline__ long item_slot(int cid, int h) {
  if (cid < 516) { const int s = cid / 129, c = cid - s * 129; return (long)((s * 8 + h) * 129 + c); }
  return (long)(4128 + (cid - 516) * 8 + h);
}

__device__ __forceinline__ void chunk_prep(const Params& p, int layer, int item, int nitem, unsigned char* smem) {
  const int tid = opaque_tid() & 511, wv = __builtin_amdgcn_readfirstlane(tid >> 6), lane = tid & 63, fr = lane & 15, fq = lane >> 4;
  const int cid = item >> 3, h = item & 7;
  int row0, nvalid, prevmode, sidx; bool lastc;
  chunk_geom(cid, row0, nvalid, prevmode, sidx, lastc);
  u16* sKB = (u16*)smem;
  u16* sK = sKB + 64 * 136;
  u16* sQ = sK + 64 * 136;
  u16* sVBT = sQ + 64 * 136;
  u16* sKBGT = sVBT + 128 * 72;
  u16* sT = sKBGT + 128 * 72;
  float* sA = (float*)(sT + 64 * 72);
  float* sBeta = sA + 64 * 68;
  float* sGc = sBeta + 64;
  u16* sKPT = (u16*)(sGc + 64);
  float* sTf = (float*)smem;
  float* sY = sTf + 64 * 68;
  int zoff;
  asm volatile("v_mov_b32 %0, 0" : "=v"(zoff));
  const u16* proj = (const u16*)(p.ws + OFF_PROJ);
  const long slot = item_slot(cid, h);
  u16* Wd = (u16*)((unsigned char*)p.out) + slot * 24576;
  u16* QG = Wd + 8192;
  u16* KPT = Wd + 16384;
  u16* UTd = (u16*)(p.ws + OFF_QK) + slot * 12288;
  u16* QKd = UTd + 8192;
  float* EGL = (float*)(p.ws + OFF_EGL);

  unsigned tch = 0;
  {
    if (nitem >= 0) {
      int nrow0, nnv, npm, nsi; bool nl;
      chunk_geom(nitem >> 3, nrow0, nnv, npm, nsi, nl);
      const int nh = nitem & 7;
      if (tid < 402) {
        const int r = tid / 6, m6 = tid - r * 6;
        tch = touch_ld(proj + (long)(nrow0 - 3 + r) * NP + 4096 + (m6 >> 1) * 1024 + nh * 128 + (m6 & 1) * 64);
      } else if (tid >= 448) {
        tch = touch_ld(proj + (long)(nrow0 + (tid - 448)) * NP + 8192 + nh);
      }
    }
  }
  if (wv == 0) {
    float beta = 0.f, g = 0.f;
    if (lane < nvalid) {
      const long rb = (long)(row0 + lane) * NP;
      const float bl = bf2f(proj[rb + 8192 + h]);
      const float al = bf2f(proj[rb + 8200 + h]) + p.dtb[layer * 8 + h];
      beta = 1.f / (1.f + expf(-bl));
      const float sp = (al > 20.f) ? al : log1pf(expf(al));
      g = -expf(p.alog[layer * 8 + h]) * sp;
    }
    float gc = g;
#pragma unroll
    for (int o = 1; o < 64; o <<= 1) { const float t = __shfl_up(gc, o); if (lane >= o) gc += t; }
    sBeta[lane] = beta; sGc[lane] = gc;
  }

  const int rg = tid >> 5, cg = tid & 31, i0 = rg * 4, d0 = cg * 4;
  float qv[4][4], kv[4][4], vv[4][4];
#pragma unroll
  for (int mat = 0; mat < 3; ++mat) {
    const int ch = mat * 1024 + h * 128 + d0;
    const int colbase = 4096 + ch;
    float xr[7][4];
#pragma unroll
    for (int a = 0; a < 7; ++a) {
      const int ri = i0 - 3 + a;
      if (ri >= 0 || prevmode == 1) {
        uint2 raw = *reinterpret_cast<const uint2*>(proj + (long)(row0 + ri) * NP + colbase);
        unpack4(raw, xr[a]);
      } else if (prevmode == 2) {
        const float4 v = *reinterpret_cast<const float4*>(p.scq + ((long)(layer * 8 + sidx) * 3 + (3 + ri)) * 3072 + ch);
        xr[a][0] = v.x; xr[a][1] = v.y; xr[a][2] = v.z; xr[a][3] = v.w;
      } else {
        xr[a][0] = xr[a][1] = xr[a][2] = xr[a][3] = 0.f;
      }
    }
    if (lastc && rg == 15) {
      float* dst = p.out + (prevmode == 2 ? SCQ_OFF + (long)(layer * 8 + sidx) * 3 * 3072 : PCQ_OFF + (long)(layer * 4 + sidx) * 3 * 3072) + ch;
#pragma unroll
      for (int a = 4; a < 7; ++a)
        *reinterpret_cast<float4*>(dst + (a - 4) * 3072) = make_float4(xr[a][0], xr[a][1], xr[a][2], xr[a][3]);
    }
    float cw[4][4];
#pragma unroll
    for (int j = 0; j < 4; ++j) {
      const float4 v = *reinterpret_cast<const float4*>(p.cvqw + (long)(layer * 4 + j) * 3072 + ch);
      cw[j][0] = v.x; cw[j][1] = v.y; cw[j][2] = v.z; cw[j][3] = v.w;
    }
#pragma unroll
    for (int ii = 0; ii < 4; ++ii)
#pragma unroll
      for (int e = 0; e < 4; ++e) {
        float o = 0.f;
#pragma unroll
        for (int j = 0; j < 4; ++j) o += cw[j][e] * xr[ii + j][e];
        o = silu_f(o);
        if (mat == 0) qv[ii][e] = o; else if (mat == 1) kv[ii][e] = o; else vv[ii][e] = o;
      }
  }
#pragma unroll
  for (int ii = 0; ii < 4; ++ii) {
    float sq = 0.f, sk = 0.f;
#pragma unroll
    for (int e = 0; e < 4; ++e) { sq += qv[ii][e] * qv[ii][e]; sk += kv[ii][e] * kv[ii][e]; }
#pragma unroll
    for (int o = 1; o < 32; o <<= 1) { sq += __shfl_xor(sq, o); sk += __shfl_xor(sk, o); }
    const float rq = rsqrtf(sq + EPS) * 0.08838834764831845f, rk = rsqrtf(sk + EPS);
    const bool valid = (i0 + ii) < nvalid;
#pragma unroll
    for (int e = 0; e < 4; ++e) {
      qv[ii][e] = valid ? qv[ii][e] * rq : 0.f;
      kv[ii][e] = valid ? kv[ii][e] * rk : 0.f;
      vv[ii][e] = valid ? vv[ii][e] : 0.f;
    }
  }
  __syncthreads();
  float beta[4], gcv[4];
#pragma unroll
  for (int ii = 0; ii < 4; ++ii) { beta[ii] = sBeta[i0 + ii]; gcv[ii] = sGc[i0 + ii]; }
  const float glast = sGc[63];
  if (tid == 0) EGL[slot] = expf(glast);

#pragma unroll
  for (int ii = 0; ii < 4; ++ii) {
    const int i = i0 + ii;
    const float b = beta[ii];
    *reinterpret_cast<uint2*>(sKB + i * 136 + d0) = pack4(kv[ii][0] * b, kv[ii][1] * b, kv[ii][2] * b, kv[ii][3] * b);
    *reinterpret_cast<uint2*>(sK + i * 136 + d0) = pack4(kv[ii][0], kv[ii][1], kv[ii][2], kv[ii][3]);
    *reinterpret_cast<uint2*>(sQ + i * 136 + d0) = pack4(qv[ii][0], qv[ii][1], qv[ii][2], qv[ii][3]);

  }
  {
    float bg[4], kd[4];
#pragma unroll
    for (int ii = 0; ii < 4; ++ii) { bg[ii] = beta[ii] * __expf(gcv[ii]); kd[ii] = __expf(glast - gcv[ii]); }
#pragma unroll
    for (int e = 0; e < 4; ++e) {
      const int d = d0 + e;
      *reinterpret_cast<uint2*>(sVBT + d * 72 + i0) = pack4(vv[0][e] * beta[0], vv[1][e] * beta[1], vv[2][e] * beta[2], vv[3][e] * beta[3]);
      *reinterpret_cast<uint2*>(sKBGT + d * 72 + i0) = pack4(kv[0][e] * bg[0], kv[1][e] * bg[1], kv[2][e] * bg[2], kv[3][e] * bg[3]);
      *reinterpret_cast<uint2*>(sKPT + d * 72 + i0) = pack4(kv[0][e] * kd[0], kv[1][e] * kd[1], kv[2][e] * kd[2], kv[3][e] * kd[3]);
    }
  }
  __syncthreads();
#pragma unroll
  for (int t2 = 0; t2 < 2; ++t2) {
    {
      const int qib = wv >> 1, qkk = (wv & 1) * 2 + t2;
      const bf16x8 qf = ldfrag(sQ, 136, qib * 16 + fr, qkk * 32 + fq * 8);
      const float eg = __expf(sGc[qib * 16 + fr]);
      float qx[8];
      unpack8(__builtin_bit_cast(uint4, qf), qx);
      uint4 o;
      o.x = pack2(qx[0] * eg, qx[1] * eg); o.y = pack2(qx[2] * eg, qx[3] * eg);
      o.z = pack2(qx[4] * eg, qx[5] * eg); o.w = pack2(qx[6] * eg, qx[7] * eg);
      *reinterpret_cast<uint4*>(QG + (((qib * 4 + qkk) * 64 + lane) << 3)) = o;
    }
    *reinterpret_cast<bf16x8*>(KPT + (((wv * 2 + t2) * 64 + lane) << 3)) = ldfrag(sKPT, 72, wv * 16 + fr, t2 * 32 + fq * 8);
  }
  {
    const int ib = wv >> 1;
#pragma unroll
    for (int jj = 0; jj < 2; ++jj) {
      const int jb = (wv & 1) * 2 + jj;
      f32x4 c = {0.f, 0.f, 0.f, 0.f}, c2 = {0.f, 0.f, 0.f, 0.f};
#pragma unroll
      for (int kk = 0; kk < 4; ++kk) {
        const bf16x8 a = ldfrag(sKB, 136, ib * 16 + fr, kk * 32 + fq * 8);
        const bf16x8 b = ldfrag(sK, 136, jb * 16 + fr, kk * 32 + fq * 8);
        c = mfma16(a, b, c);
        const bf16x8 b2 = ldfrag(sQ, 136, ib * 16 + fr, kk * 32 + fq * 8);
        c2 = mfma16(b, b2, c2);
      }
      {
        const int j = jb * 16 + fr;
        const float gj = sGc[j];
#pragma unroll
        for (int r = 0; r < 4; ++r) {
          const int i = ib * 16 + fq * 4 + r;
          sA[i * 68 + j] = (i > j) ? c[r] * __expf(sGc[i] - gj) : 0.f;
        }
      }
      {
        const int i = ib * 16 + fr;
        const float gi = sGc[i];
        float o[4];
#pragma unroll
        for (int r = 0; r < 4; ++r) {
          const int j = jb * 16 + fq * 4 + r;
          o[r] = (i >= j) ? c2[r] * __expf(gi - sGc[j]) : 0.f;
        }
        *reinterpret_cast<uint2*>(QKd + ((((ib * 2 + (jb >> 1)) * 64) + ((jb & 1) * 2 + (fq >> 1)) * 16 + fr) << 3) + (fq & 1) * 4) = pack4(o[0], o[1], o[2], o[3]);
      }
    }
  }
  __syncthreads();
  {
    for (int e = tid; e < 64 * 68; e += 512) sTf[e] = 0.f;
    __syncthreads();
    if (wv < 4 && lane < 16) {
      const float* Ab = sA + (wv * 16) * 68 + wv * 16 + zoff;
      float t[16], ac[16], an[16];
      t[0] = (lane == 0) ? 1.f : 0.f;
      sTf[(wv * 16) * 68 + wv * 16 + lane] = t[0];
      ac[0] = Ab[68];
#pragma unroll
      for (int i = 1; i < 16; ++i) {
        if (i + 1 < 16) {
#pragma unroll
          for (int j = 0; j <= i; ++j) an[j] = Ab[(i + 1) * 68 + j];
        }
        float a = (lane == i) ? 1.f : 0.f;
#pragma unroll
        for (int j = 0; j < i; ++j) a -= ac[j] * t[j];
        t[i] = a;
        sTf[(wv * 16 + i) * 68 + wv * 16 + lane] = a;
        if (i + 1 < 16) {
#pragma unroll
          for (int j = 0; j <= i; ++j) ac[j] = an[j];
        }
        __builtin_amdgcn_sched_barrier(0);
      }
    }
    __syncthreads();
    if (wv < 2) {
      const int o = wv * 32;
      const f32x4 c = mm16(sA, o + 16, o, sTf, o, o, 16, fr, fq);
#pragma unroll
      for (int r = 0; r < 4; ++r) sY[(o + 16 + fq * 4 + r) * 68 + o + fr] = c[r];
    }
    __syncthreads();
    if (wv < 2) {
      const int o = wv * 32;
      const f32x4 c = mm16(sTf, o + 16, o + 16, sY, o + 16, o, 16, fr, fq);
#pragma unroll
      for (int r = 0; r < 4; ++r) sTf[(o + 16 + fq * 4 + r) * 68 + o + fr] = -c[r];
    }
    __syncthreads();
    if (wv < 4) {
      const int bi = wv >> 1, bj = wv & 1;
      const f32x4 c = mm16(sA, 32 + bi * 16, 0, sTf, 0, bj * 16, 32, fr, fq);
#pragma unroll
      for (int r = 0; r < 4; ++r) sY[(32 + bi * 16 + fq * 4 + r) * 68 + bj * 16 + fr] = c[r];
    }
    __syncthreads();
    if (wv < 4) {
      const int bi = wv >> 1, bj = wv & 1;
      const f32x4 c = mm16(sTf, 32 + bi * 16, 32, sY, 32, bj * 16, 32, fr, fq);
#pragma unroll
      for (int r = 0; r < 4; ++r) sTf[(32 + bi * 16 + fq * 4 + r) * 68 + bj * 16 + fr] = -c[r];
    }
    __syncthreads();
    {
      const int i = tid >> 3, j0 = (tid & 7) * 8;
      float v[8];
#pragma unroll
      for (int e = 0; e < 8; ++e) v[e] = sTf[i * 68 + j0 + e];
      uint4 o;
      o.x = pack2(v[0], v[1]); o.y = pack2(v[2], v[3]); o.z = pack2(v[4], v[5]); o.w = pack2(v[6], v[7]);
      *reinterpret_cast<uint4*>(sT + i * 72 + j0) = o;
    }
  }
  __syncthreads();
  {
    const int ib = wv >> 1;
#pragma unroll
    for (int x = 0; x < 4; ++x) {
      const int dvb = (wv & 1) * 4 + x;
      f32x4 c = {0.f, 0.f, 0.f, 0.f};
#pragma unroll
      for (int kk = 0; kk < 2; ++kk)
        c = mfma16(ldfrag(sT, 72, ib * 16 + fr, kk * 32 + fq * 8), ldfrag(sVBT, 72, dvb * 16 + fr, kk * 32 + fq * 8), c);
      *reinterpret_cast<uint2*>(UTd + (((dvb * 4 + ib) * 64 + lane) << 2)) = pack4(c[0], c[1], c[2], c[3]);
    }
#pragma unroll
    for (int ib2 = 0; ib2 < 4; ++ib2) {
      f32x4 c = {0.f, 0.f, 0.f, 0.f};
#pragma unroll
      for (int kk = 0; kk < 2; ++kk)
        c = mfma16(ldfrag(sKBGT, 72, wv * 16 + fr, kk * 32 + fq * 8), ldfrag(sT, 72, ib2 * 16 + fr, kk * 32 + fq * 8), c);
      *reinterpret_cast<uint2*>(Wd + ((((ib2 * 4 + (wv >> 1)) * 64) + ((wv & 1) * 2 + (fq >> 1)) * 16 + fr) << 3) + (fq & 1) * 4) = pack4(c[0], c[1], c[2], c[3]);
    }
  }
  __syncthreads();
  {
    unsigned tacc = 0;
    touch_use(tacc, tch);
    if (tacc == 0x9e3779b9u) ((volatile float*)EGL)[NITEM + 9] = 1.f;
  }
}

__device__ __forceinline__ void gdn_scan(const Params& p, int layer, int widx, unsigned char* smem, const XcdBarrier* xbp, int csplit) {
  const int tid = opaque_tid() & 511, wv = __builtin_amdgcn_readfirstlane(tid >> 6), lane = tid & 63, fr = lane & 15, fq = lane >> 4;
  const bool is_prompt = widx < 128;
  int s, h, sl, nsteps, cid0;
  if (is_prompt) { s = widx >> 5; h = (widx >> 2) & 7; sl = widx & 3; nsteps = 129; cid0 = s * 129; }
  else { const int j = widx - 128; s = j >> 5; h = (j >> 2) & 7; sl = j & 3; nsteps = 1; cid0 = 516 + s; }
  const int dv0 = sl * 32;
  u16* sST = (u16*)smem;
  u16* sVT = sST + 32 * 136;
  u16* sO = sVT + 32 * 72;
  const u16* R1g = (const u16*)((const unsigned char*)p.out);
  const u16* R2g = (const u16*)(p.ws + OFF_QK);
  const float* EGL = (const float*)(p.ws + OFF_EGL);
  const long slot0 = item_slot(cid0, h);
  const int rowbase = is_prompt ? s * TP : ROWS_P + s * 64;
  u16* ymix = (u16*)(p.ws + OFF_YMIX);

  f32x4 accS[2];
#pragma unroll
  for (int nb = 0; nb < 2; ++nb) {
    if (is_prompt) { accS[nb][0] = 0.f; accS[nb][1] = 0.f; accS[nb][2] = 0.f; accS[nb][3] = 0.f; }
    else {
      const float4 v = *reinterpret_cast<const float4*>(p.sdel + ((long)(layer * 8 + s) * 8 + h) * 16384 + (wv * 16 + fr) * 128 + dv0 + nb * 16 + fq * 4);
      accS[nb][0] = v.x; accS[nb][1] = v.y; accS[nb][2] = v.z; accS[nb][3] = v.w;
    }
#pragma unroll
    for (int r = 0; r < 4; ++r) sST[(nb * 16 + fq * 4 + r) * 136 + wv * 16 + fr] = f2bf(accS[nb][r]);
  }
  __syncthreads();
  const int part = wv >> 2;
  const int ib = wv & 3;
  int zoff;
  asm volatile("v_mov_b32 %0, 0" : "=v"(zoff));
#define LDS_BAR() asm volatile("s_waitcnt lgkmcnt(0)\n\ts_barrier" ::: "memory")
#define SCAN_LOAD(IT, F, G, KPF, UU0, UU1, EG) do { \
    const u16* R1p = R1g + (IT) * 24576; const u16* R2p = R2g + (IT) * 12288; \
    _Pragma("unroll") for (int kk = 0; kk < 2; ++kk) \
      KPF[kk] = *reinterpret_cast<const bf16x8*>(R1p + 16384 + (((wv * 2 + kk) * 64 + lane) << 3)); \
    EG = EGL[(IT) + zoff]; \
    { const u16* Fp = R1p + part * 8192;     \
      _Pragma("unroll") for (int kk = 0; kk < 4; ++kk) \
        F[kk] = *reinterpret_cast<const bf16x8*>(Fp + (((ib * 4 + kk) * 64 + lane) << 3)); } \
    if (part == 0) { \
      UU0 = *reinterpret_cast<const uint2*>(R2p + ((((sl * 2) * 4 + ib) * 64 + lane) << 2)); \
      UU1 = *reinterpret_cast<const uint2*>(R2p + ((((sl * 2 + 1) * 4 + ib) * 64 + lane) << 2)); \
    } else { \
      _Pragma("unroll") for (int kk = 0; kk < 2; ++kk) \
        G[kk] = *reinterpret_cast<const bf16x8*>(R2p + 8192 + (((ib * 2 + kk) * 64 + lane) << 3)); } } while (0)
#define SCAN_FLUSH(PROW0, PNV) do { \
    if (tid < 256) { const int i_ = tid >> 2, sg_ = tid & 3; \
      if (i_ < (PNV)) *reinterpret_cast<uint4*>(ymix + (long)((PROW0) + i_) * DM + 1024 + h * 128 + dv0 + sg_ * 8) = \
          *reinterpret_cast<const uint4*>(sO + i_ * 40 + sg_ * 8); } } while (0)
#define SCAN_STEP(STEP, F, G, KPF, UU0, UU1, EGLV, FN, GN, KPFN, UU0N, UU1N, EGLN) do { \
    const int row0 = (is_prompt && (STEP) > 0) ? rowbase + 16 + ((STEP) - 1) * 64 : rowbase; \
    const int nvalid = (is_prompt && (STEP) == 0) ? 16 : 64; \
    { const long itn = slot0 + min((STEP) + 2, nsteps - 1); \
      SCAN_LOAD(itn, FN, GN, KPFN, UU0N, UU1N, EGLN); } \
    if ((STEP) > 0) SCAN_FLUSH(prow0, pnv); \
    f32x4 c0 = {0.f, 0.f, 0.f, 0.f}, c1 = {0.f, 0.f, 0.f, 0.f}; \
    _Pragma("unroll") for (int kk = 0; kk < 4; ++kk) { \
      c0 = mfma16(F[kk], ldfrag(sST, 136, fr, kk * 32 + fq * 8), c0); \
      c1 = mfma16(F[kk], ldfrag(sST, 136, 16 + fr, kk * 32 + fq * 8), c1); } \
    if (part == 0) { \
      float u0[4], u1[4]; \
      unpack4(UU0, u0); unpack4(UU1, u1); \
      *reinterpret_cast<uint2*>(sVT + fr * 72 + ib * 16 + fq * 4) = pack4(u0[0] - c0[0], u0[1] - c0[1], u0[2] - c0[2], u0[3] - c0[3]); \
      *reinterpret_cast<uint2*>(sVT + (16 + fr) * 72 + ib * 16 + fq * 4) = pack4(u1[0] - c1[0], u1[1] - c1[1], u1[2] - c1[2], u1[3] - c1[3]); } \
    LDS_BAR(); \
    _Pragma("unroll") for (int nb = 0; nb < 2; ++nb) { \
      f32x4 c = accS[nb]; \
      c[0] *= EGLV; c[1] *= EGLV; c[2] *= EGLV; c[3] *= EGLV; \
      _Pragma("unroll") for (int kk = 0; kk < 2; ++kk) \
        c = mfma16(ldfrag(sVT, 72, nb * 16 + fr, kk * 32 + fq * 8), KPF[kk], c); \
      accS[nb] = c; \
      _Pragma("unroll") for (int r = 0; r < 4; ++r) sST[(nb * 16 + fq * 4 + r) * 136 + wv * 16 + fr] = f2bf(c[r]); } \
    if (part == 1) { \
      _Pragma("unroll") for (int kk = 0; kk < 2; ++kk) { \
        c0 = mfma16(G[kk], ldfrag(sVT, 72, fr, kk * 32 + fq * 8), c0); \
        c1 = mfma16(G[kk], ldfrag(sVT, 72, 16 + fr, kk * 32 + fq * 8), c1); } \
      _Pragma("unroll") for (int r = 0; r < 4; ++r) { \
        sO[(ib * 16 + fq * 4 + r) * 40 + fr] = f2bf(c0[r]); \
        sO[(ib * 16 + fq * 4 + r) * 40 + 16 + fr] = f2bf(c1[r]); } } \
    LDS_BAR(); \
    prow0 = row0; pnv = nvalid; } while (0)
  bf16x8 fA[4], gA[2], kpfA[2]; uint2 u0A, u1A; float eglA;
  bf16x8 fB[4], gB[2], kpfB[2]; uint2 u0B, u1B; float eglB;
  bf16x8 fC[4], gC[2], kpfC[2]; uint2 u0C, u1C; float eglC;
  int prow0 = 0, pnv = 0;
  SCAN_LOAD(slot0, fA, gA, kpfA, u0A, u1A, eglA);
  SCAN_LOAD(slot0 + min(1, nsteps - 1), fB, gB, kpfB, u0B, u1B, eglB);
  for (int step = 0; step < nsteps; step += 3) {
    if (xbp && step == csplit) xcd_barrier(*xbp);
    SCAN_STEP(step, fA, gA, kpfA, u0A, u1A, eglA, fC, gC, kpfC, u0C, u1C, eglC);
    if (step + 1 < nsteps) SCAN_STEP(step + 1, fB, gB, kpfB, u0B, u1B, eglB, fA, gA, kpfA, u0A, u1A, eglA);
    if (step + 2 < nsteps) SCAN_STEP(step + 2, fC, gC, kpfC, u0C, u1C, eglC, fB, gB, kpfB, u0B, u1B, eglB);
  }
  SCAN_FLUSH(prow0, pnv);
#undef SCAN_STEP
#undef SCAN_FLUSH
#undef SCAN_LOAD
  float* dst = p.out + (is_prompt ? PD_OFF + ((long)(layer * 4 + s) * 8 + h) * 16384 : SD_OFF + ((long)(layer * 8 + s) * 8 + h) * 16384);
#pragma unroll
  for (int nb = 0; nb < 2; ++nb)
    *reinterpret_cast<float4*>(dst + (wv * 16 + fr) * 128 + dv0 + nb * 16 + fq * 4) = make_float4(accS[nb][0], accS[nb][1], accS[nb][2], accS[nb][3]);
  __syncthreads();
}

constexpr int NUNIT = 4 * 513 + 32;
__device__ __forceinline__ void mixer_a_group(const Params& p, int layer, int ug) {
  const int tid = opaque_tid() & 511;
  const int uid = ug * 4 + (tid >> 7);
  if (uid >= NUNIT) return;
  const int c0 = (tid & 127) * 8;
  int row0, sidx; bool first, last, samp;
  if (uid < 2052) { sidx = uid / 513; const int k = uid - sidx * 513; row0 = sidx * TP + 16 * k; first = (k == 0); last = (k == 512); samp = false; }
  else { const int v = uid - 2052; sidx = v >> 2; const int k = v & 3; row0 = ROWS_P + sidx * 64 + 16 * k; first = (k == 0); last = (k == 3); samp = true; }
  const u16* proj = (const u16*)(p.ws + OFF_PROJ);
  u16* ymix = (u16*)(p.ws + OFF_YMIX);
  float w0[8], w1[8], w2[8], um2[8], um1[8];
  {
    const float* cw = p.cvaw + (long)layer * 3 * 1024 + c0;
#pragma unroll
    for (int e = 0; e < 8; ++e) { w0[e] = cw[e]; w1[e] = cw[1024 + e]; w2[e] = cw[2048 + e]; }
  }
  if (first) {
    if (samp) {
      const float* st = p.sca + (long)(layer * 8 + sidx) * 2 * 1024 + c0;
#pragma unroll
      for (int e = 0; e < 8; ++e) { um2[e] = st[e]; um1[e] = st[1024 + e]; }
    } else {
#pragma unroll
      for (int e = 0; e < 8; ++e) { um2[e] = 0.f; um1[e] = 0.f; }
    }
  } else {
    float c[8], x[8];
    unpack8(*reinterpret_cast<const uint4*>(proj + (long)(row0 - 2) * NP + 1024 + c0), c);
    unpack8(*reinterpret_cast<const uint4*>(proj + (long)(row0 - 2) * NP + 2048 + c0), x);
#pragma unroll
    for (int e = 0; e < 8; ++e) um2[e] = c[e] * x[e];
    unpack8(*reinterpret_cast<const uint4*>(proj + (long)(row0 - 1) * NP + 1024 + c0), c);
    unpack8(*reinterpret_cast<const uint4*>(proj + (long)(row0 - 1) * NP + 2048 + c0), x);
#pragma unroll
    for (int e = 0; e < 8; ++e) um1[e] = c[e] * x[e];
  }
  for (int t0 = 0; t0 < 16; t0 += 4) {
    uint4 rbv[4], rcv[4], rxv[4], rzv[4];
#pragma unroll
    for (int q = 0; q < 4; ++q) {
      const long rb = (long)(row0 + t0 + q) * NP + c0;
      rbv[q] = *reinterpret_cast<const uint4*>(proj + rb);
      rcv[q] = *reinterpret_cast<const uint4*>(proj + rb + 1024);
      rxv[q] = *reinterpret_cast<const uint4*>(proj + rb + 2048);
      rzv[q] = *reinterpret_cast<const uint4*>(proj + rb + 3072);
    }
#pragma unroll
    for (int q = 0; q < 4; ++q) {
      float b[8], c[8], x[8], z[8], y[8];
      unpack8(rbv[q], b); unpack8(rcv[q], c); unpack8(rxv[q], x); unpack8(rzv[q], z);
#pragma unroll
      for (int e = 0; e < 8; ++e) {
        const float u = c[e] * x[e];
        const float cv = w0[e] * um2[e] + w1[e] * um1[e] + w2[e] * u;
        y[e] = b[e] * cv * silu_f(z[e]);
        um2[e] = um1[e]; um1[e] = u;
      }
      uint4 o;
      o.x = pack2(y[0], y[1]); o.y = pack2(y[2], y[3]); o.z = pack2(y[4], y[5]); o.w = pack2(y[6], y[7]);
      *reinterpret_cast<uint4*>(ymix + (long)(row0 + t0 + q) * DM + c0) = o;
    }
  }
  if (last) {
    float* dst = p.out + (samp ? SCA_OFF + (long)(layer * 8 + sidx) * 2 * 1024 : PCA_OFF + (long)(layer * 4 + sidx) * 2 * 1024) + c0;
#pragma unroll
    for (int e = 0; e < 8; ++e) { dst[e] = um2[e]; dst[1024 + e] = um1[e]; }
  }
}

__device__ __forceinline__ void phase_post(const Params& p, int layer) {
  const int tid = opaque_tid() & 511;
  const u16* proj = (const u16*)(p.ws + OFF_PROJ);
  u16* ymix = (u16*)(p.ws + OFF_YMIX);
  const int hh = (tid >> 4) & 7, d = (tid & 15) * 8;
  float w[8];
#pragma unroll
  for (int e = 0; e < 8; ++e) w[e] = p.onw[layer * 128 + d + e];
  for (int g = blockIdx.x; g < ROWS / 4; g += gridDim.x) {
    const int row = g * 4 + (tid >> 7);
    u16* op = ymix + (long)row * DM + 1024 + hh * 128 + d;
    float o[8], z[8];
    unpack8(*reinterpret_cast<const uint4*>(op), o);
    unpack8(*reinterpret_cast<const uint4*>(proj + (long)row * NP + 7168 + hh * 128 + d), z);
    float ss = 0.f;
#pragma unroll
    for (int e = 0; e < 8; ++e) ss += o[e] * o[e];
    ss += __shfl_xor(ss, 1); ss += __shfl_xor(ss, 2); ss += __shfl_xor(ss, 4); ss += __shfl_xor(ss, 8);
    const float rs = rsqrtf(ss * (1.f / 128.f) + EPS);
    float y[8];
#pragma unroll
    for (int e = 0; e < 8; ++e) y[e] = o[e] * rs * w[e] * silu_f(z[e]);
    uint4 ov;
    ov.x = pack2(y[0], y[1]); ov.y = pack2(y[2], y[3]); ov.z = pack2(y[4], y[5]); ov.w = pack2(y[6], y[7]);
    *reinterpret_cast<uint4*>(op) = ov;
  }
}

__device__ __forceinline__ void phase_final(const Params& p) {
  const int tid = opaque_tid() & 511, wv = tid >> 6, lane = tid & 63;
  const float* sumsq = (const float*)(p.ws + OFF_SUMSQ) + 2L * ROWSP;
  for (int r = blockIdx.x * 8 + wv; r < ROWS; r += gridDim.x * 8) {
    float* dst;
    if (r < ROWS_P) {
      const int b = r / TP, t = r - b * TP;
      if (t < 16) continue;
      dst = p.out + ((long)b * 8192 + (t - 16)) * DM;
    } else {
      dst = p.out + YS_OFF + (long)(r - ROWS_P) * DM;
    }
    const float rs = rsqrtf(sumsq[r] * (1.f / DM) + EPS);
#pragma unroll
    for (int i = 0; i < 8; ++i) {
      const int c = (i * 64 + lane) * 4;
      float4 v = *reinterpret_cast<const float4*>(dst + c);
      const float4 w = *reinterpret_cast<const float4*>(p.fnw + c);
      v.x *= rs * w.x; v.y *= rs * w.y; v.z *= rs * w.z; v.w *= rs * w.w;
      *reinterpret_cast<float4*>(dst + c) = v;
    }
  }
}

typedef const __attribute__((address_space(4))) Params* CParamsPtr;
__device__ __forceinline__ Params ldparams(CParamsPtr q) {
#if defined(__HIP_DEVICE_COMPILE__)
  asm volatile("" : "+s"(q));
  Params r;
  r.xp = q->xp; r.xs = q->xs; r.sca = q->sca; r.scq = q->scq; r.sdel = q->sdel; r.meta = q->meta; r.normw = q->normw; r.win = q->win;
  r.cvaw = q->cvaw; r.cvqw = q->cvqw; r.alog = q->alog; r.dtb = q->dtb; r.onw = q->onw; r.wout = q->wout; r.fnw = q->fnw;
  r.out = q->out; r.ws = q->ws;
  return r;
#else
  return Params{};
#endif
}

__global__ void __launch_bounds__(512) mega(Params p_unused) {
  extern __shared__ __attribute__((aligned(16))) unsigned char smem[];
  cg::grid_group grid = cg::this_grid();
  CParamsPtr kp = (CParamsPtr)__builtin_amdgcn_kernarg_segment_ptr();
  volatile LAS unsigned* xst = (volatile LAS unsigned*)(smem + 147440);
  if (threadIdx.x < 2) xst[threadIdx.x] = 0u;
  __syncthreads();
  XcdBarrier xb;
  { const Params p = ldparams(kp); xb = xcd_barrier_post((unsigned*)(p.ws + OFF_BAR), xst); }
  { const Params p = ldparams(kp); phase_prep(p, smem); }
  grid.sync();
  for (int layer = 0; layer < 2; ++layer) {
    { const Params p = ldparams(kp); gemm_phase<1>(p, layer, smem); }
    xcd_barrier(xb);
    const bool split = gridDim.x >= 256;
    const int cprep = split ? 110 : 129, csplit = 108;
    {
      const Params p = ldparams(kp);
      const int per_s = cprep * 8, na = 4 * per_s + 64;
      for (int idx = blockIdx.x; idx < na; idx += gridDim.x) {
        int it[2];
#pragma unroll
        for (int q = 0; q < 2; ++q) {
          const int ix = idx + q * (int)gridDim.x;
          if (ix >= na) it[q] = -1;
          else if (ix < 4 * per_s) { const int s_ = ix / per_s, r_ = ix - s_ * per_s; it[q] = (s_ * 129 + (r_ >> 3)) * 8 + (r_ & 7); }
          else { const int r_ = ix - 4 * per_s; it[q] = (516 + (r_ >> 3)) * 8 + (r_ & 7); }
        }
        chunk_prep(p, layer, it[0], it[1], smem);
      }
    }
    xcd_barrier(xb);
    {
      const Params p = ldparams(kp);
      const int G = gridDim.x, b = blockIdx.x;
      if (split) {
        if (b < 128) gdn_scan(p, layer, (((b & 7) + 8 * (b >> 5)) << 2) + ((b >> 3) & 3), smem, &xb, csplit);
        else {
          if (b < 256) { gdn_scan(p, layer, b, smem, nullptr, 0); gdn_scan(p, layer, b + 128, smem, nullptr, 0); }
          const int per_b = (129 - cprep) * 8, nb = 4 * per_b, W = G - 128;
          for (int idx = b - 128; idx < nb; idx += W) {
            int it[2];
#pragma unroll
            for (int q = 0; q < 2; ++q) {
              const int ix = idx + q * W;
              if (ix >= nb) it[q] = -1;
              else { const int s_ = ix / per_b, r_ = ix - s_ * per_b; it[q] = (s_ * 129 + cprep + (r_ >> 3)) * 8 + (r_ & 7); }
            }
            chunk_prep(p, layer, it[0], it[1], smem);
          }
          constexpr int UGT = (NUNIT + 3) / 4, UG1 = (UGT * 9) / 20;
          for (int ug = b - 128; ug < UG1; ug += W) mixer_a_group(p, layer, ug);
          xcd_barrier(xb);
          for (int ug = UG1 + b - 128; ug < UGT; ug += W) mixer_a_group(p, layer, ug);
        }
      } else {
        for (int w = b; w < 384; w += G) gdn_scan(p, layer, w, smem, nullptr, 0);
        for (int ug = b; ug < (NUNIT + 3) / 4; ug += G) mixer_a_group(p, layer, ug);
      }
    }
    xcd_barrier(xb);
    { const Params p = ldparams(kp); phase_post(p, layer); }
    xcd_barrier(xb);
    { const Params p = ldparams(kp); if (layer == 0) gemm_phase<2>(p, layer, smem); else gemm_phase<3>(p, layer, smem); }
    xcd_barrier(xb);
  }
  { const Params p = ldparams(kp); phase_final(p); }
}

extern "C" void kernel_launch(void* const* d_in, const int* in_sizes, int n_in,
                              void* d_out, int out_size, void* d_ws, size_t ws_size,
                              hipStream_t stream) {
  constexpr size_t kLds = 147456;
  static int grid_blocks = 0;
  if (!grid_blocks) {
    int dev = 0, cus = 0, per_cu = 0;
    (void)hipGetDevice(&dev);
    (void)hipDeviceGetAttribute(&cus, hipDeviceAttributeMultiprocessorCount, dev);
    (void)hipFuncSetAttribute((const void*)mega, hipFuncAttributeMaxDynamicSharedMemorySize, (int)kLds);
    (void)hipOccupancyMaxActiveBlocksPerMultiprocessor(&per_cu, (const void*)mega, 512, kLds);
    if (per_cu < 1) per_cu = 1;
    grid_blocks = cus * per_cu;
    if (ws_size < (size_t)WS_END) fprintf(stderr, "workspace too small: %zu < %ld\n", ws_size, WS_END);
  }
  Params p{};
  p.xp = (const float*)d_in[0]; p.xs = (const float*)d_in[1]; p.sca = (const float*)d_in[2]; p.scq = (const float*)d_in[3];
  p.sdel = (const float*)d_in[4]; p.meta = (const float*)d_in[5]; p.normw = (const float*)d_in[6]; p.win = (const float*)d_in[7];
  p.cvaw = (const float*)d_in[8]; p.cvqw = (const float*)d_in[9]; p.alog = (const float*)d_in[10]; p.dtb = (const float*)d_in[11];
  p.onw = (const float*)d_in[12]; p.wout = (const float*)d_in[13]; p.fnw = (const float*)d_in[14];
  p.out = (float*)d_out; p.ws = (unsigned char*)d_ws;
  (void)hipMemsetAsync((unsigned char*)d_ws + OFF_BAR, 0, XCD_BAR_WORDS * sizeof(unsigned), stream);
  void* args[] = {&p};
  hipError_t e = hipLaunchCooperativeKernel((void*)mega, dim3(grid_blocks), dim3(512), args, kLds, stream);
  if (e != hipSuccess) fprintf(stderr, "cooperative launch failed: %s (grid %d)\n", hipGetErrorString(e), grid_blocks);
}
```

```cpp
#include <hip/hip_runtime.h>
#include <hip/hip_bf16.h>
#include <hip/hip_cooperative_groups.h>
#include <cstdio>
namespace cg = cooperative_groups;

typedef unsigned short u16;
using bf16x8 = __attribute__((ext_vector_type(8))) short;
using f32x4 = __attribute__((ext_vector_type(4))) float;

constexpr int DM = 2048;
constexpr int NP = 8208;
constexpr int NPP = 8448;
constexpr int TP = 8208;
constexpr int ROWS_P = 4 * TP;
constexpr int ROWS = ROWS_P + 512;
constexpr int ROWSP = 33536;
constexpr int NCHUNK = 524;
constexpr int NITEM = NCHUNK * 8;
constexpr float EPS = 1e-6f;

constexpr long OFF_WTIN = 0;
constexpr long OFF_WTOUT = OFF_WTIN + 2L * NPP * DM * 2;
constexpr long OFF_HB = OFF_WTOUT + 2L * DM * DM * 2;
constexpr long OFF_PROJ = OFF_HB + (long)ROWSP * DM * 2;
constexpr long OFF_YMIX = OFF_PROJ + (long)ROWS * NP * 2;
constexpr long OFF_SUMSQ = OFF_YMIX + (long)ROWSP * DM * 2;
constexpr long OFF_EGL = OFF_SUMSQ + 3L * ROWSP * 4;
constexpr long OFF_QK = OFF_EGL + 16896;
constexpr long OFF_UT = OFF_QK + (long)NITEM * 4096 * 2;
constexpr long OFF_BAR = OFF_UT + (long)NITEM * 8192 * 2;
constexpr long WS_END = OFF_BAR + 16384;
constexpr long OOFF_W = 0;
constexpr long OOFF_QG = OOFF_W + (long)NITEM * 8192 * 2;
constexpr long OOFF_KPT = OOFF_QG + (long)NITEM * 8192 * 2;
constexpr long YS_OFF = 67108864L;
constexpr long PCA_OFF = YS_OFF + 1048576L;
constexpr long PCQ_OFF = PCA_OFF + 16384L;
constexpr long PD_OFF = PCQ_OFF + 73728L;
constexpr long SCA_OFF = PD_OFF + 1048576L;
constexpr long SCQ_OFF = SCA_OFF + 32768L;
constexpr long SD_OFF = SCQ_OFF + 147456L;

struct Params {
  const float *xp, *xs, *sca, *scq, *sdel, *meta, *normw, *win, *cvaw, *cvqw, *alog, *dtb, *onw, *wout, *fnw;
  float* out;
  unsigned char* ws;
};

typedef __bf16 bf16x2_t __attribute__((ext_vector_type(2)));
typedef float f32x2_t __attribute__((ext_vector_type(2)));
__device__ __forceinline__ unsigned pack2(float a, float b) {
#if defined(__HIP_DEVICE_COMPILE__)
  f32x2_t v = {a, b};
  return __builtin_bit_cast(unsigned, __builtin_convertvector(v, bf16x2_t));
#else
  return 0u;
#endif
}
__device__ __forceinline__ u16 f2bf(float f) { return (u16)(pack2(f, 0.f) & 0xffffu); }
__device__ __forceinline__ int opaque_tid() { int t; asm volatile("v_mov_b32 %0, %1" : "=v"(t) : "v"((int)threadIdx.x)); return t; }
__device__ __forceinline__ float bf2f(u16 h) { return __uint_as_float(((unsigned)h) << 16); }
__device__ __forceinline__ uint2 pack4(float a, float b, float c, float d) { return make_uint2(pack2(a, b), pack2(c, d)); }
__device__ __forceinline__ void unpack4(uint2 v, float* o) {
  o[0] = __uint_as_float(v.x << 16); o[1] = __uint_as_float(v.x & 0xffff0000u);
  o[2] = __uint_as_float(v.y << 16); o[3] = __uint_as_float(v.y & 0xffff0000u);
}
__device__ __forceinline__ void unpack8(uint4 v, float* o) {
  o[0] = __uint_as_float(v.x << 16); o[1] = __uint_as_float(v.x & 0xffff0000u);
  o[2] = __uint_as_float(v.y << 16); o[3] = __uint_as_float(v.y & 0xffff0000u);
  o[4] = __uint_as_float(v.z << 16); o[5] = __uint_as_float(v.z & 0xffff0000u);
  o[6] = __uint_as_float(v.w << 16); o[7] = __uint_as_float(v.w & 0xffff0000u);
}
__device__ __forceinline__ float silu_f(float x) { return x * __frcp_rn(1.f + __expf(-x)); }
__device__ __forceinline__ f32x4 mfma16(bf16x8 a, bf16x8 b, f32x4 c) {
  return __builtin_amdgcn_mfma_f32_16x16x32_bf16(a, b, c, 0, 0, 0);
}
__device__ __forceinline__ bf16x8 ldfrag(const u16* base, int stride, int row, int k) {
  return *reinterpret_cast<const bf16x8*>(base + row * stride + k);
}

__device__ __forceinline__ void l2_touch(const void* ptr) {
  (void)ptr;
}
__device__ __forceinline__ unsigned touch_ld(const void* ptr) { return *reinterpret_cast<const unsigned*>(ptr); }
__device__ __forceinline__ void touch_use(unsigned& acc, unsigned v) { asm volatile("v_add_u32 %0, %0, %1" : "+v"(acc) : "v"(v)); }

__device__ __forceinline__ f32x4 mm16(const float* X, int xr, int xc, const float* Y, int yr, int yc, int kn, int fr, int fq) {
  f32x4 c = {0.f, 0.f, 0.f, 0.f};
  for (int k0 = 0; k0 < kn; k0 += 4) {
    const float a = X[(xr + fr) * 68 + xc + k0 + fq];
    const float b = Y[(yr + k0 + fq) * 68 + yc + fr];
    c = __builtin_amdgcn_mfma_f32_16x16x4f32(a, b, c, 0, 0, 0);
  }
  return c;
}

__device__ __forceinline__ void transpose_tiles(const float* __restrict__ src, u16* __restrict__ dst, const float* __restrict__ scale,
                                                int nsrc, int ntile_n, unsigned char* smem, int widx, int wcnt, bool perm) {
  float* tile = (float*)smem;
  const int tid = opaque_tid();
  const int ntiles = 32 * ntile_n;
  for (int t = widx; t < ntiles; t += wcnt) {
    const int kt = t & 31, nt = t >> 5;
    const int k0 = kt * 64, n0 = nt * 64;
    {
      const int nl = tid & 63, kb = tid >> 6;
#pragma unroll
      for (int it = 0; it < 8; ++it) {
        const int kl = kb + it * 8;
        const int n = (perm && n0 < 4096) ? ((nl >> 4) * 1024 + (n0 >> 6) * 16 + (nl & 15)) : n0 + nl;
        float v = 0.f;
        if (n < nsrc) v = src[(long)(k0 + kl) * nsrc + n] * (scale ? scale[k0 + kl] : 1.f);
        tile[kl * 65 + nl] = v;
      }
    }
    __syncthreads();
    {
      const int nl = tid >> 3, kg = tid & 7;
      float v[8];
#pragma unroll
      for (int e = 0; e < 8; ++e) v[e] = tile[(kg * 8 + e) * 65 + nl];
      uint4 o;
      o.x = pack2(v[0], v[1]); o.y = pack2(v[2], v[3]); o.z = pack2(v[4], v[5]); o.w = pack2(v[6], v[7]);
      *reinterpret_cast<uint4*>(dst + (long)(n0 + nl) * DM + k0 + kg * 8) = o;
    }
    __syncthreads();
  }
}

__device__ __forceinline__ void phase_prep(const Params& p, unsigned char* smem) {
  const int tid = opaque_tid(), wv = tid >> 6, lane = tid & 63;
  u16* hb = (u16*)(p.ws + OFF_HB);
  float* sumsq = (float*)(p.ws + OFF_SUMSQ);
  for (int r = blockIdx.x * 8 + wv; r < ROWSP; r += gridDim.x * 8) {
    const float* src = nullptr;
    if (r < ROWS_P) {
      const int b = r / TP, t = r - b * TP;
      src = (t < 16) ? (p.meta + (long)t * DM) : (p.xp + ((long)b * 8192 + (t - 16)) * DM);
    } else if (r < ROWS) {
      src = p.xs + (long)(r - ROWS_P) * DM;
    }
    float ss = 0.f;
#pragma unroll
    for (int i = 0; i < 8; ++i) {
      const int c = (i * 64 + lane) * 4;
      float4 v = make_float4(0.f, 0.f, 0.f, 0.f);
      if (src) v = *reinterpret_cast<const float4*>(src + c);
      ss += v.x * v.x + v.y * v.y + v.z * v.z + v.w * v.w;
      *reinterpret_cast<uint2*>(hb + (long)r * DM + c) = pack4(v.x, v.y, v.z, v.w);
    }
#pragma unroll
    for (int o = 32; o > 0; o >>= 1) ss += __shfl_xor(ss, o);
    if (lane == 0) sumsq[r] = ss;
  }
  for (long i = (long)blockIdx.x * 512 + tid; i < 2L * ROWSP; i += (long)gridDim.x * 512) sumsq[ROWSP + i] = 0.f;
  transpose_tiles(p.win, (u16*)(p.ws + OFF_WTIN), p.normw, NP, NPP / 64, smem, blockIdx.x, gridDim.x, true);
  transpose_tiles(p.wout, (u16*)(p.ws + OFF_WTOUT), nullptr, DM, DM / 64, smem, blockIdx.x, gridDim.x, false);
}

constexpr int BM = 256, BK = 64, HALF = 128, HT = HALF * BK;

__device__ __forceinline__ int lds_byte(int r, int c) {
  int st = (r >> 4) * 2 + (c >> 5), rr = r & 15, cc = c & 31, ob = rr * 64 + cc * 2;
  return st * 1024 + (ob ^ (((ob >> 9) & 1) << 5));
}
__device__ __forceinline__ void stage_rc(int b, int& R, int& C) {
  int st = b / 1024, sb = b % 1024, swz = sb ^ (((sb >> 9) & 1) << 5);
  R = (st >> 1) * 16 + swz / 64; C = (st & 1) * 32 + (swz % 64) / 2;
}

template <int EPI>
__device__ __forceinline__ void gemm_phase(const Params& p, int layer, unsigned char* smem) {
  typedef __hip_bfloat16 bf16;
  bf16* shm = (bf16*)smem;
  const bf16* A = (const bf16*)(p.ws + (EPI == 1 ? OFF_HB : OFF_YMIX));
  const bf16* Bt = (EPI == 1) ? (const bf16*)(p.ws + OFF_WTIN) + (long)layer * NPP * DM
                              : (const bf16*)(p.ws + OFF_WTOUT) + (long)layer * DM * DM;
  constexpr int K = DM;
  constexpr int nM = ROWSP / BM;
  constexpr int nN = (EPI == 1) ? NPP / BM : DM / BM;
  constexpr int WGM = 4;
  constexpr int nwg = nM * nN;
#define SA(b, h) (shm + ((b) * 2 + (h)) * HT)
#define SB(b, h) (shm + (4 + (b) * 2 + (h)) * HT)
#define OA(b, h) ((((b) * 2 + (h)) * HT) * 2)
#define OB(b, h) (((4 + (b) * 2 + (h)) * HT) * 2)
#define STAGE(PO, BASE, br, kt) do { const char* _ub = (const char*)(BASE) + ((long)(br) * K + (long)(kt) * BK) * 2; \
      asm volatile("s_add_u32 m0, %0, %3\n\ts_nop 0\n\tglobal_load_lds_dwordx4 %1, %2" :: "s"(ldsw), "v"(soff0), "s"(_ub), "n"(PO) : "memory", "scc"); \
      asm volatile("s_add_u32 m0, %0, %3\n\ts_nop 0\n\tglobal_load_lds_dwordx4 %1, %2" :: "s"(ldsw), "v"(soff1), "s"(_ub), "n"((PO) + 8192) : "memory", "scc"); } while (0)
#define LDA(dst, b, h) for (int m = 0; m < 4; ++m) for (int k = 0; k < 2; ++k) \
    dst[m][k] = *reinterpret_cast<const bf16x8*>((char*)SA(b, h) + lds_byte(wr * 64 + m * 16 + fr, k * 32 + fq * 8))
#define LDB(dst, b, h) for (int n = 0; n < 2; ++n) for (int k = 0; k < 2; ++k) \
    dst[n][k] = *reinterpret_cast<const bf16x8*>((char*)SB(b, h) + lds_byte(wc * 32 + n * 16 + fr, k * 32 + fq * 8))
#define MMA(ai, bj, At, Bt_) do { __builtin_amdgcn_s_setprio(1); \
    for (int m = 0; m < 4; ++m) for (int n = 0; n < 2; ++n) for (int k = 0; k < 2; ++k) \
      acc[ai][bj][m][n] = __builtin_amdgcn_mfma_f32_16x16x32_bf16(At[m][k], Bt_[n][k], acc[ai][bj][m][n], 0, 0, 0); \
    __builtin_amdgcn_s_setprio(0); } while (0)
#define WAIT_V(n) asm volatile("s_waitcnt vmcnt(" #n ")" ::: "memory")
#define WAIT_L(n) asm volatile("s_waitcnt lgkmcnt(" #n ")" ::: "memory")
#define BAR __builtin_amdgcn_s_barrier()
#define SCHED __builtin_amdgcn_sched_barrier(0)

  const int gtid = opaque_tid() & 511;
  const int wid = __builtin_amdgcn_readfirstlane(gtid >> 6), lane = gtid & 63, wr = wid >> 2, wc = wid & 3, fr = lane & 15, fq = lane >> 4;
  unsigned soff0, soff1;
  { int _r, _c; stage_rc(gtid * 16, _r, _c); soff0 = (unsigned)(_r * K + _c) * 2u;
    stage_rc(gtid * 16 + 8192, _r, _c); soff1 = (unsigned)(_r * K + _c) * 2u; }
  const unsigned ldsw = (unsigned)(size_t)((__attribute__((address_space(3))) unsigned char*)smem) + (unsigned)wid * 1024u;
  int gdim = (int)gridDim.x;
  asm volatile("" : "+s"(gdim));
  int vb = blockIdx.x;
  if ((gdim & 7) == 0) vb = (blockIdx.x & 7) * (gdim >> 3) + (blockIdx.x >> 3);
  constexpr int nig = WGM * nN;
#define TILE_RC(wg, BR, BC) do { const int gid_ = (wg) / nig, fm_ = gid_ * WGM, gsz_ = min(nM - fm_, WGM); \
    BC = (fm_ + (((wg) % nig) % gsz_)) * BM; BR = (((wg) % nig) / gsz_) * BM; } while (0)
  int brow = 0, bcol = 0;
  if (vb < nwg) {
    TILE_RC(vb, brow, bcol);
    STAGE(OB(0, 0), A, bcol, 0); STAGE(OA(0, 0), Bt, brow, 0);
    STAGE(OB(0, 1), A, bcol + HALF, 0); STAGE(OA(0, 1), Bt, brow + HALF, 0);
  }
  for (int wgid = vb; wgid < nwg; wgid += gdim) {
    f32x4 acc[2][2][4][2] = {};
    bf16x8 At[4][2], B0[2][2], B1[2][2];
    constexpr int nt = K / BK;
    if (wr == 1) BAR;
    WAIT_V(4); BAR;
    STAGE(OB(1, 0), A, bcol, 1); STAGE(OA(1, 0), Bt, brow, 1); STAGE(OB(1, 1), A, bcol + HALF, 1);
    WAIT_V(6); BAR;
    for (int t = 0; t < nt - 2; t += 2) {
      LDB(B0, 0, 0); SCHED; LDA(At, 0, 0); STAGE(OA(1, 1), Bt, brow + HALF, t + 1);
      WAIT_L(8); BAR; WAIT_L(0); MMA(0, 0, At, B0); BAR; SCHED;
      LDB(B1, 0, 1); STAGE(OB(0, 0), A, bcol, t + 2);
      BAR; WAIT_L(0); MMA(0, 1, At, B1); BAR;
      LDA(At, 0, 1); STAGE(OA(0, 0), Bt, brow, t + 2);
      BAR; WAIT_L(0); MMA(1, 0, At, B0); BAR; SCHED;
      STAGE(OB(0, 1), A, bcol + HALF, t + 2);
      WAIT_V(6); BAR; MMA(1, 1, At, B1); BAR;
      LDB(B0, 1, 0); SCHED; LDA(At, 1, 0); STAGE(OA(0, 1), Bt, brow + HALF, t + 2);
      WAIT_L(8); BAR; WAIT_L(0); MMA(0, 0, At, B0); BAR; SCHED;
      LDB(B1, 1, 1); STAGE(OB(1, 0), A, bcol, t + 3);
      BAR; WAIT_L(0); MMA(0, 1, At, B1); BAR;
      LDA(At, 1, 1); STAGE(OA(1, 0), Bt, brow, t + 3);
      BAR; WAIT_L(0); MMA(1, 0, At, B0); BAR; SCHED;
      STAGE(OB(1, 1), A, bcol + HALF, t + 3);
      WAIT_V(6); BAR; MMA(1, 1, At, B1); BAR;
    }
    { LDB(B0, 0, 0); LDA(At, 0, 0); STAGE(OA(1, 1), Bt, brow + HALF, nt - 1);
      BAR; WAIT_L(0); MMA(0, 0, At, B0); BAR;
      LDB(B1, 0, 1); BAR; WAIT_L(0); MMA(0, 1, At, B1); BAR;
      LDA(At, 0, 1); WAIT_V(4); BAR; WAIT_L(0); MMA(1, 0, At, B0); MMA(1, 1, At, B1); BAR; }
    { LDB(B0, 1, 0); LDA(At, 1, 0); WAIT_V(2); BAR; WAIT_L(0); MMA(0, 0, At, B0); BAR;
      LDB(B1, 1, 1); WAIT_V(0); BAR; WAIT_L(0); MMA(0, 1, At, B1); BAR;
      LDA(At, 1, 1); BAR; WAIT_L(0); MMA(1, 0, At, B0); MMA(1, 1, At, B1); BAR; }
    if (wr == 0) BAR;
    const int erow = brow, ecol = bcol;
    if (wgid + gdim < nwg) {
      TILE_RC(wgid + gdim, brow, bcol);
      STAGE(OB(0, 0), A, bcol, 0); STAGE(OA(0, 0), Bt, brow, 0);
      STAGE(OB(0, 1), A, bcol + HALF, 0); STAGE(OA(0, 1), Bt, brow + HALF, 0);
    }
    if (EPI == 1) {
      u16* proj = (u16*)(p.ws + OFF_PROJ);
      const float* sumsq = (const float*)(p.ws + OFF_SUMSQ) + (long)layer * ROWSP;
#pragma unroll
      for (int bj = 0; bj < 2; ++bj)
#pragma unroll
        for (int n = 0; n < 2; ++n) {
          const int tok = ecol + bj * HALF + wc * 32 + n * 16 + fr;
          if (tok < ROWS) {
            const float rs = rsqrtf(sumsq[tok] * (1.f / DM) + EPS);
            u16* prow = proj + (long)tok * NP;
            if (erow < 4096) {
#pragma unroll
              for (int ai = 0; ai < 2; ++ai) {
                const int c0 = ((erow >> 6) + ai * 2 + wr) * 16 + fq * 4;
                float uu[4], gg[4];
#pragma unroll
                for (int j = 0; j < 4; ++j) {
                  uu[j] = (acc[ai][bj][1][n][j] * rs) * (acc[ai][bj][2][n][j] * rs);
                  gg[j] = (acc[ai][bj][0][n][j] * rs) * silu_f(acc[ai][bj][3][n][j] * rs);
                }
                *reinterpret_cast<uint2*>(prow + 1024 + c0) = pack4(uu[0], uu[1], uu[2], uu[3]);
                *reinterpret_cast<uint2*>(prow + c0) = pack4(gg[0], gg[1], gg[2], gg[3]);
              }
            } else
#pragma unroll
            for (int ai = 0; ai < 2; ++ai)
#pragma unroll
              for (int m = 0; m < 4; ++m) {
                const int n0 = erow + ai * HALF + wr * 64 + m * 16 + fq * 4;
                if (n0 < NP)
                  *reinterpret_cast<uint2*>(prow + n0) = pack4(acc[ai][bj][m][n][0] * rs, acc[ai][bj][m][n][1] * rs,
                                                                acc[ai][bj][m][n][2] * rs, acc[ai][bj][m][n][3] * rs);
              }
          }
        }
    } else {
      u16* hb = (u16*)(p.ws + OFF_HB);
      float* sumsq = (float*)(p.ws + OFF_SUMSQ) + (long)(EPI == 2 ? 1 : 2) * ROWSP;
#pragma unroll
      for (int bj = 0; bj < 2; ++bj)
#pragma unroll
        for (int n = 0; n < 2; ++n) {
          const int tok = ecol + bj * HALF + wc * 32 + n * 16 + fr;
          float* dst = nullptr;
          if (EPI == 3) {
            if (tok < ROWS_P) {
              const int b = tok / TP, t = tok - b * TP;
              if (t >= 16) dst = p.out + ((long)b * 8192 + (t - 16)) * DM;
            } else if (tok < ROWS) {
              dst = p.out + YS_OFF + (long)(tok - ROWS_P) * DM;
            }
          }
          u16* hrow = hb + (long)tok * DM;
          float rsum = 0.f;
#pragma unroll
          for (int ai = 0; ai < 2; ++ai)
#pragma unroll
            for (int m = 0; m < 4; ++m) {
              const int n0 = erow + ai * HALF + wr * 64 + m * 16 + fq * 4;
              float r4[4];
              unpack4(*reinterpret_cast<const uint2*>(hrow + n0), r4);
              float v[4];
#pragma unroll
              for (int j = 0; j < 4; ++j) { v[j] = acc[ai][bj][m][n][j] + r4[j]; rsum += v[j] * v[j]; }
              if (EPI == 2) *reinterpret_cast<uint2*>(hrow + n0) = pack4(v[0], v[1], v[2], v[3]);
              else if (dst) *reinterpret_cast<float4*>(dst + n0) = make_float4(v[0], v[1], v[2], v[3]);
            }
          rsum += __shfl_xor(rsum, 16); rsum += __shfl_xor(rsum, 32);
          if (fq == 0) atomicAdd(&sumsq[tok], rsum);
        }
    }
  }
  __syncthreads();
  if (EPI == 2) {
    const int rem = nwg % gdim;
    const int widx = (vb >= rem) ? vb - rem : -1, wcnt = gdim - rem;
    if (wcnt <= 0) {
      transpose_tiles(p.win + (long)DM * NP, (u16*)(p.ws + OFF_WTIN) + (long)NPP * DM, p.normw + DM, NP, NPP / 64, smem, vb, gdim, true);
      transpose_tiles(p.wout + (long)DM * DM, (u16*)(p.ws + OFF_WTOUT) + (long)DM * DM, nullptr, DM, DM / 64, smem, vb, gdim, false);
    } else if (widx >= 0) {
      transpose_tiles(p.win + (long)DM * NP, (u16*)(p.ws + OFF_WTIN) + (long)NPP * DM, p.normw + DM, NP, NPP / 64, smem, widx, wcnt, true);
      transpose_tiles(p.wout + (long)DM * DM, (u16*)(p.ws + OFF_WTOUT) + (long)DM * DM, nullptr, DM, DM / 64, smem, widx, wcnt, false);
    }
  }
#undef TILE_RC
#undef SA
#undef SB
#undef OA
#undef OB
#undef STAGE
#undef LDA
#undef LDB
#undef MMA
}

#define XB_TMO      128
#define XB_XCNT(j)  (256  + 64 * (j))
#define XB_XSUB(j)  (1280 + 64 * (j))
#define XB_XGEN(j)  (2304 + 64 * (j))
#define XB_TOP      3328
#define XB_TOPGEN   3392
#define XCD_BAR_WORDS 3456
#define XB_SPIN_CAP (1u << 18)
#define LAS __attribute__((address_space(3)))
__device__ __forceinline__ unsigned xb_ld(unsigned* p)              { return __hip_atomic_load(p, __ATOMIC_RELAXED, __HIP_MEMORY_SCOPE_AGENT); }
__device__ __forceinline__ unsigned xb_add(unsigned* p, unsigned v) { return __hip_atomic_fetch_add(p, v, __ATOMIC_RELAXED, __HIP_MEMORY_SCOPE_AGENT); }
__device__ __forceinline__ unsigned xb_xcc_id() { return (unsigned)__builtin_amdgcn_s_getreg((3 << 11) | 20) & 0xFu; }
#define XB_SPIN(cond, bar) do { unsigned _sp = 0; while (cond) { __builtin_amdgcn_s_sleep(1); \
    if ((++_sp & 255u) == 0u) { if (xb_ld(&(bar)[XB_TMO])) break; if (_sp > XB_SPIN_CAP) { atomicAdd(&(bar)[XB_TMO], 1u); break; } } } } while (0)
struct XcdBarrier { unsigned* bar; unsigned x; volatile LAS unsigned* st; };
__device__ __forceinline__ XcdBarrier xcd_barrier_post(unsigned* bar, volatile LAS unsigned* st) {
  XcdBarrier b; b.bar = bar; b.x = xb_xcc_id(); b.st = st;
  if (threadIdx.x == 0) (void)xb_add(&bar[XB_XCNT(b.x)], 1u);
  return b;
}
__device__ __forceinline__ void xcd_barrier_complete(unsigned* bar, unsigned x, unsigned& nloc, unsigned& nx) {
  const unsigned G = gridDim.x * gridDim.y * gridDim.z;
  unsigned sum, cnt, mine, sp = 0u;
  for (;;) {
    sum = 0u; cnt = 0u; mine = 0u;
#pragma unroll
    for (unsigned j = 0; j < 16; ++j) { const unsigned c = xb_ld(&bar[XB_XCNT(j)]); sum += c; cnt += (c > 0u) ? 1u : 0u; mine = (j == x) ? c : mine; }
    if (sum == G) break;
    __builtin_amdgcn_s_sleep(1);
    if ((++sp & 255u) == 0u) { if (xb_ld(&bar[XB_TMO])) break; if (sp > XB_SPIN_CAP) { atomicAdd(&bar[XB_TMO], 1u); break; } }
  }
  nloc = mine > 0u ? mine : 1u; nx = cnt > 0u ? cnt : 1u;
}
__device__ __forceinline__ void xcd_barrier(const XcdBarrier& b) {
  asm volatile("s_waitcnt vmcnt(0)" ::: "memory");
  __syncthreads();
  if (threadIdx.x == 0) {
    unsigned* bar = b.bar;
    __builtin_amdgcn_s_waitcnt(0);
    unsigned nloc = b.st[0], nx = b.st[1];
    if (nloc == 0u) { xcd_barrier_complete(bar, b.x, nloc, nx); b.st[0] = nloc; b.st[1] = nx; }
    const unsigned old = xb_add(&bar[XB_XSUB(b.x)], 1u);
    const unsigned gen = old / nloc;
    if (old + 1u == (gen + 1u) * nloc) {
      __builtin_amdgcn_fence(__ATOMIC_RELEASE, "agent");
      asm volatile("s_waitcnt vmcnt(0)" ::: "memory");
      const unsigned og = xb_add(&bar[XB_TOP], 1u);
      const unsigned tg = og / nx;
      if (og + 1u == (tg + 1u) * nx) xb_add(&bar[XB_TOPGEN], 1u);
      else XB_SPIN(xb_ld(&bar[XB_TOPGEN]) == tg, bar);
      __builtin_amdgcn_fence(__ATOMIC_ACQUIRE, "agent");
      xb_add(&bar[XB_XGEN(b.x)], 1u);
      asm volatile("s_waitcnt vmcnt(0)" ::: "memory");
    } else {
      XB_SPIN(xb_ld(&bar[XB_XGEN(b.x)]) == gen, bar);
      __builtin_amdgcn_fence(__ATOMIC_ACQUIRE, "agent");
      asm volatile("s_waitcnt vmcnt(0)" ::: "memory");
    }
  }
  __syncthreads();
}

__device__ __forceinline__ void chunk_geom(int cid, int& row0, int& nvalid, int& prevmode, int& sidx, bool& lastc) {
  if (cid < 516) {
    const int s = cid / 129, c = cid - s * 129;
    sidx = s; lastc = (c == 128);
    if (c == 0) { row0 = s * TP; nvalid = 16; prevmode = 0; }
    else { row0 = s * TP + 16 + (c - 1) * 64; nvalid = 64; prevmode = 1; }
  } else {
    sidx = cid - 516; row0 = ROWS_P + sidx * 64; nvalid = 64; prevmode = 2; lastc = true;
  }
}

__device__ __forceinline__ long item_slot(int cid, int h) {
  if (cid < 516) { const int s = cid / 129, c = cid - s * 129; return (long)((s * 8 + h) * 129 + c); }
  return (long)(4128 + (cid - 516) * 8 + h);
}

__device__ __forceinline__ void chunk_prep(const Params& p, int layer, int item, int nitem, unsigned char* smem) {
  const int tid = opaque_tid() & 511, wv = __builtin_amdgcn_readfirstlane(tid >> 6), lane = tid & 63, fr = lane & 15, fq = lane >> 4;
  const int cid = item >> 3, h = item & 7;
  int row0, nvalid, prevmode, sidx; bool lastc;
  chunk_geom(cid, row0, nvalid, prevmode, sidx, lastc);
  u16* sKB = (u16*)smem;
  u16* sK = sKB + 64 * 136;
  u16* sQ = sK + 64 * 136;
  u16* sVBT = sQ + 64 * 136;
  u16* sKBGT = sVBT + 128 * 72;
  u16* sT = sKBGT + 128 * 72;
  float* sA = (float*)(sT + 64 * 72);
  float* sBeta = sA + 64 * 68;
  float* sGc = sBeta + 64;
  u16* sKPT = (u16*)(sGc + 64);
  float* sTf = (float*)smem;
  float* sY = sTf + 64 * 68;
  int zoff;
  asm volatile("v_mov_b32 %0, 0" : "=v"(zoff));
  const u16* proj = (const u16*)(p.ws + OFF_PROJ);
  const long slot = item_slot(cid, h);
  u16* Wd = (u16*)((unsigned char*)p.out) + slot * 24576;
  u16* QG = Wd + 8192;
  u16* KPT = Wd + 16384;
  u16* UTd = (u16*)(p.ws + OFF_QK) + slot * 12288;
  u16* QKd = UTd + 8192;
  float* EGL = (float*)(p.ws + OFF_EGL);

  unsigned tch = 0;
  {
    if (nitem >= 0) {
      int nrow0, nnv, npm, nsi; bool nl;
      chunk_geom(nitem >> 3, nrow0, nnv, npm, nsi, nl);
      const int nh = nitem & 7;
      if (tid < 402) {
        const int r = tid / 6, m6 = tid - r * 6;
        tch = touch_ld(proj + (long)(nrow0 - 3 + r) * NP + 4096 + (m6 >> 1) * 1024 + nh * 128 + (m6 & 1) * 64);
      } else if (tid >= 448) {
        tch = touch_ld(proj + (long)(nrow0 + (tid - 448)) * NP + 8192 + nh);
      }
    }
  }
  if (wv == 0) {
    float beta = 0.f, g = 0.f;
    if (lane < nvalid) {
      const long rb = (long)(row0 + lane) * NP;
      const float bl = bf2f(proj[rb + 8192 + h]);
      const float al = bf2f(proj[rb + 8200 + h]) + p.dtb[layer * 8 + h];
      beta = 1.f / (1.f + expf(-bl));
      const float sp = (al > 20.f) ? al : log1pf(expf(al));
      g = -expf(p.alog[layer * 8 + h]) * sp;
    }
    float gc = g;
#pragma unroll
    for (int o = 1; o < 64; o <<= 1) { const float t = __shfl_up(gc, o); if (lane >= o) gc += t; }
    sBeta[lane] = beta; sGc[lane] = gc;
  }

  const int rg = tid >> 5, cg = tid & 31, i0 = rg * 4, d0 = cg * 4;
  float qv[4][4], kv[4][4], vv[4][4];
#pragma unroll
  for (int mat = 0; mat < 3; ++mat) {
    const int ch = mat * 1024 + h * 128 + d0;
    const int colbase = 4096 + ch;
    float xr[7][4];
#pragma unroll
    for (int a = 0; a < 7; ++a) {
      const int ri = i0 - 3 + a;
      if (ri >= 0 || prevmode == 1) {
        uint2 raw = *reinterpret_cast<const uint2*>(proj + (long)(row0 + ri) * NP + colbase);
        unpack4(raw, xr[a]);
      } else if (prevmode == 2) {
        const float4 v = *reinterpret_cast<const float4*>(p.scq + ((long)(layer * 8 + sidx) * 3 + (3 + ri)) * 3072 + ch);
        xr[a][0] = v.x; xr[a][1] = v.y; xr[a][2] = v.z; xr[a][3] = v.w;
      } else {
        xr[a][0] = xr[a][1] = xr[a][2] = xr[a][3] = 0.f;
      }
    }
    if (lastc && rg == 15) {
      float* dst = p.out + (prevmode == 2 ? SCQ_OFF + (long)(layer * 8 + sidx) * 3 * 3072 : PCQ_OFF + (long)(layer * 4 + sidx) * 3 * 3072) + ch;
#pragma unroll
      for (int a = 4; a < 7; ++a)
        *reinterpret_cast<float4*>(dst + (a - 4) * 3072) = make_float4(xr[a][0], xr[a][1], xr[a][2], xr[a][3]);
    }
    float cw[4][4];
#pragma unroll
    for (int j = 0; j < 4; ++j) {
      const float4 v = *reinterpret_cast<const float4*>(p.cvqw + (long)(layer * 4 + j) * 3072 + ch);
      cw[j][0] = v.x; cw[j][1] = v.y; cw[j][2] = v.z; cw[j][3] = v.w;
    }
#pragma unroll
    for (int ii = 0; ii < 4; ++ii)
#pragma unroll
      for (int e = 0; e < 4; ++e) {
        float o = 0.f;
#pragma unroll
        for (int j = 0; j < 4; ++j) o += cw[j][e] * xr[ii + j][e];
        o = silu_f(o);
        if (mat == 0) qv[ii][e] = o; else if (mat == 1) kv[ii][e] = o; else vv[ii][e] = o;
      }
  }
#pragma unroll
  for (int ii = 0; ii < 4; ++ii) {
    float sq = 0.f, sk = 0.f;
#pragma unroll
    for (int e = 0; e < 4; ++e) { sq += qv[ii][e] * qv[ii][e]; sk += kv[ii][e] * kv[ii][e]; }
#pragma unroll
    for (int o = 1; o < 32; o <<= 1) { sq += __shfl_xor(sq, o); sk += __shfl_xor(sk, o); }
    const float rq = rsqrtf(sq + EPS) * 0.08838834764831845f, rk = rsqrtf(sk + EPS);
    const bool valid = (i0 + ii) < nvalid;
#pragma unroll
    for (int e = 0; e < 4; ++e) {
      qv[ii][e] = valid ? qv[ii][e] * rq : 0.f;
      kv[ii][e] = valid ? kv[ii][e] * rk : 0.f;
      vv[ii][e] = valid ? vv[ii][e] : 0.f;
    }
  }
  __syncthreads();
  float beta[4], gcv[4];
#pragma unroll
  for (int ii = 0; ii < 4; ++ii) { beta[ii] = sBeta[i0 + ii]; gcv[ii] = sGc[i0 + ii]; }
  const float glast = sGc[63];
  if (tid == 0) EGL[slot] = expf(glast);

#pragma unroll
  for (int ii = 0; ii < 4; ++ii) {
    const int i = i0 + ii;
    const float b = beta[ii];
    *reinterpret_cast<uint2*>(sKB + i * 136 + d0) = pack4(kv[ii][0] * b, kv[ii][1] * b, kv[ii][2] * b, kv[ii][3] * b);
    *reinterpret_cast<uint2*>(sK + i * 136 + d0) = pack4(kv[ii][0], kv[ii][1], kv[ii][2], kv[ii][3]);
    *reinterpret_cast<uint2*>(sQ + i * 136 + d0) = pack4(qv[ii][0], qv[ii][1], qv[ii][2], qv[ii][3]);

  }
  {
    float bg[4], kd[4];
#pragma unroll
    for (int ii = 0; ii < 4; ++ii) { bg[ii] = beta[ii] * __expf(gcv[ii]); kd[ii] = __expf(glast - gcv[ii]); }
#pragma unroll
    for (int e = 0; e < 4; ++e) {
      const int d = d0 + e;
      *reinterpret_cast<uint2*>(sVBT + d * 72 + i0) = pack4(vv[0][e] * beta[0], vv[1][e] * beta[1], vv[2][e] * beta[2], vv[3][e] * beta[3]);
      *reinterpret_cast<uint2*>(sKBGT + d * 72 + i0) = pack4(kv[0][e] * bg[0], kv[1][e] * bg[1], kv[2][e] * bg[2], kv[3][e] * bg[3]);
      *reinterpret_cast<uint2*>(sKPT + d * 72 + i0) = pack4(kv[0][e] * kd[0], kv[1][e] * kd[1], kv[2][e] * kd[2], kv[3][e] * kd[3]);
    }
  }
  __syncthreads();
#pragma unroll
  for (int t2 = 0; t2 < 2; ++t2) {
    {
      const int qib = wv >> 1, qkk = (wv & 1) * 2 + t2;
      const bf16x8 qf = ldfrag(sQ, 136, qib * 16 + fr, qkk * 32 + fq * 8);
      const float eg = __expf(sGc[qib * 16 + fr]);
      float qx[8];
      unpack8(__builtin_bit_cast(uint4, qf), qx);
      uint4 o;
      o.x = pack2(qx[0] * eg, qx[1] * eg); o.y = pack2(qx[2] * eg, qx[3] * eg);
      o.z = pack2(qx[4] * eg, qx[5] * eg); o.w = pack2(qx[6] * eg, qx[7] * eg);
      *reinterpret_cast<uint4*>(QG + (((qib * 4 + qkk) * 64 + lane) << 3)) = o;
    }
    *reinterpret_cast<bf16x8*>(KPT + (((wv * 2 + t2) * 64 + lane) << 3)) = ldfrag(sKPT, 72, wv * 16 + fr, t2 * 32 + fq * 8);
  }
  {
    const int ib = wv >> 1;
#pragma unroll
    for (int jj = 0; jj < 2; ++jj) {
      const int jb = (wv & 1) * 2 + jj;
      f32x4 c = {0.f, 0.f, 0.f, 0.f}, c2 = {0.f, 0.f, 0.f, 0.f};
#pragma unroll
      for (int kk = 0; kk < 4; ++kk) {
        const bf16x8 a = ldfrag(sKB, 136, ib * 16 + fr, kk * 32 + fq * 8);
        const bf16x8 b = ldfrag(sK, 136, jb * 16 + fr, kk * 32 + fq * 8);
        c = mfma16(a, b, c);
        const bf16x8 b2 = ldfrag(sQ, 136, ib * 16 + fr, kk * 32 + fq * 8);
        c2 = mfma16(b, b2, c2);
      }
      {
        const int j = jb * 16 + fr;
        const float gj = sGc[j];
#pragma unroll
        for (int r = 0; r < 4; ++r) {
          const int i = ib * 16 + fq * 4 + r;
          sA[i * 68 + j] = (i > j) ? c[r] * __expf(sGc[i] - gj) : 0.f;
        }
      }
      {
        const int i = ib * 16 + fr;
        const float gi = sGc[i];
        float o[4];
#pragma unroll
        for (int r = 0; r < 4; ++r) {
          const int j = jb * 16 + fq * 4 + r;
          o[r] = (i >= j) ? c2[r] * __expf(gi - sGc[j]) : 0.f;
        }
        *reinterpret_cast<uint2*>(QKd + ((((ib * 2 + (jb >> 1)) * 64) + ((jb & 1) * 2 + (fq >> 1)) * 16 + fr) << 3) + (fq & 1) * 4) = pack4(o[0], o[1], o[2], o[3]);
      }
    }
  }
  __syncthreads();
  {
    for (int e = tid; e < 64 * 68; e += 512) sTf[e] = 0.f;
    __syncthreads();
    if (wv < 4 && lane < 16) {
      const float* Ab = sA + (wv * 16) * 68 + wv * 16 + zoff;
      float t[16], ac[16], an[16];
      t[0] = (lane == 0) ? 1.f : 0.f;
      sTf[(wv * 16) * 68 + wv * 16 + lane] = t[0];
      ac[0] = Ab[68];
#pragma unroll
      for (int i = 1; i < 16; ++i) {
        if (i + 1 < 16) {
#pragma unroll
          for (int j = 0; j <= i; ++j) an[j] = Ab[(i + 1) * 68 + j];
        }
        float a = (lane == i) ? 1.f : 0.f;
#pragma unroll
        for (int j = 0; j < i; ++j) a -= ac[j] * t[j];
        t[i] = a;
        sTf[(wv * 16 + i) * 68 + wv * 16 + lane] = a;
        if (i + 1 < 16) {
#pragma unroll
          for (int j = 0; j <= i; ++j) ac[j] = an[j];
        }
        __builtin_amdgcn_sched_barrier(0);
      }
    }
    __syncthreads();
    if (wv < 2) {
      const int o = wv * 32;
      const f32x4 c = mm16(sA, o + 16, o, sTf, o, o, 16, fr, fq);
#pragma unroll
      for (int r = 0; r < 4; ++r) sY[(o + 16 + fq * 4 + r) * 68 + o + fr] = c[r];
    }
    __syncthreads();
    if (wv < 2) {
      const int o = wv * 32;
      const f32x4 c = mm16(sTf, o + 16, o + 16, sY, o + 16, o, 16, fr, fq);
#pragma unroll
      for (int r = 0; r < 4; ++r) sTf[(o + 16 + fq * 4 + r) * 68 + o + fr] = -c[r];
    }
    __syncthreads();
    if (wv < 4) {
      const int bi = wv >> 1, bj = wv & 1;
      const f32x4 c = mm16(sA, 32 + bi * 16, 0, sTf, 0, bj * 16, 32, fr, fq);
#pragma unroll
      for (int r = 0; r < 4; ++r) sY[(32 + bi * 16 + fq * 4 + r) * 68 + bj * 16 + fr] = c[r];
    }
    __syncthreads();
    if (wv < 4) {
      const int bi = wv >> 1, bj = wv & 1;
      const f32x4 c = mm16(sTf, 32 + bi * 16, 32, sY, 32, bj * 16, 32, fr, fq);
#pragma unroll
      for (int r = 0; r < 4; ++r) sTf[(32 + bi * 16 + fq * 4 + r) * 68 + bj * 16 + fr] = -c[r];
    }
    __syncthreads();
    {
      const int i = tid >> 3, j0 = (tid & 7) * 8;
      float v[8];
#pragma unroll
      for (int e = 0; e < 8; ++e) v[e] = sTf[i * 68 + j0 + e];
      uint4 o;
      o.x = pack2(v[0], v[1]); o.y = pack2(v[2], v[3]); o.z = pack2(v[4], v[5]); o.w = pack2(v[6], v[7]);
      *reinterpret_cast<uint4*>(sT + i * 72 + j0) = o;
    }
  }
  __syncthreads();
  {
    const int ib = wv >> 1;
#pragma unroll
    for (int x = 0; x < 4; ++x) {
      const int dvb = (wv & 1) * 4 + x;
      f32x4 c = {0.f, 0.f, 0.f, 0.f};
#pragma unroll
      for (int kk = 0; kk < 2; ++kk)
        c = mfma16(ldfrag(sT, 72, ib * 16 + fr, kk * 32 + fq * 8), ldfrag(sVBT, 72, dvb * 16 + fr, kk * 32 + fq * 8), c);
      *reinterpret_cast<uint2*>(UTd + (((dvb * 4 + ib) * 64 + lane) << 2)) = pack4(c[0], c[1], c[2], c[3]);
    }
#pragma unroll
    for (int ib2 = 0; ib2 < 4; ++ib2) {
      f32x4 c = {0.f, 0.f, 0.f, 0.f};
#pragma unroll
      for (int kk = 0; kk < 2; ++kk)
        c = mfma16(ldfrag(sKBGT, 72, wv * 16 + fr, kk * 32 + fq * 8), ldfrag(sT, 72, ib2 * 16 + fr, kk * 32 + fq * 8), c);
      *reinterpret_cast<uint2*>(Wd + ((((ib2 * 4 + (wv >> 1)) * 64) + ((wv & 1) * 2 + (fq >> 1)) * 16 + fr) << 3) + (fq & 1) * 4) = pack4(c[0], c[1], c[2], c[3]);
    }
  }
  __syncthreads();
  {
    unsigned tacc = 0;
    touch_use(tacc, tch);
    if (tacc == 0x9e3779b9u) ((volatile float*)EGL)[NITEM + 9] = 1.f;
  }
}

__device__ __forceinline__ void gdn_scan(const Params& p, int layer, int widx, unsigned char* smem, const XcdBarrier* xbp, int csplit) {
  const int tid = opaque_tid() & 511, wv = __builtin_amdgcn_readfirstlane(tid >> 6), lane = tid & 63, fr = lane & 15, fq = lane >> 4;
  const bool is_prompt = widx < 128;
  int s, h, sl, nsteps, cid0;
  if (is_prompt) { s = widx >> 5; h = (widx >> 2) & 7; sl = widx & 3; nsteps = 129; cid0 = s * 129; }
  else { const int j = widx - 128; s = j >> 5; h = (j >> 2) & 7; sl = j & 3; nsteps = 1; cid0 = 516 + s; }
  const int dv0 = sl * 32;
  u16* sST = (u16*)smem;
  u16* sVT = sST + 32 * 136;
  u16* sO = sVT + 32 * 72;
  const u16* R1g = (const u16*)((const unsigned char*)p.out);
  const u16* R2g = (const u16*)(p.ws + OFF_QK);
  const float* EGL = (const float*)(p.ws + OFF_EGL);
  const long slot0 = item_slot(cid0, h);
  const int rowbase = is_prompt ? s * TP : ROWS_P + s * 64;
  u16* ymix = (u16*)(p.ws + OFF_YMIX);

  f32x4 accS[2];
#pragma unroll
  for (int nb = 0; nb < 2; ++nb) {
    if (is_prompt) { accS[nb][0] = 0.f; accS[nb][1] = 0.f; accS[nb][2] = 0.f; accS[nb][3] = 0.f; }
    else {
      const float4 v = *reinterpret_cast<const float4*>(p.sdel + ((long)(layer * 8 + s) * 8 + h) * 16384 + (wv * 16 + fr) * 128 + dv0 + nb * 16 + fq * 4);
      accS[nb][0] = v.x; accS[nb][1] = v.y; accS[nb][2] = v.z; accS[nb][3] = v.w;
    }
#pragma unroll
    for (int r = 0; r < 4; ++r) sST[(nb * 16 + fq * 4 + r) * 136 + wv * 16 + fr] = f2bf(accS[nb][r]);
  }
  __syncthreads();
  const int part = wv >> 2;
  const int ib = wv & 3;
  int zoff;
  asm volatile("v_mov_b32 %0, 0" : "=v"(zoff));
#define LDS_BAR() asm volatile("s_waitcnt lgkmcnt(0)\n\ts_barrier" ::: "memory")
#define SCAN_LOAD(IT, F, G, KPF, UU0, UU1, EG) do { \
    const u16* R1p = R1g + (IT) * 24576; const u16* R2p = R2g + (IT) * 12288; \
    _Pragma("unroll") for (int kk = 0; kk < 2; ++kk) \
      KPF[kk] = *reinterpret_cast<const bf16x8*>(R1p + 16384 + (((wv * 2 + kk) * 64 + lane) << 3)); \
    EG = EGL[(IT) + zoff]; \
    { const u16* Fp = R1p + part * 8192;     \
      _Pragma("unroll") for (int kk = 0; kk < 4; ++kk) \
        F[kk] = *reinterpret_cast<const bf16x8*>(Fp + (((ib * 4 + kk) * 64 + lane) << 3)); } \
    if (part == 0) { \
      UU0 = *reinterpret_cast<const uint2*>(R2p + ((((sl * 2) * 4 + ib) * 64 + lane) << 2)); \
      UU1 = *reinterpret_cast<const uint2*>(R2p + ((((sl * 2 + 1) * 4 + ib) * 64 + lane) << 2)); \
    } else { \
      _Pragma("unroll") for (int kk = 0; kk < 2; ++kk) \
        G[kk] = *reinterpret_cast<const bf16x8*>(R2p + 8192 + (((ib * 2 + kk) * 64 + lane) << 3)); } } while (0)
#define SCAN_FLUSH(PROW0, PNV) do { \
    if (tid < 256) { const int i_ = tid >> 2, sg_ = tid & 3; \
      if (i_ < (PNV)) *reinterpret_cast<uint4*>(ymix + (long)((PROW0) + i_) * DM + 1024 + h * 128 + dv0 + sg_ * 8) = \
          *reinterpret_cast<const uint4*>(sO + i_ * 40 + sg_ * 8); } } while (0)
#define SCAN_STEP(STEP, F, G, KPF, UU0, UU1, EGLV, FN, GN, KPFN, UU0N, UU1N, EGLN) do { \
    const int row0 = (is_prompt && (STEP) > 0) ? rowbase + 16 + ((STEP) - 1) * 64 : rowbase; \
    const int nvalid = (is_prompt && (STEP) == 0) ? 16 : 64; \
    { const long itn = slot0 + min((STEP) + 2, nsteps - 1); \
      SCAN_LOAD(itn, FN, GN, KPFN, UU0N, UU1N, EGLN); } \
    if ((STEP) > 0) SCAN_FLUSH(prow0, pnv); \
    f32x4 c0 = {0.f, 0.f, 0.f, 0.f}, c1 = {0.f, 0.f, 0.f, 0.f}; \
    _Pragma("unroll") for (int kk = 0; kk < 4; ++kk) { \
      c0 = mfma16(F[kk], ldfrag(sST, 136, fr, kk * 32 + fq * 8), c0); \
      c1 = mfma16(F[kk], ldfrag(sST, 136, 16 + fr, kk * 32 + fq * 8), c1); } \
    if (part == 0) { \
      float u0[4], u1[4]; \
      unpack4(UU0, u0); unpack4(UU1, u1); \
      *reinterpret_cast<uint2*>(sVT + fr * 72 + ib * 16 + fq * 4) = pack4(u0[0] - c0[0], u0[1] - c0[1], u0[2] - c0[2], u0[3] - c0[3]); \
      *reinterpret_cast<uint2*>(sVT + (16 + fr) * 72 + ib * 16 + fq * 4) = pack4(u1[0] - c1[0], u1[1] - c1[1], u1[2] - c1[2], u1[3] - c1[3]); } \
    LDS_BAR(); \
    _Pragma("unroll") for (int nb = 0; nb < 2; ++nb) { \
      f32x4 c = accS[nb]; \
      c[0] *= EGLV; c[1] *= EGLV; c[2] *= EGLV; c[3] *= EGLV; \
      _Pragma("unroll") for (int kk = 0; kk < 2; ++kk) \
        c = mfma16(ldfrag(sVT, 72, nb * 16 + fr, kk * 32 + fq * 8), KPF[kk], c); \
      accS[nb] = c; \
      _Pragma("unroll") for (int r = 0; r < 4; ++r) sST[(nb * 16 + fq * 4 + r) * 136 + wv * 16 + fr] = f2bf(c[r]); } \
    if (part == 1) { \
      _Pragma("unroll") for (int kk = 0; kk < 2; ++kk) { \
        c0 = mfma16(G[kk], ldfrag(sVT, 72, fr, kk * 32 + fq * 8), c0); \
        c1 = mfma16(G[kk], ldfrag(sVT, 72, 16 + fr, kk * 32 + fq * 8), c1); } \
      _Pragma("unroll") for (int r = 0; r < 4; ++r) { \
        sO[(ib * 16 + fq * 4 + r) * 40 + fr] = f2bf(c0[r]); \
        sO[(ib * 16 + fq * 4 + r) * 40 + 16 + fr] = f2bf(c1[r]); } } \
    LDS_BAR(); \
    prow0 = row0; pnv = nvalid; } while (0)
  bf16x8 fA[4], gA[2], kpfA[2]; uint2 u0A, u1A; float eglA;
  bf16x8 fB[4], gB[2], kpfB[2]; uint2 u0B, u1B; float eglB;
  bf16x8 fC[4], gC[2], kpfC[2]; uint2 u0C, u1C; float eglC;
  int prow0 = 0, pnv = 0;
  SCAN_LOAD(slot0, fA, gA, kpfA, u0A, u1A, eglA);
  SCAN_LOAD(slot0 + min(1, nsteps - 1), fB, gB, kpfB, u0B, u1B, eglB);
  for (int step = 0; step < nsteps; step += 3) {
    if (xbp && step == csplit) xcd_barrier(*xbp);
    SCAN_STEP(step, fA, gA, kpfA, u0A, u1A, eglA, fC, gC, kpfC, u0C, u1C, eglC);
    if (step + 1 < nsteps) SCAN_STEP(step + 1, fB, gB, kpfB, u0B, u1B, eglB, fA, gA, kpfA, u0A, u1A, eglA);
    if (step + 2 < nsteps) SCAN_STEP(step + 2, fC, gC, kpfC, u0C, u1C, eglC, fB, gB, kpfB, u0B, u1B, eglB);
  }
  SCAN_FLUSH(prow0, pnv);
#undef SCAN_STEP
#undef SCAN_FLUSH
#undef SCAN_LOAD
  float* dst = p.out + (is_prompt ? PD_OFF + ((long)(layer * 4 + s) * 8 + h) * 16384 : SD_OFF + ((long)(layer * 8 + s) * 8 + h) * 16384);
#pragma unroll
  for (int nb = 0; nb < 2; ++nb)
    *reinterpret_cast<float4*>(dst + (wv * 16 + fr) * 128 + dv0 + nb * 16 + fq * 4) = make_float4(accS[nb][0], accS[nb][1], accS[nb][2], accS[nb][3]);
  __syncthreads();
}

constexpr int NUNIT = 4 * 513 + 32;
__device__ __forceinline__ void mixer_a_group(const Params& p, int layer, int ug) {
  const int tid = opaque_tid() & 511;
  const int uid = ug * 4 + (tid >> 7);
  if (uid >= NUNIT) return;
  const int c0 = (tid & 127) * 8;
  int row0, sidx; bool first, last, samp;
  if (uid < 2052) { sidx = uid / 513; const int k = uid - sidx * 513; row0 = sidx * TP + 16 * k; first = (k == 0); last = (k == 512); samp = false; }
  else { const int v = uid - 2052; sidx = v >> 2; const int k = v & 3; row0 = ROWS_P + sidx * 64 + 16 * k; first = (k == 0); last = (k == 3); samp = true; }
  const u16* proj = (const u16*)(p.ws + OFF_PROJ);
  u16* ymix = (u16*)(p.ws + OFF_YMIX);
  float w0[8], w1[8], w2[8], um2[8], um1[8];
  {
    const float* cw = p.cvaw + (long)layer * 3 * 1024 + c0;
#pragma unroll
    for (int e = 0; e < 8; ++e) { w0[e] = cw[e]; w1[e] = cw[1024 + e]; w2[e] = cw[2048 + e]; }
  }
  if (first) {
    if (samp) {
      const float* st = p.sca + (long)(layer * 8 + sidx) * 2 * 1024 + c0;
#pragma unroll
      for (int e = 0; e < 8; ++e) { um2[e] = st[e]; um1[e] = st[1024 + e]; }
    } else {
#pragma unroll
      for (int e = 0; e < 8; ++e) { um2[e] = 0.f; um1[e] = 0.f; }
    }
  } else {
    unpack8(*reinterpret_cast<const uint4*>(proj + (long)(row0 - 2) * NP + 1024 + c0), um2);
    unpack8(*reinterpret_cast<const uint4*>(proj + (long)(row0 - 1) * NP + 1024 + c0), um1);
  }
  for (int t0 = 0; t0 < 16; t0 += 4) {
    uint4 rgv[4], ruv[4];
#pragma unroll
    for (int q = 0; q < 4; ++q) {
      const long rb = (long)(row0 + t0 + q) * NP + c0;
      rgv[q] = *reinterpret_cast<const uint4*>(proj + rb);
      ruv[q] = *reinterpret_cast<const uint4*>(proj + rb + 1024);
    }
#pragma unroll
    for (int q = 0; q < 4; ++q) {
      float g[8], u[8], y[8];
      unpack8(rgv[q], g); unpack8(ruv[q], u);
#pragma unroll
      for (int e = 0; e < 8; ++e) {
        y[e] = g[e] * (w0[e] * um2[e] + w1[e] * um1[e] + w2[e] * u[e]);
        um2[e] = um1[e]; um1[e] = u[e];
      }
      uint4 o;
      o.x = pack2(y[0], y[1]); o.y = pack2(y[2], y[3]); o.z = pack2(y[4], y[5]); o.w = pack2(y[6], y[7]);
      *reinterpret_cast<uint4*>(ymix + (long)(row0 + t0 + q) * DM + c0) = o;
    }
  }
  if (last) {
    float* dst = p.out + (samp ? SCA_OFF + (long)(layer * 8 + sidx) * 2 * 1024 : PCA_OFF + (long)(layer * 4 + sidx) * 2 * 1024) + c0;
#pragma unroll
    for (int e = 0; e < 8; ++e) { dst[e] = um2[e]; dst[1024 + e] = um1[e]; }
  }
}

__device__ __forceinline__ void phase_post(const Params& p, int layer) {
  const int tid = opaque_tid() & 511;
  const u16* proj = (const u16*)(p.ws + OFF_PROJ);
  u16* ymix = (u16*)(p.ws + OFF_YMIX);
  const int hh = (tid >> 4) & 7, d = (tid & 15) * 8;
  float w[8];
#pragma unroll
  for (int e = 0; e < 8; ++e) w[e] = p.onw[layer * 128 + d + e];
  for (int g = blockIdx.x; g < ROWS / 4; g += gridDim.x) {
    const int row = g * 4 + (tid >> 7);
    u16* op = ymix + (long)row * DM + 1024 + hh * 128 + d;
    float o[8], z[8];
    unpack8(*reinterpret_cast<const uint4*>(op), o);
    unpack8(*reinterpret_cast<const uint4*>(proj + (long)row * NP + 7168 + hh * 128 + d), z);
    float ss = 0.f;
#pragma unroll
    for (int e = 0; e < 8; ++e) ss += o[e] * o[e];
    ss += __shfl_xor(ss, 1); ss += __shfl_xor(ss, 2); ss += __shfl_xor(ss, 4); ss += __shfl_xor(ss, 8);
    const float rs = rsqrtf(ss * (1.f / 128.f) + EPS);
    float y[8];
#pragma unroll
    for (int e = 0; e < 8; ++e) y[e] = o[e] * rs * w[e] * silu_f(z[e]);
    uint4 ov;
    ov.x = pack2(y[0], y[1]); ov.y = pack2(y[2], y[3]); ov.z = pack2(y[4], y[5]); ov.w = pack2(y[6], y[7]);
    *reinterpret_cast<uint4*>(op) = ov;
  }
}

__device__ __forceinline__ void phase_final(const Params& p) {
  const int tid = opaque_tid() & 511, wv = tid >> 6, lane = tid & 63;
  const float* sumsq = (const float*)(p.ws + OFF_SUMSQ) + 2L * ROWSP;
  for (int r = blockIdx.x * 8 + wv; r < ROWS; r += gridDim.x * 8) {
    float* dst;
    if (r < ROWS_P) {
      const int b = r / TP, t = r - b * TP;
      if (t < 16) continue;
      dst = p.out + ((long)b * 8192 + (t - 16)) * DM;
    } else {
      dst = p.out + YS_OFF + (long)(r - ROWS_P) * DM;
    }
    const float rs = rsqrtf(sumsq[r] * (1.f / DM) + EPS);
#pragma unroll
    for (int i = 0; i < 8; ++i) {
      const int c = (i * 64 + lane) * 4;
      float4 v = *reinterpret_cast<const float4*>(dst + c);
      const float4 w = *reinterpret_cast<const float4*>(p.fnw + c);
      v.x *= rs * w.x; v.y *= rs * w.y; v.z *= rs * w.z; v.w *= rs * w.w;
      *reinterpret_cast<float4*>(dst + c) = v;
    }
  }
}

typedef const __attribute__((address_space(4))) Params* CParamsPtr;
__device__ __forceinline__ Params ldparams(CParamsPtr q) {
#if defined(__HIP_DEVICE_COMPILE__)
  asm volatile("" : "+s"(q));
  Params r;
  r.xp = q->xp; r.xs = q->xs; r.sca = q->sca; r.scq = q->scq; r.sdel = q->sdel; r.meta = q->meta; r.normw = q->normw; r.win = q->win;
  r.cvaw = q->cvaw; r.cvqw = q->cvqw; r.alog = q->alog; r.dtb = q->dtb; r.onw = q->onw; r.wout = q->wout; r.fnw = q->fnw;
  r.out = q->out; r.ws = q->ws;
  return r;
#else
  return Params{};
#endif
}

__global__ void __launch_bounds__(512) mega(Params p_unused) {
  extern __shared__ __attribute__((aligned(16))) unsigned char smem[];
  cg::grid_group grid = cg::this_grid();
  CParamsPtr kp = (CParamsPtr)__builtin_amdgcn_kernarg_segment_ptr();
  volatile LAS unsigned* xst = (volatile LAS unsigned*)(smem + 147440);
  if (threadIdx.x < 2) xst[threadIdx.x] = 0u;
  __syncthreads();
  XcdBarrier xb;
  { const Params p = ldparams(kp); xb = xcd_barrier_post((unsigned*)(p.ws + OFF_BAR), xst); }
  { const Params p = ldparams(kp); phase_prep(p, smem); }
  grid.sync();
  for (int layer = 0; layer < 2; ++layer) {
    { const Params p = ldparams(kp); gemm_phase<1>(p, layer, smem); }
    xcd_barrier(xb);
    const bool split = gridDim.x >= 256;
    const int cprep = split ? 110 : 129, csplit = 108;
    {
      const Params p = ldparams(kp);
      const int per_s = cprep * 8, na = 4 * per_s + 64;
      for (int idx = blockIdx.x; idx < na; idx += gridDim.x) {
        int it[2];
#pragma unroll
        for (int q = 0; q < 2; ++q) {
          const int ix = idx + q * (int)gridDim.x;
          if (ix >= na) it[q] = -1;
          else if (ix < 4 * per_s) { const int s_ = ix / per_s, r_ = ix - s_ * per_s; it[q] = (s_ * 129 + (r_ >> 3)) * 8 + (r_ & 7); }
          else { const int r_ = ix - 4 * per_s; it[q] = (516 + (r_ >> 3)) * 8 + (r_ & 7); }
        }
        chunk_prep(p, layer, it[0], it[1], smem);
      }
    }
    xcd_barrier(xb);
    {
      const Params p = ldparams(kp);
      const int G = gridDim.x, b = blockIdx.x;
      if (split) {
        if (b < 128) gdn_scan(p, layer, (((b & 7) + 8 * (b >> 5)) << 2) + ((b >> 3) & 3), smem, &xb, csplit);
        else {
          if (b < 256) { gdn_scan(p, layer, b, smem, nullptr, 0); gdn_scan(p, layer, b + 128, smem, nullptr, 0); }
          const int per_b = (129 - cprep) * 8, nb = 4 * per_b, W = G - 128;
          for (int idx = b - 128; idx < nb; idx += W) {
            int it[2];
#pragma unroll
            for (int q = 0; q < 2; ++q) {
              const int ix = idx + q * W;
              if (ix >= nb) it[q] = -1;
              else { const int s_ = ix / per_b, r_ = ix - s_ * per_b; it[q] = (s_ * 129 + cprep + (r_ >> 3)) * 8 + (r_ & 7); }
            }
            chunk_prep(p, layer, it[0], it[1], smem);
          }
          constexpr int UGT = (NUNIT + 3) / 4, UG1 = (UGT * 9) / 20;
          for (int ug = b - 128; ug < UG1; ug += W) mixer_a_group(p, layer, ug);
          xcd_barrier(xb);
          for (int ug = UG1 + b - 128; ug < UGT; ug += W) mixer_a_group(p, layer, ug);
        }
      } else {
        for (int w = b; w < 384; w += G) gdn_scan(p, layer, w, smem, nullptr, 0);
        for (int ug = b; ug < (NUNIT + 3) / 4; ug += G) mixer_a_group(p, layer, ug);
      }
    }
    xcd_barrier(xb);
    { const Params p = ldparams(kp); phase_post(p, layer); }
    xcd_barrier(xb);
    { const Params p = ldparams(kp); if (layer == 0) gemm_phase<2>(p, layer, smem); else gemm_phase<3>(p, layer, smem); }
    xcd_barrier(xb);
  }
  { const Params p = ldparams(kp); phase_final(p); }
}

extern "C" void kernel_launch(void* const* d_in, const int* in_sizes, int n_in,
                              void* d_out, int out_size, void* d_ws, size_t ws_size,
                              hipStream_t stream) {
  constexpr size_t kLds = 147456;
  static int grid_blocks = 0;
  if (!grid_blocks) {
    int dev = 0, cus = 0, per_cu = 0;
    (void)hipGetDevice(&dev);
    (void)hipDeviceGetAttribute(&cus, hipDeviceAttributeMultiprocessorCount, dev);
    (void)hipFuncSetAttribute((const void*)mega, hipFuncAttributeMaxDynamicSharedMemorySize, (int)kLds);
    (void)hipOccupancyMaxActiveBlocksPerMultiprocessor(&per_cu, (const void*)mega, 512, kLds);
    if (per_cu < 1) per_cu = 1;
    grid_blocks = cus * per_cu;
    if (ws_size < (size_t)WS_END) fprintf(stderr, "workspace too small: %zu < %ld\n", ws_size, WS_END);
  }
  Params p{};
  p.xp = (const float*)d_in[0]; p.xs = (const float*)d_in[1]; p.sca = (const float*)d_in[2]; p.scq = (const float*)d_in[3];
  p.sdel = (const float*)d_in[4]; p.meta = (const float*)d_in[5]; p.normw = (const float*)d_in[6]; p.win = (const float*)d_in[7];
  p.cvaw = (const float*)d_in[8]; p.cvqw = (const float*)d_in[9]; p.alog = (const float*)d_in[10]; p.dtb = (const float*)d_in[11];
  p.onw = (const float*)d_in[12]; p.wout = (const float*)d_in[13]; p.fnw = (const float*)d_in[14];
  p.out = (float*)d_out; p.ws = (unsigned char*)d_ws;
  (void)hipMemsetAsync((unsigned char*)d_ws + OFF_BAR, 0, XCD_BAR_WORDS * sizeof(unsigned), stream);
  void* args[] = {&p};
  hipError_t e = hipLaunchCooperativeKernel((void*)mega, dim3(grid_blocks), dim3(512), args, kLds, stream);
  if (e != hipSuccess) fprintf(stderr, "cooperative launch failed: %s (grid %d)\n", hipGetErrorString(e), grid_blocks);
}
```

```cpp
#include <hip/hip_runtime.h>
#include <hip/hip_bf16.h>
#include <hip/hip_cooperative_groups.h>
#include <cstdio>
namespace cg = cooperative_groups;

typedef unsigned short u16;
using bf16x8 = __attribute__((ext_vector_type(8))) short;
using f32x4 = __attribute__((ext_vector_type(4))) float;

constexpr int DM = 2048;
constexpr int NP = 8208;
constexpr int NPP = 8448;
constexpr int TP = 8208;
constexpr int ROWS_P = 4 * TP;
constexpr int ROWS = ROWS_P + 512;
constexpr int ROWSP = 33536;
constexpr int NCHUNK = 524;
constexpr int NITEM = NCHUNK * 8;
constexpr float EPS = 1e-6f;

constexpr long OFF_WTIN = 0;
constexpr long OFF_WTOUT = OFF_WTIN + 2L * NPP * DM * 2;
constexpr long OFF_HB = OFF_WTOUT + 2L * DM * DM * 2;
constexpr long OFF_PROJ = OFF_HB + (long)ROWSP * DM * 2;
constexpr long OFF_YMIX = OFF_PROJ + (long)ROWS * NP * 2;
constexpr long OFF_SUMSQ = OFF_YMIX + (long)ROWSP * DM * 2;
constexpr long OFF_EGL = OFF_SUMSQ + 3L * ROWSP * 4;
constexpr long OFF_QK = OFF_EGL + 16896;
constexpr long OFF_UT = OFF_QK + (long)NITEM * 4096 * 2;
constexpr long OFF_BAR = OFF_UT + (long)NITEM * 8192 * 2;
constexpr long WS_END = OFF_BAR + 16384;
constexpr long OOFF_W = 0;
constexpr long OOFF_QG = OOFF_W + (long)NITEM * 8192 * 2;
constexpr long OOFF_KPT = OOFF_QG + (long)NITEM * 8192 * 2;
constexpr long YS_OFF = 67108864L;
constexpr long PCA_OFF = YS_OFF + 1048576L;
constexpr long PCQ_OFF = PCA_OFF + 16384L;
constexpr long PD_OFF = PCQ_OFF + 73728L;
constexpr long SCA_OFF = PD_OFF + 1048576L;
constexpr long SCQ_OFF = SCA_OFF + 32768L;
constexpr long SD_OFF = SCQ_OFF + 147456L;

struct Params {
  const float *xp, *xs, *sca, *scq, *sdel, *meta, *normw, *win, *cvaw, *cvqw, *alog, *dtb, *onw, *wout, *fnw;
  float* out;
  unsigned char* ws;
};

typedef __bf16 bf16x2_t __attribute__((ext_vector_type(2)));
typedef float f32x2_t __attribute__((ext_vector_type(2)));
__device__ __forceinline__ unsigned pack2(float a, float b) {
#if defined(__HIP_DEVICE_COMPILE__)
  f32x2_t v = {a, b};
  return __builtin_bit_cast(unsigned, __builtin_convertvector(v, bf16x2_t));
#else
  return 0u;
#endif
}
__device__ __forceinline__ u16 f2bf(float f) { return (u16)(pack2(f, 0.f) & 0xffffu); }
__device__ __forceinline__ int opaque_tid() { int t; asm volatile("v_mov_b32 %0, %1" : "=v"(t) : "v"((int)threadIdx.x)); return t; }
__device__ __forceinline__ float bf2f(u16 h) { return __uint_as_float(((unsigned)h) << 16); }
__device__ __forceinline__ uint2 pack4(float a, float b, float c, float d) { return make_uint2(pack2(a, b), pack2(c, d)); }
__device__ __forceinline__ void unpack4(uint2 v, float* o) {
  o[0] = __uint_as_float(v.x << 16); o[1] = __uint_as_float(v.x & 0xffff0000u);
  o[2] = __uint_as_float(v.y << 16); o[3] = __uint_as_float(v.y & 0xffff0000u);
}
__device__ __forceinline__ void unpack8(uint4 v, float* o) {
  o[0] = __uint_as_float(v.x << 16); o[1] = __uint_as_float(v.x & 0xffff0000u);
  o[2] = __uint_as_float(v.y << 16); o[3] = __uint_as_float(v.y & 0xffff0000u);
  o[4] = __uint_as_float(v.z << 16); o[5] = __uint_as_float(v.z & 0xffff0000u);
  o[6] = __uint_as_float(v.w << 16); o[7] = __uint_as_float(v.w & 0xffff0000u);
}
__device__ __forceinline__ float silu_f(float x) { return x * __builtin_amdgcn_rcpf(1.f + __expf(-x)); }
__device__ __forceinline__ f32x4 mfma16(bf16x8 a, bf16x8 b, f32x4 c) {
  return __builtin_amdgcn_mfma_f32_16x16x32_bf16(a, b, c, 0, 0, 0);
}
__device__ __forceinline__ bf16x8 ldfrag(const u16* base, int stride, int row, int k) {
  return *reinterpret_cast<const bf16x8*>(base + row * stride + k);
}

__device__ __forceinline__ void l2_touch(const void* ptr) {
  (void)ptr;
}
__device__ __forceinline__ unsigned touch_ld(const void* ptr) { return *reinterpret_cast<const unsigned*>(ptr); }
__device__ __forceinline__ void touch_use(unsigned& acc, unsigned v) { asm volatile("v_add_u32 %0, %0, %1" : "+v"(acc) : "v"(v)); }

__device__ __forceinline__ f32x4 mm16(const float* X, int xr, int xc, const float* Y, int yr, int yc, int kn, int fr, int fq) {
  f32x4 c = {0.f, 0.f, 0.f, 0.f};
  for (int k0 = 0; k0 < kn; k0 += 4) {
    const float a = X[(xr + fr) * 68 + xc + k0 + fq];
    const float b = Y[(yr + k0 + fq) * 68 + yc + fr];
    c = __builtin_amdgcn_mfma_f32_16x16x4f32(a, b, c, 0, 0, 0);
  }
  return c;
}

__device__ __forceinline__ void transpose_tiles(const float* __restrict__ src, u16* __restrict__ dst, const float* __restrict__ scale,
                                                int nsrc, int ntile_n, unsigned char* smem, int widx, int wcnt, bool perm) {
  float* tile = (float*)smem;
  const int tid = opaque_tid();
  const int ntiles = 32 * ntile_n;
  for (int t = widx; t < ntiles; t += wcnt) {
    const int kt = t & 31, nt = t >> 5;
    const int k0 = kt * 64, n0 = nt * 64;
    {
      const int nl = tid & 63, kb = tid >> 6;
#pragma unroll
      for (int it = 0; it < 8; ++it) {
        const int kl = kb + it * 8;
        const int n = (perm && n0 < 4096) ? ((nl >> 4) * 1024 + (n0 >> 6) * 16 + (nl & 15)) : n0 + nl;
        float v = 0.f;
        if (n < nsrc) v = src[(long)(k0 + kl) * nsrc + n] * (scale ? scale[k0 + kl] : 1.f);
        tile[kl * 65 + nl] = v;
      }
    }
    __syncthreads();
    {
      const int nl = tid >> 3, kg = tid & 7;
      float v[8];
#pragma unroll
      for (int e = 0; e < 8; ++e) v[e] = tile[(kg * 8 + e) * 65 + nl];
      uint4 o;
      o.x = pack2(v[0], v[1]); o.y = pack2(v[2], v[3]); o.z = pack2(v[4], v[5]); o.w = pack2(v[6], v[7]);
      *reinterpret_cast<uint4*>(dst + (long)(n0 + nl) * DM + k0 + kg * 8) = o;
    }
    __syncthreads();
  }
}

__device__ __forceinline__ void phase_prep(const Params& p, unsigned char* smem) {
  const int tid = opaque_tid(), wv = tid >> 6, lane = tid & 63;
  u16* hb = (u16*)(p.ws + OFF_HB);
  float* sumsq = (float*)(p.ws + OFF_SUMSQ);
  for (int r = blockIdx.x * 8 + wv; r < ROWSP; r += gridDim.x * 8) {
    const float* src = nullptr;
    if (r < ROWS_P) {
      const int b = r / TP, t = r - b * TP;
      src = (t < 16) ? (p.meta + (long)t * DM) : (p.xp + ((long)b * 8192 + (t - 16)) * DM);
    } else if (r < ROWS) {
      src = p.xs + (long)(r - ROWS_P) * DM;
    }
    float ss = 0.f;
#pragma unroll
    for (int i = 0; i < 8; ++i) {
      const int c = (i * 64 + lane) * 4;
      float4 v = make_float4(0.f, 0.f, 0.f, 0.f);
      if (src) v = *reinterpret_cast<const float4*>(src + c);
      ss += v.x * v.x + v.y * v.y + v.z * v.z + v.w * v.w;
      *reinterpret_cast<uint2*>(hb + (long)r * DM + c) = pack4(v.x, v.y, v.z, v.w);
    }
#pragma unroll
    for (int o = 32; o > 0; o >>= 1) ss += __shfl_xor(ss, o);
    if (lane == 0) sumsq[r] = ss;
  }
  for (long i = (long)blockIdx.x * 512 + tid; i < 2L * ROWSP; i += (long)gridDim.x * 512) sumsq[ROWSP + i] = 0.f;
  transpose_tiles(p.win, (u16*)(p.ws + OFF_WTIN), p.normw, NP, NPP / 64, smem, blockIdx.x, gridDim.x, true);
  transpose_tiles(p.wout, (u16*)(p.ws + OFF_WTOUT), nullptr, DM, DM / 64, smem, blockIdx.x, gridDim.x, false);
}

constexpr int BM = 256, BK = 64, HALF = 128, HT = HALF * BK;

__device__ __forceinline__ int lds_byte(int r, int c) {
  int st = (r >> 4) * 2 + (c >> 5), rr = r & 15, cc = c & 31, ob = rr * 64 + cc * 2;
  return st * 1024 + (ob ^ (((ob >> 9) & 1) << 5));
}
__device__ __forceinline__ void stage_rc(int b, int& R, int& C) {
  int st = b / 1024, sb = b % 1024, swz = sb ^ (((sb >> 9) & 1) << 5);
  R = (st >> 1) * 16 + swz / 64; C = (st & 1) * 32 + (swz % 64) / 2;
}

template <int EPI>
__device__ __forceinline__ void gemm_phase(const Params& p, int layer, unsigned char* smem) {
  typedef __hip_bfloat16 bf16;
  bf16* shm = (bf16*)smem;
  const bf16* A = (const bf16*)(p.ws + (EPI == 1 ? OFF_HB : OFF_YMIX));
  const bf16* Bt = (EPI == 1) ? (const bf16*)(p.ws + OFF_WTIN) + (long)layer * NPP * DM
                              : (const bf16*)(p.ws + OFF_WTOUT) + (long)layer * DM * DM;
  constexpr int K = DM;
  constexpr int nM = ROWSP / BM;
  constexpr int nN = (EPI == 1) ? NPP / BM : DM / BM;
  constexpr int WGM = 4;
  constexpr int nwg = nM * nN;
#define SA(b, h) (shm + ((b) * 2 + (h)) * HT)
#define SB(b, h) (shm + (4 + (b) * 2 + (h)) * HT)
#define OA(b, h) ((((b) * 2 + (h)) * HT) * 2)
#define OB(b, h) (((4 + (b) * 2 + (h)) * HT) * 2)
#define STAGE(PO, BASE, br, kt) do { const char* _ub = (const char*)(BASE) + ((long)(br) * K + (long)(kt) * BK) * 2; \
      asm volatile("s_add_u32 m0, %0, %3\n\ts_nop 0\n\tglobal_load_lds_dwordx4 %1, %2" :: "s"(ldsw), "v"(soff0), "s"(_ub), "n"(PO) : "memory", "scc"); \
      asm volatile("s_add_u32 m0, %0, %3\n\ts_nop 0\n\tglobal_load_lds_dwordx4 %1, %2" :: "s"(ldsw), "v"(soff1), "s"(_ub), "n"((PO) + 8192) : "memory", "scc"); } while (0)
#define LDA(dst, b, h) for (int m = 0; m < 4; ++m) for (int k = 0; k < 2; ++k) \
    dst[m][k] = *reinterpret_cast<const bf16x8*>((char*)SA(b, h) + lds_byte(wr * 64 + m * 16 + fr, k * 32 + fq * 8))
#define LDB(dst, b, h) for (int n = 0; n < 2; ++n) for (int k = 0; k < 2; ++k) \
    dst[n][k] = *reinterpret_cast<const bf16x8*>((char*)SB(b, h) + lds_byte(wc * 32 + n * 16 + fr, k * 32 + fq * 8))
#define MMA(ai, bj, At, Bt_) do { __builtin_amdgcn_s_setprio(1); \
    for (int m = 0; m < 4; ++m) for (int n = 0; n < 2; ++n) for (int k = 0; k < 2; ++k) \
      acc[ai][bj][m][n] = __builtin_amdgcn_mfma_f32_16x16x32_bf16(At[m][k], Bt_[n][k], acc[ai][bj][m][n], 0, 0, 0); \
    __builtin_amdgcn_s_setprio(0); } while (0)
#define WAIT_V(n) asm volatile("s_waitcnt vmcnt(" #n ")" ::: "memory")
#define WAIT_L(n) asm volatile("s_waitcnt lgkmcnt(" #n ")" ::: "memory")
#define BAR __builtin_amdgcn_s_barrier()
#define SCHED __builtin_amdgcn_sched_barrier(0)

  const int gtid = opaque_tid() & 511;
  const int wid = __builtin_amdgcn_readfirstlane(gtid >> 6), lane = gtid & 63, wr = wid >> 2, wc = wid & 3, fr = lane & 15, fq = lane >> 4;
  unsigned soff0, soff1;
  { int _r, _c; stage_rc(gtid * 16, _r, _c); soff0 = (unsigned)(_r * K + _c) * 2u;
    stage_rc(gtid * 16 + 8192, _r, _c); soff1 = (unsigned)(_r * K + _c) * 2u; }
  const unsigned ldsw = (unsigned)(size_t)((__attribute__((address_space(3))) unsigned char*)smem) + (unsigned)wid * 1024u;
  int gdim = (int)gridDim.x;
  asm volatile("" : "+s"(gdim));
  int vb = blockIdx.x;
  if ((gdim & 7) == 0) vb = (blockIdx.x & 7) * (gdim >> 3) + (blockIdx.x >> 3);
  constexpr int nig = WGM * nN;
#define TILE_RC(wg, BR, BC) do { const int gid_ = (wg) / nig, fm_ = gid_ * WGM, gsz_ = min(nM - fm_, WGM); \
    BC = (fm_ + (((wg) % nig) % gsz_)) * BM; BR = (((wg) % nig) / gsz_) * BM; } while (0)
  int brow = 0, bcol = 0;
  if (vb < nwg) {
    TILE_RC(vb, brow, bcol);
    STAGE(OB(0, 0), A, bcol, 0); STAGE(OA(0, 0), Bt, brow, 0);
    STAGE(OB(0, 1), A, bcol + HALF, 0); STAGE(OA(0, 1), Bt, brow + HALF, 0);
  }
  for (int wgid = vb; wgid < nwg; wgid += gdim) {
    f32x4 acc[2][2][4][2] = {};
    bf16x8 At[4][2], B0[2][2], B1[2][2];
    constexpr int nt = K / BK;
    if (wr == 1) BAR;
    WAIT_V(4); BAR;
    STAGE(OB(1, 0), A, bcol, 1); STAGE(OA(1, 0), Bt, brow, 1); STAGE(OB(1, 1), A, bcol + HALF, 1);
    WAIT_V(6); BAR;
    for (int t = 0; t < nt - 2; t += 2) {
      LDB(B0, 0, 0); SCHED; LDA(At, 0, 0); STAGE(OA(1, 1), Bt, brow + HALF, t + 1);
      WAIT_L(8); BAR; WAIT_L(0); MMA(0, 0, At, B0); BAR; SCHED;
      LDB(B1, 0, 1); STAGE(OB(0, 0), A, bcol, t + 2);
      BAR; WAIT_L(0); MMA(0, 1, At, B1); BAR;
      LDA(At, 0, 1); STAGE(OA(0, 0), Bt, brow, t + 2);
      BAR; WAIT_L(0); MMA(1, 0, At, B0); BAR; SCHED;
      STAGE(OB(0, 1), A, bcol + HALF, t + 2);
      WAIT_V(6); BAR; MMA(1, 1, At, B1); BAR;
      LDB(B0, 1, 0); SCHED; LDA(At, 1, 0); STAGE(OA(0, 1), Bt, brow + HALF, t + 2);
      WAIT_L(8); BAR; WAIT_L(0); MMA(0, 0, At, B0); BAR; SCHED;
      LDB(B1, 1, 1); STAGE(OB(1, 0), A, bcol, t + 3);
      BAR; WAIT_L(0); MMA(0, 1, At, B1); BAR;
      LDA(At, 1, 1); STAGE(OA(1, 0), Bt, brow, t + 3);
      BAR; WAIT_L(0); MMA(1, 0, At, B0); BAR; SCHED;
      STAGE(OB(1, 1), A, bcol + HALF, t + 3);
      WAIT_V(6); BAR; MMA(1, 1, At, B1); BAR;
    }
    { LDB(B0, 0, 0); LDA(At, 0, 0); STAGE(OA(1, 1), Bt, brow + HALF, nt - 1);
      BAR; WAIT_L(0); MMA(0, 0, At, B0); BAR;
      LDB(B1, 0, 1); BAR; WAIT_L(0); MMA(0, 1, At, B1); BAR;
      LDA(At, 0, 1); WAIT_V(4); BAR; WAIT_L(0); MMA(1, 0, At, B0); MMA(1, 1, At, B1); BAR; }
    { LDB(B0, 1, 0); LDA(At, 1, 0); WAIT_V(2); BAR; WAIT_L(0); MMA(0, 0, At, B0); BAR;
      LDB(B1, 1, 1); WAIT_V(0); BAR; WAIT_L(0); MMA(0, 1, At, B1); BAR;
      LDA(At, 1, 1); BAR; WAIT_L(0); MMA(1, 0, At, B0); MMA(1, 1, At, B1); BAR; }
    if (wr == 0) BAR;
    const int erow = brow, ecol = bcol;
    if (wgid + gdim < nwg) {
      TILE_RC(wgid + gdim, brow, bcol);
      STAGE(OB(0, 0), A, bcol, 0); STAGE(OA(0, 0), Bt, brow, 0);
      STAGE(OB(0, 1), A, bcol + HALF, 0); STAGE(OA(0, 1), Bt, brow + HALF, 0);
    }
    if (EPI == 1) {
      u16* proj = (u16*)(p.ws + OFF_PROJ);
      const float* sumsq = (const float*)(p.ws + OFF_SUMSQ) + (long)layer * ROWSP;
#pragma unroll
      for (int bj = 0; bj < 2; ++bj)
#pragma unroll
        for (int n = 0; n < 2; ++n) {
          const int tok = ecol + bj * HALF + wc * 32 + n * 16 + fr;
          if (tok < ROWS) {
            const float rs = rsqrtf(sumsq[tok] * (1.f / DM) + EPS);
            u16* prow = proj + (long)tok * NP;
            if (erow < 4096) {
#pragma unroll
              for (int ai = 0; ai < 2; ++ai) {
                const int c0 = ((erow >> 6) + ai * 2 + wr) * 16 + fq * 4;
                float uu[4], gg[4];
#pragma unroll
                for (int j = 0; j < 4; ++j) {
                  uu[j] = (acc[ai][bj][1][n][j] * rs) * (acc[ai][bj][2][n][j] * rs);
                  gg[j] = (acc[ai][bj][0][n][j] * rs) * silu_f(acc[ai][bj][3][n][j] * rs);
                }
                *reinterpret_cast<uint2*>(prow + 1024 + c0) = pack4(uu[0], uu[1], uu[2], uu[3]);
                *reinterpret_cast<uint2*>(prow + c0) = pack4(gg[0], gg[1], gg[2], gg[3]);
              }
            } else
#pragma unroll
            for (int ai = 0; ai < 2; ++ai)
#pragma unroll
              for (int m = 0; m < 4; ++m) {
                const int n0 = erow + ai * HALF + wr * 64 + m * 16 + fq * 4;
                if (n0 < NP)
                  *reinterpret_cast<uint2*>(prow + n0) = pack4(acc[ai][bj][m][n][0] * rs, acc[ai][bj][m][n][1] * rs,
                                                                acc[ai][bj][m][n][2] * rs, acc[ai][bj][m][n][3] * rs);
              }
          }
        }
    } else {
      u16* hb = (u16*)(p.ws + OFF_HB);
      float* sumsq = (float*)(p.ws + OFF_SUMSQ) + (long)(EPI == 2 ? 1 : 2) * ROWSP;
#pragma unroll
      for (int bj = 0; bj < 2; ++bj)
#pragma unroll
        for (int n = 0; n < 2; ++n) {
          const int tok = ecol + bj * HALF + wc * 32 + n * 16 + fr;
          float* dst = nullptr;
          if (EPI == 3) {
            if (tok < ROWS_P) {
              const int b = tok / TP, t = tok - b * TP;
              if (t >= 16) dst = p.out + ((long)b * 8192 + (t - 16)) * DM;
            } else if (tok < ROWS) {
              dst = p.out + YS_OFF + (long)(tok - ROWS_P) * DM;
            }
          }
          u16* hrow = hb + (long)tok * DM;
          float rsum = 0.f;
#pragma unroll
          for (int ai = 0; ai < 2; ++ai)
#pragma unroll
            for (int m = 0; m < 4; ++m) {
              const int n0 = erow + ai * HALF + wr * 64 + m * 16 + fq * 4;
              float r4[4];
              unpack4(*reinterpret_cast<const uint2*>(hrow + n0), r4);
              float v[4];
#pragma unroll
              for (int j = 0; j < 4; ++j) { v[j] = acc[ai][bj][m][n][j] + r4[j]; rsum += v[j] * v[j]; }
              if (EPI == 2) *reinterpret_cast<uint2*>(hrow + n0) = pack4(v[0], v[1], v[2], v[3]);
              else if (dst) *reinterpret_cast<float4*>(dst + n0) = make_float4(v[0], v[1], v[2], v[3]);
            }
          rsum += __shfl_xor(rsum, 16); rsum += __shfl_xor(rsum, 32);
          if (fq == 0) atomicAdd(&sumsq[tok], rsum);
        }
    }
  }
  __syncthreads();
  if (EPI == 2) {
    const int rem = nwg % gdim;
    const int widx = (vb >= rem) ? vb - rem : -1, wcnt = gdim - rem;
    if (wcnt <= 0) {
      transpose_tiles(p.win + (long)DM * NP, (u16*)(p.ws + OFF_WTIN) + (long)NPP * DM, p.normw + DM, NP, NPP / 64, smem, vb, gdim, true);
      transpose_tiles(p.wout + (long)DM * DM, (u16*)(p.ws + OFF_WTOUT) + (long)DM * DM, nullptr, DM, DM / 64, smem, vb, gdim, false);
    } else if (widx >= 0) {
      transpose_tiles(p.win + (long)DM * NP, (u16*)(p.ws + OFF_WTIN) + (long)NPP * DM, p.normw + DM, NP, NPP / 64, smem, widx, wcnt, true);
      transpose_tiles(p.wout + (long)DM * DM, (u16*)(p.ws + OFF_WTOUT) + (long)DM * DM, nullptr, DM, DM / 64, smem, widx, wcnt, false);
    }
  }
#undef TILE_RC
#undef SA
#undef SB
#undef OA
#undef OB
#undef STAGE
#undef LDA
#undef LDB
#undef MMA
}

#define XB_TMO      128
#define XB_XCNT(j)  (256  + 64 * (j))
#define XB_XSUB(j)  (1280 + 64 * (j))
#define XB_XGEN(j)  (2304 + 64 * (j))
#define XB_TOP      3328
#define XB_TOPGEN   3392
#define XCD_BAR_WORDS 3456
#define XB_SPIN_CAP (1u << 18)
#define LAS __attribute__((address_space(3)))
__device__ __forceinline__ unsigned xb_ld(unsigned* p)              { return __hip_atomic_load(p, __ATOMIC_RELAXED, __HIP_MEMORY_SCOPE_AGENT); }
__device__ __forceinline__ unsigned xb_add(unsigned* p, unsigned v) { return __hip_atomic_fetch_add(p, v, __ATOMIC_RELAXED, __HIP_MEMORY_SCOPE_AGENT); }
__device__ __forceinline__ unsigned xb_xcc_id() { return (unsigned)__builtin_amdgcn_s_getreg((3 << 11) | 20) & 0xFu; }
#define XB_SPIN(cond, bar) do { unsigned _sp = 0; while (cond) { __builtin_amdgcn_s_sleep(1); \
    if ((++_sp & 255u) == 0u) { if (xb_ld(&(bar)[XB_TMO])) break; if (_sp > XB_SPIN_CAP) { atomicAdd(&(bar)[XB_TMO], 1u); break; } } } } while (0)
struct XcdBarrier { unsigned* bar; unsigned x; volatile LAS unsigned* st; };
__device__ __forceinline__ XcdBarrier xcd_barrier_post(unsigned* bar, volatile LAS unsigned* st) {
  XcdBarrier b; b.bar = bar; b.x = xb_xcc_id(); b.st = st;
  if (threadIdx.x == 0) (void)xb_add(&bar[XB_XCNT(b.x)], 1u);
  return b;
}
__device__ __forceinline__ void xcd_barrier_complete(unsigned* bar, unsigned x, unsigned& nloc, unsigned& nx) {
  const unsigned G = gridDim.x * gridDim.y * gridDim.z;
  unsigned sum, cnt, mine, sp = 0u;
  for (;;) {
    sum = 0u; cnt = 0u; mine = 0u;
#pragma unroll
    for (unsigned j = 0; j < 16; ++j) { const unsigned c = xb_ld(&bar[XB_XCNT(j)]); sum += c; cnt += (c > 0u) ? 1u : 0u; mine = (j == x) ? c : mine; }
    if (sum == G) break;
    __builtin_amdgcn_s_sleep(1);
    if ((++sp & 255u) == 0u) { if (xb_ld(&bar[XB_TMO])) break; if (sp > XB_SPIN_CAP) { atomicAdd(&bar[XB_TMO], 1u); break; } }
  }
  nloc = mine > 0u ? mine : 1u; nx = cnt > 0u ? cnt : 1u;
}
__device__ __forceinline__ void xcd_barrier(const XcdBarrier& b) {
  asm volatile("s_waitcnt vmcnt(0)" ::: "memory");
  __syncthreads();
  if (threadIdx.x == 0) {
    unsigned* bar = b.bar;
    __builtin_amdgcn_s_waitcnt(0);
    unsigned nloc = b.st[0], nx = b.st[1];
    if (nloc == 0u) { xcd_barrier_complete(bar, b.x, nloc, nx); b.st[0] = nloc; b.st[1] = nx; }
    const unsigned old = xb_add(&bar[XB_XSUB(b.x)], 1u);
    const unsigned gen = old / nloc;
    if (old + 1u == (gen + 1u) * nloc) {
      __builtin_amdgcn_fence(__ATOMIC_RELEASE, "agent");
      asm volatile("s_waitcnt vmcnt(0)" ::: "memory");
      const unsigned og = xb_add(&bar[XB_TOP], 1u);
      const unsigned tg = og / nx;
      if (og + 1u == (tg + 1u) * nx) xb_add(&bar[XB_TOPGEN], 1u);
      else XB_SPIN(xb_ld(&bar[XB_TOPGEN]) == tg, bar);
      __builtin_amdgcn_fence(__ATOMIC_ACQUIRE, "agent");
      xb_add(&bar[XB_XGEN(b.x)], 1u);
      asm volatile("s_waitcnt vmcnt(0)" ::: "memory");
    } else {
      XB_SPIN(xb_ld(&bar[XB_XGEN(b.x)]) == gen, bar);
      __builtin_amdgcn_fence(__ATOMIC_ACQUIRE, "agent");
      asm volatile("s_waitcnt vmcnt(0)" ::: "memory");
    }
  }
  __syncthreads();
}

__device__ __forceinline__ void chunk_geom(int cid, int& row0, int& nvalid, int& prevmode, int& sidx, bool& lastc) {
  if (cid < 516) {
    const int s = cid / 129, c = cid - s * 129;
    sidx = s; lastc = (c == 128);
    if (c == 0) { row0 = s * TP; nvalid = 16; prevmode = 0; }
    else { row0 = s * TP + 16 + (c - 1) * 64; nvalid = 64; prevmode = 1; }
  } else {
    sidx = cid - 516; row0 = ROWS_P + sidx * 64; nvalid = 64; prevmode = 2; lastc = true;
  }
}

__device__ __forceinline__ long item_slot(int cid, int h) {
  if (cid < 516) { const int s = cid / 129, c = cid - s * 129; return (long)((s * 8 + h) * 129 + c); }
  return (long)(4128 + (cid - 516) * 8 + h);
}

__device__ __forceinline__ void chunk_prep(const Params& p, int layer, int item, int nitem, unsigned char* smem) {
  const int tid = opaque_tid() & 511, wv = __builtin_amdgcn_readfirstlane(tid >> 6), lane = tid & 63, fr = lane & 15, fq = lane >> 4;
  const int cid = item >> 3, h = item & 7;
  int row0, nvalid, prevmode, sidx; bool lastc;
  chunk_geom(cid, row0, nvalid, prevmode, sidx, lastc);
  u16* sKB = (u16*)smem;
  u16* sK = sKB + 64 * 136;
  u16* sQ = sK + 64 * 136;
  u16* sVBT = sQ + 64 * 136;
  u16* sKBGT = sVBT + 128 * 72;
  u16* sT = sKBGT + 128 * 72;
  float* sA = (float*)(sT + 64 * 72);
  float* sBeta = sA + 64 * 68;
  float* sGc = sBeta + 64;
  u16* sKPT = (u16*)(sGc + 64);
  float* sTf = (float*)smem;
  float* sY = sTf + 64 * 68;
  int zoff;
  asm volatile("v_mov_b32 %0, 0" : "=v"(zoff));
  const u16* proj = (const u16*)(p.ws + OFF_PROJ);
  const long slot = item_slot(cid, h);
  u16* Wd = (u16*)((unsigned char*)p.out) + slot * 24576;
  u16* QG = Wd + 8192;
  u16* KPT = Wd + 16384;
  u16* UTd = (u16*)(p.ws + OFF_QK) + slot * 12288;
  u16* QKd = UTd + 8192;
  float* EGL = (float*)(p.ws + OFF_EGL);

  unsigned tch = 0;
  {
    if (nitem >= 0) {
      int nrow0, nnv, npm, nsi; bool nl;
      chunk_geom(nitem >> 3, nrow0, nnv, npm, nsi, nl);
      const int nh = nitem & 7;
      if (tid < 402) {
        const int r = tid / 6, m6 = tid - r * 6;
        tch = touch_ld(proj + (long)(nrow0 - 3 + r) * NP + 4096 + (m6 >> 1) * 1024 + nh * 128 + (m6 & 1) * 64);
      } else if (tid >= 448) {
        tch = touch_ld(proj + (long)(nrow0 + (tid - 448)) * NP + 8192 + nh);
      }
    }
  }
  if (wv == 0) {
    float beta = 0.f, g = 0.f;
    if (lane < nvalid) {
      const long rb = (long)(row0 + lane) * NP;
      const float bl = bf2f(proj[rb + 8192 + h]);
      const float al = bf2f(proj[rb + 8200 + h]) + p.dtb[layer * 8 + h];
      beta = 1.f / (1.f + expf(-bl));
      const float sp = (al > 20.f) ? al : log1pf(expf(al));
      g = -expf(p.alog[layer * 8 + h]) * sp;
    }
    float gc = g;
#pragma unroll
    for (int o = 1; o < 64; o <<= 1) { const float t = __shfl_up(gc, o); if (lane >= o) gc += t; }
    sBeta[lane] = beta; sGc[lane] = gc;
  }

  const int rg = tid >> 5, cg = tid & 31, i0 = rg * 4, d0 = cg * 4;
  float qv[4][4], kv[4][4], vv[4][4];
#pragma unroll
  for (int mat = 0; mat < 3; ++mat) {
    const int ch = mat * 1024 + h * 128 + d0;
    const int colbase = 4096 + ch;
    float xr[7][4];
#pragma unroll
    for (int a = 0; a < 7; ++a) {
      const int ri = i0 - 3 + a;
      if (ri >= 0 || prevmode == 1) {
        uint2 raw = *reinterpret_cast<const uint2*>(proj + (long)(row0 + ri) * NP + colbase);
        unpack4(raw, xr[a]);
      } else if (prevmode == 2) {
        const float4 v = *reinterpret_cast<const float4*>(p.scq + ((long)(layer * 8 + sidx) * 3 + (3 + ri)) * 3072 + ch);
        xr[a][0] = v.x; xr[a][1] = v.y; xr[a][2] = v.z; xr[a][3] = v.w;
      } else {
        xr[a][0] = xr[a][1] = xr[a][2] = xr[a][3] = 0.f;
      }
    }
    if (lastc && rg == 15) {
      float* dst = p.out + (prevmode == 2 ? SCQ_OFF + (long)(layer * 8 + sidx) * 3 * 3072 : PCQ_OFF + (long)(layer * 4 + sidx) * 3 * 3072) + ch;
#pragma unroll
      for (int a = 4; a < 7; ++a)
        *reinterpret_cast<float4*>(dst + (a - 4) * 3072) = make_float4(xr[a][0], xr[a][1], xr[a][2], xr[a][3]);
    }
    float cw[4][4];
#pragma unroll
    for (int j = 0; j < 4; ++j) {
      const float4 v = *reinterpret_cast<const float4*>(p.cvqw + (long)(layer * 4 + j) * 3072 + ch);
      cw[j][0] = v.x; cw[j][1] = v.y; cw[j][2] = v.z; cw[j][3] = v.w;
    }
#pragma unroll
    for (int ii = 0; ii < 4; ++ii)
#pragma unroll
      for (int e = 0; e < 4; ++e) {
        float o = 0.f;
#pragma unroll
        for (int j = 0; j < 4; ++j) o += cw[j][e] * xr[ii + j][e];
        o = silu_f(o);
        if (mat == 0) qv[ii][e] = o; else if (mat == 1) kv[ii][e] = o; else vv[ii][e] = o;
      }
  }
#pragma unroll
  for (int ii = 0; ii < 4; ++ii) {
    float sq = 0.f, sk = 0.f;
#pragma unroll
    for (int e = 0; e < 4; ++e) { sq += qv[ii][e] * qv[ii][e]; sk += kv[ii][e] * kv[ii][e]; }
#pragma unroll
    for (int o = 1; o < 32; o <<= 1) { sq += __shfl_xor(sq, o); sk += __shfl_xor(sk, o); }
    const float rq = rsqrtf(sq + EPS) * 0.08838834764831845f, rk = rsqrtf(sk + EPS);
    const bool valid = (i0 + ii) < nvalid;
#pragma unroll
    for (int e = 0; e < 4; ++e) {
      qv[ii][e] = valid ? qv[ii][e] * rq : 0.f;
      kv[ii][e] = valid ? kv[ii][e] * rk : 0.f;
      vv[ii][e] = valid ? vv[ii][e] : 0.f;
    }
  }
  __syncthreads();
  float beta[4], gcv[4];
#pragma unroll
  for (int ii = 0; ii < 4; ++ii) { beta[ii] = sBeta[i0 + ii]; gcv[ii] = sGc[i0 + ii]; }
  const float glast = sGc[63];
  if (tid == 0) EGL[slot] = expf(glast);

#pragma unroll
  for (int ii = 0; ii < 4; ++ii) {
    const int i = i0 + ii;
    const float b = beta[ii];
    *reinterpret_cast<uint2*>(sKB + i * 136 + d0) = pack4(kv[ii][0] * b, kv[ii][1] * b, kv[ii][2] * b, kv[ii][3] * b);
    *reinterpret_cast<uint2*>(sK + i * 136 + d0) = pack4(kv[ii][0], kv[ii][1], kv[ii][2], kv[ii][3]);
    *reinterpret_cast<uint2*>(sQ + i * 136 + d0) = pack4(qv[ii][0], qv[ii][1], qv[ii][2], qv[ii][3]);

  }
  {
    float bg[4], kd[4];
#pragma unroll
    for (int ii = 0; ii < 4; ++ii) { bg[ii] = beta[ii] * __expf(gcv[ii]); kd[ii] = __expf(glast - gcv[ii]); }
#pragma unroll
    for (int e = 0; e < 4; ++e) {
      const int d = d0 + e;
      *reinterpret_cast<uint2*>(sVBT + d * 72 + i0) = pack4(vv[0][e] * beta[0], vv[1][e] * beta[1], vv[2][e] * beta[2], vv[3][e] * beta[3]);
      *reinterpret_cast<uint2*>(sKBGT + d * 72 + i0) = pack4(kv[0][e] * bg[0], kv[1][e] * bg[1], kv[2][e] * bg[2], kv[3][e] * bg[3]);
      *reinterpret_cast<uint2*>(sKPT + d * 72 + i0) = pack4(kv[0][e] * kd[0], kv[1][e] * kd[1], kv[2][e] * kd[2], kv[3][e] * kd[3]);
    }
  }
  __syncthreads();
#pragma unroll
  for (int t2 = 0; t2 < 2; ++t2) {
    {
      const int qib = wv >> 1, qkk = (wv & 1) * 2 + t2;
      const bf16x8 qf = ldfrag(sQ, 136, qib * 16 + fr, qkk * 32 + fq * 8);
      const float eg = __expf(sGc[qib * 16 + fr]);
      float qx[8];
      unpack8(__builtin_bit_cast(uint4, qf), qx);
      uint4 o;
      o.x = pack2(qx[0] * eg, qx[1] * eg); o.y = pack2(qx[2] * eg, qx[3] * eg);
      o.z = pack2(qx[4] * eg, qx[5] * eg); o.w = pack2(qx[6] * eg, qx[7] * eg);
      *reinterpret_cast<uint4*>(QG + (((qib * 4 + qkk) * 64 + lane) << 3)) = o;
    }
    *reinterpret_cast<bf16x8*>(KPT + (((wv * 2 + t2) * 64 + lane) << 3)) = ldfrag(sKPT, 72, wv * 16 + fr, t2 * 32 + fq * 8);
  }
  {
    const int ib = wv >> 1;
#pragma unroll
    for (int jj = 0; jj < 2; ++jj) {
      const int jb = (wv & 1) * 2 + jj;
      f32x4 c = {0.f, 0.f, 0.f, 0.f}, c2 = {0.f, 0.f, 0.f, 0.f};
#pragma unroll
      for (int kk = 0; kk < 4; ++kk) {
        const bf16x8 a = ldfrag(sKB, 136, ib * 16 + fr, kk * 32 + fq * 8);
        const bf16x8 b = ldfrag(sK, 136, jb * 16 + fr, kk * 32 + fq * 8);
        c = mfma16(a, b, c);
        const bf16x8 b2 = ldfrag(sQ, 136, ib * 16 + fr, kk * 32 + fq * 8);
        c2 = mfma16(b, b2, c2);
      }
      {
        const int j = jb * 16 + fr;
        const float gj = sGc[j];
#pragma unroll
        for (int r = 0; r < 4; ++r) {
          const int i = ib * 16 + fq * 4 + r;
          sA[i * 68 + j] = (i > j) ? c[r] * __expf(sGc[i] - gj) : 0.f;
        }
      }
      {
        const int i = ib * 16 + fr;
        const float gi = sGc[i];
        float o[4];
#pragma unroll
        for (int r = 0; r < 4; ++r) {
          const int j = jb * 16 + fq * 4 + r;
          o[r] = (i >= j) ? c2[r] * __expf(gi - sGc[j]) : 0.f;
        }
        *reinterpret_cast<uint2*>(QKd + ((((ib * 2 + (jb >> 1)) * 64) + ((jb & 1) * 2 + (fq >> 1)) * 16 + fr) << 3) + (fq & 1) * 4) = pack4(o[0], o[1], o[2], o[3]);
      }
    }
  }
  __syncthreads();
  {
    for (int e = tid; e < 64 * 68; e += 512) sTf[e] = 0.f;
    __syncthreads();
    if (wv < 4 && lane < 16) {
      const float* Ab = sA + (wv * 16) * 68 + wv * 16 + zoff;
      float t[16], ac[16], an[16];
      t[0] = (lane == 0) ? 1.f : 0.f;
      sTf[(wv * 16) * 68 + wv * 16 + lane] = t[0];
      ac[0] = Ab[68];
#pragma unroll
      for (int i = 1; i < 16; ++i) {
        if (i + 1 < 16) {
#pragma unroll
          for (int j = 0; j <= i; ++j) an[j] = Ab[(i + 1) * 68 + j];
        }
        float a = (lane == i) ? 1.f : 0.f;
#pragma unroll
        for (int j = 0; j < i; ++j) a -= ac[j] * t[j];
        t[i] = a;
        sTf[(wv * 16 + i) * 68 + wv * 16 + lane] = a;
        if (i + 1 < 16) {
#pragma unroll
          for (int j = 0; j <= i; ++j) ac[j] = an[j];
        }
        __builtin_amdgcn_sched_barrier(0);
      }
    }
    __syncthreads();
    if (wv < 2) {
      const int o = wv * 32;
      const f32x4 c = mm16(sA, o + 16, o, sTf, o, o, 16, fr, fq);
#pragma unroll
      for (int r = 0; r < 4; ++r) sY[(o + 16 + fq * 4 + r) * 68 + o + fr] = c[r];
    }
    __syncthreads();
    if (wv < 2) {
      const int o = wv * 32;
      const f32x4 c = mm16(sTf, o + 16, o + 16, sY, o + 16, o, 16, fr, fq);
#pragma unroll
      for (int r = 0; r < 4; ++r) sTf[(o + 16 + fq * 4 + r) * 68 + o + fr] = -c[r];
    }
    __syncthreads();
    if (wv < 4) {
      const int bi = wv >> 1, bj = wv & 1;
      const f32x4 c = mm16(sA, 32 + bi * 16, 0, sTf, 0, bj * 16, 32, fr, fq);
#pragma unroll
      for (int r = 0; r < 4; ++r) sY[(32 + bi * 16 + fq * 4 + r) * 68 + bj * 16 + fr] = c[r];
    }
    __syncthreads();
    if (wv < 4) {
      const int bi = wv >> 1, bj = wv & 1;
      const f32x4 c = mm16(sTf, 32 + bi * 16, 32, sY, 32, bj * 16, 32, fr, fq);
#pragma unroll
      for (int r = 0; r < 4; ++r) sTf[(32 + bi * 16 + fq * 4 + r) * 68 + bj * 16 + fr] = -c[r];
    }
    __syncthreads();
    {
      const int i = tid >> 3, j0 = (tid & 7) * 8;
      float v[8];
#pragma unroll
      for (int e = 0; e < 8; ++e) v[e] = sTf[i * 68 + j0 + e];
      uint4 o;
      o.x = pack2(v[0], v[1]); o.y = pack2(v[2], v[3]); o.z = pack2(v[4], v[5]); o.w = pack2(v[6], v[7]);
      *reinterpret_cast<uint4*>(sT + i * 72 + j0) = o;
    }
  }
  __syncthreads();
  {
    const int ib = wv >> 1;
#pragma unroll
    for (int x = 0; x < 4; ++x) {
      const int dvb = (wv & 1) * 4 + x;
      f32x4 c = {0.f, 0.f, 0.f, 0.f};
#pragma unroll
      for (int kk = 0; kk < 2; ++kk)
        c = mfma16(ldfrag(sT, 72, ib * 16 + fr, kk * 32 + fq * 8), ldfrag(sVBT, 72, dvb * 16 + fr, kk * 32 + fq * 8), c);
      *reinterpret_cast<uint2*>(UTd + (((dvb * 4 + ib) * 64 + lane) << 2)) = pack4(c[0], c[1], c[2], c[3]);
    }
#pragma unroll
    for (int ib2 = 0; ib2 < 4; ++ib2) {
      f32x4 c = {0.f, 0.f, 0.f, 0.f};
#pragma unroll
      for (int kk = 0; kk < 2; ++kk)
        c = mfma16(ldfrag(sKBGT, 72, wv * 16 + fr, kk * 32 + fq * 8), ldfrag(sT, 72, ib2 * 16 + fr, kk * 32 + fq * 8), c);
      *reinterpret_cast<uint2*>(Wd + ((((ib2 * 4 + (wv >> 1)) * 64) + ((wv & 1) * 2 + (fq >> 1)) * 16 + fr) << 3) + (fq & 1) * 4) = pack4(c[0], c[1], c[2], c[3]);
    }
  }
  __syncthreads();
  {
    unsigned tacc = 0;
    touch_use(tacc, tch);
    if (tacc == 0x9e3779b9u) ((volatile float*)EGL)[NITEM + 9] = 1.f;
  }
}

__device__ __forceinline__ void gdn_scan(const Params& p, int layer, int widx, unsigned char* smem, const XcdBarrier* xbp, int csplit) {
  const int tid = opaque_tid() & 511, wv = __builtin_amdgcn_readfirstlane(tid >> 6), lane = tid & 63, fr = lane & 15, fq = lane >> 4;
  const bool is_prompt = widx < 128;
  int s, h, sl, nsteps, cid0;
  if (is_prompt) { s = widx >> 5; h = (widx >> 2) & 7; sl = widx & 3; nsteps = 129; cid0 = s * 129; }
  else { const int j = widx - 128; s = j >> 5; h = (j >> 2) & 7; sl = j & 3; nsteps = 1; cid0 = 516 + s; }
  const int dv0 = sl * 32;
  u16* sST = (u16*)smem;
  u16* sVT = sST + 32 * 136;
  u16* sO = sVT + 32 * 72;
  const u16* R1g = (const u16*)((const unsigned char*)p.out);
  const u16* R2g = (const u16*)(p.ws + OFF_QK);
  const float* EGL = (const float*)(p.ws + OFF_EGL);
  const long slot0 = item_slot(cid0, h);
  const int rowbase = is_prompt ? s * TP : ROWS_P + s * 64;
  u16* ymix = (u16*)(p.ws + OFF_YMIX);

  f32x4 accS[2];
#pragma unroll
  for (int nb = 0; nb < 2; ++nb) {
    if (is_prompt) { accS[nb][0] = 0.f; accS[nb][1] = 0.f; accS[nb][2] = 0.f; accS[nb][3] = 0.f; }
    else {
      const float4 v = *reinterpret_cast<const float4*>(p.sdel + ((long)(layer * 8 + s) * 8 + h) * 16384 + (wv * 16 + fr) * 128 + dv0 + nb * 16 + fq * 4);
      accS[nb][0] = v.x; accS[nb][1] = v.y; accS[nb][2] = v.z; accS[nb][3] = v.w;
    }
#pragma unroll
    for (int r = 0; r < 4; ++r) sST[(nb * 16 + fq * 4 + r) * 136 + wv * 16 + fr] = f2bf(accS[nb][r]);
  }
  __syncthreads();
  const int part = wv >> 2;
  const int ib = wv & 3;
  int zoff;
  asm volatile("v_mov_b32 %0, 0" : "=v"(zoff));
#define LDS_BAR() asm volatile("s_waitcnt lgkmcnt(0)\n\ts_barrier" ::: "memory")
#define SCAN_LOAD(IT, F, G, KPF, UU0, UU1, EG) do { \
    const u16* R1p = R1g + (IT) * 24576; const u16* R2p = R2g + (IT) * 12288; \
    _Pragma("unroll") for (int kk = 0; kk < 2; ++kk) \
      KPF[kk] = *reinterpret_cast<const bf16x8*>(R1p + 16384 + (((wv * 2 + kk) * 64 + lane) << 3)); \
    EG = EGL[(IT) + zoff]; \
    { const u16* Fp = R1p + part * 8192;     \
      _Pragma("unroll") for (int kk = 0; kk < 4; ++kk) \
        F[kk] = *reinterpret_cast<const bf16x8*>(Fp + (((ib * 4 + kk) * 64 + lane) << 3)); } \
    if (part == 0) { \
      UU0 = *reinterpret_cast<const uint2*>(R2p + ((((sl * 2) * 4 + ib) * 64 + lane) << 2)); \
      UU1 = *reinterpret_cast<const uint2*>(R2p + ((((sl * 2 + 1) * 4 + ib) * 64 + lane) << 2)); \
    } else { \
      _Pragma("unroll") for (int kk = 0; kk < 2; ++kk) \
        G[kk] = *reinterpret_cast<const bf16x8*>(R2p + 8192 + (((ib * 2 + kk) * 64 + lane) << 3)); } } while (0)
#define SCAN_FLUSH(PROW0, PNV) do { \
    if (tid < 256) { const int i_ = tid >> 2, sg_ = tid & 3; \
      if (i_ < (PNV)) *reinterpret_cast<uint4*>(ymix + (long)((PROW0) + i_) * DM + 1024 + h * 128 + dv0 + sg_ * 8) = \
          *reinterpret_cast<const uint4*>(sO + i_ * 40 + sg_ * 8); } } while (0)
#define SCAN_STEP(STEP, F, G, KPF, UU0, UU1, EGLV, FN, GN, KPFN, UU0N, UU1N, EGLN) do { \
    const int row0 = (is_prompt && (STEP) > 0) ? rowbase + 16 + ((STEP) - 1) * 64 : rowbase; \
    const int nvalid = (is_prompt && (STEP) == 0) ? 16 : 64; \
    { const long itn = slot0 + min((STEP) + 2, nsteps - 1); \
      SCAN_LOAD(itn, FN, GN, KPFN, UU0N, UU1N, EGLN); } \
    if ((STEP) > 0) SCAN_FLUSH(prow0, pnv); \
    f32x4 c0 = {0.f, 0.f, 0.f, 0.f}, c1 = {0.f, 0.f, 0.f, 0.f}; \
    _Pragma("unroll") for (int kk = 0; kk < 4; ++kk) { \
      c0 = mfma16(F[kk], ldfrag(sST, 136, fr, kk * 32 + fq * 8), c0); \
      c1 = mfma16(F[kk], ldfrag(sST, 136, 16 + fr, kk * 32 + fq * 8), c1); } \
    if (part == 0) { \
      float u0[4], u1[4]; \
      unpack4(UU0, u0); unpack4(UU1, u1); \
      *reinterpret_cast<uint2*>(sVT + fr * 72 + ib * 16 + fq * 4) = pack4(u0[0] - c0[0], u0[1] - c0[1], u0[2] - c0[2], u0[3] - c0[3]); \
      *reinterpret_cast<uint2*>(sVT + (16 + fr) * 72 + ib * 16 + fq * 4) = pack4(u1[0] - c1[0], u1[1] - c1[1], u1[2] - c1[2], u1[3] - c1[3]); } \
    LDS_BAR(); \
    _Pragma("unroll") for (int nb = 0; nb < 2; ++nb) { \
      f32x4 c = accS[nb]; \
      c[0] *= EGLV; c[1] *= EGLV; c[2] *= EGLV; c[3] *= EGLV; \
      _Pragma("unroll") for (int kk = 0; kk < 2; ++kk) \
        c = mfma16(ldfrag(sVT, 72, nb * 16 + fr, kk * 32 + fq * 8), KPF[kk], c); \
      accS[nb] = c; \
      _Pragma("unroll") for (int r = 0; r < 4; ++r) sST[(nb * 16 + fq * 4 + r) * 136 + wv * 16 + fr] = f2bf(c[r]); } \
    if (part == 1) { \
      _Pragma("unroll") for (int kk = 0; kk < 2; ++kk) { \
        c0 = mfma16(G[kk], ldfrag(sVT, 72, fr, kk * 32 + fq * 8), c0); \
        c1 = mfma16(G[kk], ldfrag(sVT, 72, 16 + fr, kk * 32 + fq * 8), c1); } \
      _Pragma("unroll") for (int r = 0; r < 4; ++r) { \
        sO[(ib * 16 + fq * 4 + r) * 40 + fr] = f2bf(c0[r]); \
        sO[(ib * 16 + fq * 4 + r) * 40 + 16 + fr] = f2bf(c1[r]); } } \
    LDS_BAR(); \
    prow0 = row0; pnv = nvalid; } while (0)
  bf16x8 fA[4], gA[2], kpfA[2]; uint2 u0A, u1A; float eglA;
  bf16x8 fB[4], gB[2], kpfB[2]; uint2 u0B, u1B; float eglB;
  bf16x8 fC[4], gC[2], kpfC[2]; uint2 u0C, u1C; float eglC;
  int prow0 = 0, pnv = 0;
  SCAN_LOAD(slot0, fA, gA, kpfA, u0A, u1A, eglA);
  SCAN_LOAD(slot0 + min(1, nsteps - 1), fB, gB, kpfB, u0B, u1B, eglB);
  for (int step = 0; step < nsteps; step += 3) {
    if (xbp && step == csplit) xcd_barrier(*xbp);
    SCAN_STEP(step, fA, gA, kpfA, u0A, u1A, eglA, fC, gC, kpfC, u0C, u1C, eglC);
    if (step + 1 < nsteps) SCAN_STEP(step + 1, fB, gB, kpfB, u0B, u1B, eglB, fA, gA, kpfA, u0A, u1A, eglA);
    if (step + 2 < nsteps) SCAN_STEP(step + 2, fC, gC, kpfC, u0C, u1C, eglC, fB, gB, kpfB, u0B, u1B, eglB);
  }
  SCAN_FLUSH(prow0, pnv);
#undef SCAN_STEP
#undef SCAN_FLUSH
#undef SCAN_LOAD
  float* dst = p.out + (is_prompt ? PD_OFF + ((long)(layer * 4 + s) * 8 + h) * 16384 : SD_OFF + ((long)(layer * 8 + s) * 8 + h) * 16384);
#pragma unroll
  for (int nb = 0; nb < 2; ++nb)
    *reinterpret_cast<float4*>(dst + (wv * 16 + fr) * 128 + dv0 + nb * 16 + fq * 4) = make_float4(accS[nb][0], accS[nb][1], accS[nb][2], accS[nb][3]);
  __syncthreads();
}

constexpr int NUNIT = 4 * 513 + 32;
__device__ __forceinline__ void mixer_a_group(const Params& p, int layer, int ug) {
  const int tid = opaque_tid() & 511;
  const int uid = ug * 4 + (tid >> 7);
  if (uid >= NUNIT) return;
  const int c0 = (tid & 127) * 8;
  int row0, sidx; bool first, last, samp;
  if (uid < 2052) { sidx = uid / 513; const int k = uid - sidx * 513; row0 = sidx * TP + 16 * k; first = (k == 0); last = (k == 512); samp = false; }
  else { const int v = uid - 2052; sidx = v >> 2; const int k = v & 3; row0 = ROWS_P + sidx * 64 + 16 * k; first = (k == 0); last = (k == 3); samp = true; }
  const u16* proj = (const u16*)(p.ws + OFF_PROJ);
  u16* ymix = (u16*)(p.ws + OFF_YMIX);
  float w0[8], w1[8], w2[8], um2[8], um1[8];
  {
    const float* cw = p.cvaw + (long)layer * 3 * 1024 + c0;
#pragma unroll
    for (int e = 0; e < 8; ++e) { w0[e] = cw[e]; w1[e] = cw[1024 + e]; w2[e] = cw[2048 + e]; }
  }
  if (first) {
    if (samp) {
      const float* st = p.sca + (long)(layer * 8 + sidx) * 2 * 1024 + c0;
#pragma unroll
      for (int e = 0; e < 8; ++e) { um2[e] = st[e]; um1[e] = st[1024 + e]; }
    } else {
#pragma unroll
      for (int e = 0; e < 8; ++e) { um2[e] = 0.f; um1[e] = 0.f; }
    }
  } else {
    unpack8(*reinterpret_cast<const uint4*>(proj + (long)(row0 - 2) * NP + 1024 + c0), um2);
    unpack8(*reinterpret_cast<const uint4*>(proj + (long)(row0 - 1) * NP + 1024 + c0), um1);
  }
  for (int t0 = 0; t0 < 16; t0 += 4) {
    uint4 rgv[4], ruv[4];
#pragma unroll
    for (int q = 0; q < 4; ++q) {
      const long rb = (long)(row0 + t0 + q) * NP + c0;
      rgv[q] = *reinterpret_cast<const uint4*>(proj + rb);
      ruv[q] = *reinterpret_cast<const uint4*>(proj + rb + 1024);
    }
#pragma unroll
    for (int q = 0; q < 4; ++q) {
      float g[8], u[8], y[8];
      unpack8(rgv[q], g); unpack8(ruv[q], u);
#pragma unroll
      for (int e = 0; e < 8; ++e) {
        y[e] = g[e] * (w0[e] * um2[e] + w1[e] * um1[e] + w2[e] * u[e]);
        um2[e] = um1[e]; um1[e] = u[e];
      }
      uint4 o;
      o.x = pack2(y[0], y[1]); o.y = pack2(y[2], y[3]); o.z = pack2(y[4], y[5]); o.w = pack2(y[6], y[7]);
      *reinterpret_cast<uint4*>(ymix + (long)(row0 + t0 + q) * DM + c0) = o;
    }
  }
  if (last) {
    float* dst = p.out + (samp ? SCA_OFF + (long)(layer * 8 + sidx) * 2 * 1024 : PCA_OFF + (long)(layer * 4 + sidx) * 2 * 1024) + c0;
#pragma unroll
    for (int e = 0; e < 8; ++e) { dst[e] = um2[e]; dst[1024 + e] = um1[e]; }
  }
}

__device__ __forceinline__ void phase_post(const Params& p, int layer) {
  const int tid = opaque_tid() & 511;
  const u16* proj = (const u16*)(p.ws + OFF_PROJ);
  u16* ymix = (u16*)(p.ws + OFF_YMIX);
  const int hh = (tid >> 4) & 7, d = (tid & 15) * 8;
  float w[8];
#pragma unroll
  for (int e = 0; e < 8; ++e) w[e] = p.onw[layer * 128 + d + e];
  for (int g = blockIdx.x; g < ROWS / 4; g += gridDim.x) {
    const int row = g * 4 + (tid >> 7);
    u16* op = ymix + (long)row * DM + 1024 + hh * 128 + d;
    float o[8], z[8];
    unpack8(*reinterpret_cast<const uint4*>(op), o);
    unpack8(*reinterpret_cast<const uint4*>(proj + (long)row * NP + 7168 + hh * 128 + d), z);
    float ss = 0.f;
#pragma unroll
    for (int e = 0; e < 8; ++e) ss += o[e] * o[e];
    ss += __shfl_xor(ss, 1); ss += __shfl_xor(ss, 2); ss += __shfl_xor(ss, 4); ss += __shfl_xor(ss, 8);
    const float rs = rsqrtf(ss * (1.f / 128.f) + EPS);
    float y[8];
#pragma unroll
    for (int e = 0; e < 8; ++e) y[e] = o[e] * rs * w[e] * silu_f(z[e]);
    uint4 ov;
    ov.x = pack2(y[0], y[1]); ov.y = pack2(y[2], y[3]); ov.z = pack2(y[4], y[5]); ov.w = pack2(y[6], y[7]);
    *reinterpret_cast<uint4*>(op) = ov;
  }
}

__device__ __forceinline__ void phase_final(const Params& p) {
  const int tid = opaque_tid() & 511, wv = tid >> 6, lane = tid & 63;
  const float* sumsq = (const float*)(p.ws + OFF_SUMSQ) + 2L * ROWSP;
  for (int r = blockIdx.x * 8 + wv; r < ROWS; r += gridDim.x * 8) {
    float* dst;
    if (r < ROWS_P) {
      const int b = r / TP, t = r - b * TP;
      if (t < 16) continue;
      dst = p.out + ((long)b * 8192 + (t - 16)) * DM;
    } else {
      dst = p.out + YS_OFF + (long)(r - ROWS_P) * DM;
    }
    const float rs = rsqrtf(sumsq[r] * (1.f / DM) + EPS);
#pragma unroll
    for (int i = 0; i < 8; ++i) {
      const int c = (i * 64 + lane) * 4;
      float4 v = *reinterpret_cast<const float4*>(dst + c);
      const float4 w = *reinterpret_cast<const float4*>(p.fnw + c);
      v.x *= rs * w.x; v.y *= rs * w.y; v.z *= rs * w.z; v.w *= rs * w.w;
      *reinterpret_cast<float4*>(dst + c) = v;
    }
  }
}

typedef const __attribute__((address_space(4))) Params* CParamsPtr;
__device__ __forceinline__ Params ldparams(CParamsPtr q) {
#if defined(__HIP_DEVICE_COMPILE__)
  asm volatile("" : "+s"(q));
  Params r;
  r.xp = q->xp; r.xs = q->xs; r.sca = q->sca; r.scq = q->scq; r.sdel = q->sdel; r.meta = q->meta; r.normw = q->normw; r.win = q->win;
  r.cvaw = q->cvaw; r.cvqw = q->cvqw; r.alog = q->alog; r.dtb = q->dtb; r.onw = q->onw; r.wout = q->wout; r.fnw = q->fnw;
  r.out = q->out; r.ws = q->ws;
  return r;
#else
  return Params{};
#endif
}

__global__ void __launch_bounds__(512) mega(Params p_unused) {
  extern __shared__ __attribute__((aligned(16))) unsigned char smem[];
  cg::grid_group grid = cg::this_grid();
  CParamsPtr kp = (CParamsPtr)__builtin_amdgcn_kernarg_segment_ptr();
  volatile LAS unsigned* xst = (volatile LAS unsigned*)(smem + 147440);
  if (threadIdx.x < 2) xst[threadIdx.x] = 0u;
  __syncthreads();
  XcdBarrier xb;
  { const Params p = ldparams(kp); xb = xcd_barrier_post((unsigned*)(p.ws + OFF_BAR), xst); }
  { const Params p = ldparams(kp); phase_prep(p, smem); }
  grid.sync();
  for (int layer = 0; layer < 2; ++layer) {
    { const Params p = ldparams(kp); gemm_phase<1>(p, layer, smem); }
    xcd_barrier(xb);
    const bool split = gridDim.x >= 256;
    const int cprep = split ? 110 : 129, csplit = 108;
    {
      const Params p = ldparams(kp);
      const int per_s = cprep * 8, na = 4 * per_s + 64;
      for (int idx = blockIdx.x; idx < na; idx += gridDim.x) {
        int it[2];
#pragma unroll
        for (int q = 0; q < 2; ++q) {
          const int ix = idx + q * (int)gridDim.x;
          if (ix >= na) it[q] = -1;
          else if (ix < 4 * per_s) { const int s_ = ix / per_s, r_ = ix - s_ * per_s; it[q] = (s_ * 129 + (r_ >> 3)) * 8 + (r_ & 7); }
          else { const int r_ = ix - 4 * per_s; it[q] = (516 + (r_ >> 3)) * 8 + (r_ & 7); }
        }
        chunk_prep(p, layer, it[0], it[1], smem);
      }
    }
    xcd_barrier(xb);
    {
      const Params p = ldparams(kp);
      const int G = gridDim.x, b = blockIdx.x;
      if (split) {
        if (b < 128) gdn_scan(p, layer, (((b & 7) + 8 * (b >> 5)) << 2) + ((b >> 3) & 3), smem, &xb, csplit);
        else {
          if (b < 256) { gdn_scan(p, layer, b, smem, nullptr, 0); gdn_scan(p, layer, b + 128, smem, nullptr, 0); }
          const int per_b = (129 - cprep) * 8, nb = 4 * per_b, W = G - 128;
          for (int idx = b - 128; idx < nb; idx += W) {
            int it[2];
#pragma unroll
            for (int q = 0; q < 2; ++q) {
              const int ix = idx + q * W;
              if (ix >= nb) it[q] = -1;
              else { const int s_ = ix / per_b, r_ = ix - s_ * per_b; it[q] = (s_ * 129 + cprep + (r_ >> 3)) * 8 + (r_ & 7); }
            }
            chunk_prep(p, layer, it[0], it[1], smem);
          }
          constexpr int UGT = (NUNIT + 3) / 4, UG1 = (UGT * 9) / 20;
          for (int ug = b - 128; ug < UG1; ug += W) mixer_a_group(p, layer, ug);
          xcd_barrier(xb);
          for (int ug = UG1 + b - 128; ug < UGT; ug += W) mixer_a_group(p, layer, ug);
        }
      } else {
        for (int w = b; w < 384; w += G) gdn_scan(p, layer, w, smem, nullptr, 0);
        for (int ug = b; ug < (NUNIT + 3) / 4; ug += G) mixer_a_group(p, layer, ug);
      }
    }
    xcd_barrier(xb);
    { const Params p = ldparams(kp); phase_post(p, layer); }
    xcd_barrier(xb);
    { const Params p = ldparams(kp); if (layer == 0) gemm_phase<2>(p, layer, smem); else gemm_phase<3>(p, layer, smem); }
    xcd_barrier(xb);
  }
  { const Params p = ldparams(kp); phase_final(p); }
}

extern "C" void kernel_launch(void* const* d_in, const int* in_sizes, int n_in,
                              void* d_out, int out_size, void* d_ws, size_t ws_size,
                              hipStream_t stream) {
  constexpr size_t kLds = 147456;
  static int grid_blocks = 0;
  if (!grid_blocks) {
    int dev = 0, cus = 0, per_cu = 0;
    (void)hipGetDevice(&dev);
    (void)hipDeviceGetAttribute(&cus, hipDeviceAttributeMultiprocessorCount, dev);
    (void)hipFuncSetAttribute((const void*)mega, hipFuncAttributeMaxDynamicSharedMemorySize, (int)kLds);
    (void)hipOccupancyMaxActiveBlocksPerMultiprocessor(&per_cu, (const void*)mega, 512, kLds);
    if (per_cu < 1) per_cu = 1;
    grid_blocks = cus * per_cu;
    if (ws_size < (size_t)WS_END) fprintf(stderr, "workspace too small: %zu < %ld\n", ws_size, WS_END);
  }
  Params p{};
  p.xp = (const float*)d_in[0]; p.xs = (const float*)d_in[1]; p.sca = (const float*)d_in[2]; p.scq = (const float*)d_in[3];
  p.sdel = (const float*)d_in[4]; p.meta = (const float*)d_in[5]; p.normw = (const float*)d_in[6]; p.win = (const float*)d_in[7];
  p.cvaw = (const float*)d_in[8]; p.cvqw = (const float*)d_in[9]; p.alog = (const float*)d_in[10]; p.dtb = (const float*)d_in[11];
  p.onw = (const float*)d_in[12]; p.wout = (const float*)d_in[13]; p.fnw = (const float*)d_in[14];
  p.out = (float*)d_out; p.ws = (unsigned char*)d_ws;
  (void)hipMemsetAsync((unsigned char*)d_ws + OFF_BAR, 0, XCD_BAR_WORDS * sizeof(unsigned), stream);
  void* args[] = {&p};
  hipError_t e = hipLaunchCooperativeKernel((void*)mega, dim3(grid_blocks), dim3(512), args, kLds, stream);
  if (e != hipSuccess) fprintf(stderr, "cooperative launch failed: %s (grid %d)\n", hipGetErrorString(e), grid_blocks);
}
```

```cpp
#include <hip/hip_runtime.h>
#include <hip/hip_bf16.h>
#include <hip/hip_cooperative_groups.h>
#include <cstdio>
namespace cg = cooperative_groups;

typedef unsigned short u16;
using bf16x8 = __attribute__((ext_vector_type(8))) short;
using f32x4 = __attribute__((ext_vector_type(4))) float;

constexpr int DM = 2048;
constexpr int NP = 8208;
constexpr int NPP = 8448;
constexpr int TP = 8208;
constexpr int ROWS_P = 4 * TP;
constexpr int ROWS = ROWS_P + 512;
constexpr int ROWSP = 33536;
constexpr int NCHUNK = 524;
constexpr int NITEM = NCHUNK * 8;
constexpr float EPS = 1e-6f;

constexpr long OFF_WTIN = 0;
constexpr long OFF_WTOUT = OFF_WTIN + 2L * NPP * DM * 2;
constexpr long OFF_HB = OFF_WTOUT + 2L * DM * DM * 2;
constexpr long OFF_PROJ = OFF_HB + (long)ROWSP * DM * 2;
constexpr long OFF_YMIX = OFF_PROJ + (long)ROWS * NP * 2;
constexpr long OFF_SUMSQ = OFF_YMIX + (long)ROWSP * DM * 2;
constexpr long OFF_EGL = OFF_SUMSQ + 3L * ROWSP * 4;
constexpr long OFF_QK = OFF_EGL + 16896;
constexpr long OFF_UT = OFF_QK + (long)NITEM * 4096 * 2;
constexpr long OFF_BAR = OFF_UT + (long)NITEM * 8192 * 2;
constexpr long WS_END = OFF_BAR + 16384;
constexpr long OOFF_W = 0;
constexpr long OOFF_QG = OOFF_W + (long)NITEM * 8192 * 2;
constexpr long OOFF_KPT = OOFF_QG + (long)NITEM * 8192 * 2;
constexpr long YS_OFF = 67108864L;
constexpr long PCA_OFF = YS_OFF + 1048576L;
constexpr long PCQ_OFF = PCA_OFF + 16384L;
constexpr long PD_OFF = PCQ_OFF + 73728L;
constexpr long SCA_OFF = PD_OFF + 1048576L;
constexpr long SCQ_OFF = SCA_OFF + 32768L;
constexpr long SD_OFF = SCQ_OFF + 147456L;

struct Params {
  const float *xp, *xs, *sca, *scq, *sdel, *meta, *normw, *win, *cvaw, *cvqw, *alog, *dtb, *onw, *wout, *fnw;
  float* out;
  unsigned char* ws;
};

typedef __bf16 bf16x2_t __attribute__((ext_vector_type(2)));
typedef float f32x2_t __attribute__((ext_vector_type(2)));
__device__ __forceinline__ unsigned pack2(float a, float b) {
#if defined(__HIP_DEVICE_COMPILE__)
  f32x2_t v = {a, b};
  return __builtin_bit_cast(unsigned, __builtin_convertvector(v, bf16x2_t));
#else
  return 0u;
#endif
}
__device__ __forceinline__ u16 f2bf(float f) { return (u16)(pack2(f, 0.f) & 0xffffu); }
__device__ __forceinline__ int opaque_tid() { int t; asm volatile("v_mov_b32 %0, %1" : "=v"(t) : "v"((int)threadIdx.x)); return t; }
__device__ __forceinline__ float bf2f(u16 h) { return __uint_as_float(((unsigned)h) << 16); }
__device__ __forceinline__ uint2 pack4(float a, float b, float c, float d) { return make_uint2(pack2(a, b), pack2(c, d)); }
__device__ __forceinline__ void unpack4(uint2 v, float* o) {
  o[0] = __uint_as_float(v.x << 16); o[1] = __uint_as_float(v.x & 0xffff0000u);
  o[2] = __uint_as_float(v.y << 16); o[3] = __uint_as_float(v.y & 0xffff0000u);
}
__device__ __forceinline__ void unpack8(uint4 v, float* o) {
  o[0] = __uint_as_float(v.x << 16); o[1] = __uint_as_float(v.x & 0xffff0000u);
  o[2] = __uint_as_float(v.y << 16); o[3] = __uint_as_float(v.y & 0xffff0000u);
  o[4] = __uint_as_float(v.z << 16); o[5] = __uint_as_float(v.z & 0xffff0000u);
  o[6] = __uint_as_float(v.w << 16); o[7] = __uint_as_float(v.w & 0xffff0000u);
}
__device__ __forceinline__ float silu_f(float x) { return x * __builtin_amdgcn_rcpf(1.f + __expf(-x)); }
__device__ __forceinline__ f32x4 mfma16(bf16x8 a, bf16x8 b, f32x4 c) {
  return __builtin_amdgcn_mfma_f32_16x16x32_bf16(a, b, c, 0, 0, 0);
}
__device__ __forceinline__ bf16x8 ldfrag(const u16* base, int stride, int row, int k) {
  return *reinterpret_cast<const bf16x8*>(base + row * stride + k);
}

__device__ __forceinline__ void l2_touch(const void* ptr) {
  (void)ptr;
}
__device__ __forceinline__ unsigned touch_ld(const void* ptr) { return *reinterpret_cast<const unsigned*>(ptr); }
__device__ __forceinline__ void touch_use(unsigned& acc, unsigned v) { asm volatile("v_add_u32 %0, %0, %1" : "+v"(acc) : "v"(v)); }

__device__ __forceinline__ f32x4 mm16(const float* X, int xr, int xc, const float* Y, int yr, int yc, int kn, int fr, int fq) {
  f32x4 c = {0.f, 0.f, 0.f, 0.f};
  for (int k0 = 0; k0 < kn; k0 += 4) {
    const float a = X[(xr + fr) * 68 + xc + k0 + fq];
    const float b = Y[(yr + k0 + fq) * 68 + yc + fr];
    c = __builtin_amdgcn_mfma_f32_16x16x4f32(a, b, c, 0, 0, 0);
  }
  return c;
}

__device__ __forceinline__ void transpose_tiles(const float* __restrict__ src, u16* __restrict__ dst, const float* __restrict__ scale,
                                                int nsrc, int ntile_n, unsigned char* smem, int widx, int wcnt, bool perm) {
  float* tile = (float*)smem;
  const int tid = opaque_tid();
  const int ntiles = 32 * ntile_n;
  for (int t = widx; t < ntiles; t += wcnt) {
    const int kt = t & 31, nt = t >> 5;
    const int k0 = kt * 64, n0 = nt * 64;
    {
      const int nl = tid & 63, kb = tid >> 6;
#pragma unroll
      for (int it = 0; it < 8; ++it) {
        const int kl = kb + it * 8;
        const int n = (perm && n0 < 4096) ? ((nl >> 4) * 1024 + (n0 >> 6) * 16 + (nl & 15)) : n0 + nl;
        float v = 0.f;
        if (n < nsrc) v = src[(long)(k0 + kl) * nsrc + n] * (scale ? scale[k0 + kl] : 1.f);
        tile[kl * 65 + nl] = v;
      }
    }
    __syncthreads();
    {
      const int nl = tid >> 3, kg = tid & 7;
      float v[8];
#pragma unroll
      for (int e = 0; e < 8; ++e) v[e] = tile[(kg * 8 + e) * 65 + nl];
      uint4 o;
      o.x = pack2(v[0], v[1]); o.y = pack2(v[2], v[3]); o.z = pack2(v[4], v[5]); o.w = pack2(v[6], v[7]);
      *reinterpret_cast<uint4*>(dst + (long)(n0 + nl) * DM + k0 + kg * 8) = o;
    }
    __syncthreads();
  }
}

__device__ __forceinline__ void phase_prep(const Params& p, unsigned char* smem) {
  const int tid = opaque_tid(), wv = tid >> 6, lane = tid & 63;
  u16* hb = (u16*)(p.ws + OFF_HB);
  float* sumsq = (float*)(p.ws + OFF_SUMSQ);
  for (int r = blockIdx.x * 8 + wv; r < ROWSP; r += gridDim.x * 8) {
    const float* src = nullptr;
    if (r < ROWS_P) {
      const int b = r / TP, t = r - b * TP;
      src = (t < 16) ? (p.meta + (long)t * DM) : (p.xp + ((long)b * 8192 + (t - 16)) * DM);
    } else if (r < ROWS) {
      src = p.xs + (long)(r - ROWS_P) * DM;
    }
    float ss = 0.f;
#pragma unroll
    for (int i = 0; i < 8; ++i) {
      const int c = (i * 64 + lane) * 4;
      float4 v = make_float4(0.f, 0.f, 0.f, 0.f);
      if (src) v = *reinterpret_cast<const float4*>(src + c);
      ss += v.x * v.x + v.y * v.y + v.z * v.z + v.w * v.w;
      *reinterpret_cast<uint2*>(hb + (long)r * DM + c) = pack4(v.x, v.y, v.z, v.w);
    }
#pragma unroll
    for (int o = 32; o > 0; o >>= 1) ss += __shfl_xor(ss, o);
    if (lane == 0) sumsq[r] = ss;
  }
  for (long i = (long)blockIdx.x * 512 + tid; i < 2L * ROWSP; i += (long)gridDim.x * 512) sumsq[ROWSP + i] = 0.f;
  transpose_tiles(p.win, (u16*)(p.ws + OFF_WTIN), p.normw, NP, NPP / 64, smem, blockIdx.x, gridDim.x, true);
  transpose_tiles(p.wout, (u16*)(p.ws + OFF_WTOUT), nullptr, DM, DM / 64, smem, blockIdx.x, gridDim.x, false);
}

constexpr int BM = 256, BK = 64, HALF = 128, HT = HALF * BK;

__device__ __forceinline__ int lds_byte(int r, int c) {
  int st = (r >> 4) * 2 + (c >> 5), rr = r & 15, cc = c & 31, ob = rr * 64 + cc * 2;
  return st * 1024 + (ob ^ (((ob >> 9) & 1) << 5));
}
__device__ __forceinline__ void stage_rc(int b, int& R, int& C) {
  int st = b / 1024, sb = b % 1024, swz = sb ^ (((sb >> 9) & 1) << 5);
  R = (st >> 1) * 16 + swz / 64; C = (st & 1) * 32 + (swz % 64) / 2;
}

template <int EPI>
__device__ __forceinline__ void gemm_phase(const Params& p, int layer, unsigned char* smem) {
  typedef __hip_bfloat16 bf16;
  bf16* shm = (bf16*)smem;
  const bf16* A = (const bf16*)(p.ws + (EPI == 1 ? OFF_HB : OFF_YMIX));
  const bf16* Bt = (EPI == 1) ? (const bf16*)(p.ws + OFF_WTIN) + (long)layer * NPP * DM
                              : (const bf16*)(p.ws + OFF_WTOUT) + (long)layer * DM * DM;
  constexpr int K = DM;
  constexpr int nM = ROWSP / BM;
  constexpr int nN = (EPI == 1) ? NPP / BM : DM / BM;
  constexpr int WGM = 4;
  constexpr int nwg = nM * nN;
#define SA(b, h) (shm + ((b) * 2 + (h)) * HT)
#define SB(b, h) (shm + (4 + (b) * 2 + (h)) * HT)
#define OA(b, h) ((((b) * 2 + (h)) * HT) * 2)
#define OB(b, h) (((4 + (b) * 2 + (h)) * HT) * 2)
#define STAGE(PO, BASE, br, kt) do { const char* _ub = (const char*)(BASE) + ((long)(br) * K + (long)(kt) * BK) * 2; \
      asm volatile("s_add_u32 m0, %0, %3\n\ts_nop 0\n\tglobal_load_lds_dwordx4 %1, %2" :: "s"(ldsw), "v"(soff0), "s"(_ub), "n"(PO) : "memory", "scc"); \
      asm volatile("s_add_u32 m0, %0, %3\n\ts_nop 0\n\tglobal_load_lds_dwordx4 %1, %2" :: "s"(ldsw), "v"(soff1), "s"(_ub), "n"((PO) + 8192) : "memory", "scc"); } while (0)
#define LDA(dst, b, h) for (int m = 0; m < 4; ++m) for (int k = 0; k < 2; ++k) \
    dst[m][k] = *reinterpret_cast<const bf16x8*>((char*)SA(b, h) + lds_byte(wr * 64 + m * 16 + fr, k * 32 + fq * 8))
#define LDB(dst, b, h) for (int n = 0; n < 2; ++n) for (int k = 0; k < 2; ++k) \
    dst[n][k] = *reinterpret_cast<const bf16x8*>((char*)SB(b, h) + lds_byte(wc * 32 + n * 16 + fr, k * 32 + fq * 8))
#define MMA(ai, bj, At, Bt_) do { __builtin_amdgcn_s_setprio(1); \
    for (int m = 0; m < 4; ++m) for (int n = 0; n < 2; ++n) for (int k = 0; k < 2; ++k) \
      acc[ai][bj][m][n] = __builtin_amdgcn_mfma_f32_16x16x32_bf16(At[m][k], Bt_[n][k], acc[ai][bj][m][n], 0, 0, 0); \
    __builtin_amdgcn_s_setprio(0); } while (0)
#define WAIT_V(n) asm volatile("s_waitcnt vmcnt(" #n ")" ::: "memory")
#define WAIT_L(n) asm volatile("s_waitcnt lgkmcnt(" #n ")" ::: "memory")
#define BAR __builtin_amdgcn_s_barrier()
#define SCHED __builtin_amdgcn_sched_barrier(0)

  const int gtid = opaque_tid() & 511;
  const int wid = __builtin_amdgcn_readfirstlane(gtid >> 6), lane = gtid & 63, wr = wid >> 2, wc = wid & 3, fr = lane & 15, fq = lane >> 4;
  unsigned soff0, soff1;
  { int _r, _c; stage_rc(gtid * 16, _r, _c); soff0 = (unsigned)(_r * K + _c) * 2u;
    stage_rc(gtid * 16 + 8192, _r, _c); soff1 = (unsigned)(_r * K + _c) * 2u; }
  const unsigned ldsw = (unsigned)(size_t)((__attribute__((address_space(3))) unsigned char*)smem) + (unsigned)wid * 1024u;
  int gdim = (int)gridDim.x;
  asm volatile("" : "+s"(gdim));
  int vb = blockIdx.x;
  if ((gdim & 7) == 0) vb = (blockIdx.x & 7) * (gdim >> 3) + (blockIdx.x >> 3);
  constexpr int nig = WGM * nN;
#define TILE_RC(wg, BR, BC) do { const int gid_ = (wg) / nig, fm_ = gid_ * WGM, gsz_ = min(nM - fm_, WGM); \
    BC = (fm_ + (((wg) % nig) % gsz_)) * BM; BR = (((wg) % nig) / gsz_) * BM; } while (0)
  int brow = 0, bcol = 0;
  if (vb < nwg) {
    TILE_RC(vb, brow, bcol);
    STAGE(OB(0, 0), A, bcol, 0); STAGE(OA(0, 0), Bt, brow, 0);
    STAGE(OB(0, 1), A, bcol + HALF, 0); STAGE(OA(0, 1), Bt, brow + HALF, 0);
  }
  for (int wgid = vb; wgid < nwg; wgid += gdim) {
    f32x4 acc[2][2][4][2] = {};
    bf16x8 At[4][2], B0[2][2], B1[2][2];
    constexpr int nt = K / BK;
    if (wr == 1) BAR;
    WAIT_V(4); BAR;
    STAGE(OB(1, 0), A, bcol, 1); STAGE(OA(1, 0), Bt, brow, 1); STAGE(OB(1, 1), A, bcol + HALF, 1);
    WAIT_V(6); BAR;
    for (int t = 0; t < nt - 2; t += 2) {
      LDB(B0, 0, 0); SCHED; LDA(At, 0, 0); STAGE(OA(1, 1), Bt, brow + HALF, t + 1);
      WAIT_L(8); BAR; WAIT_L(0); MMA(0, 0, At, B0); BAR; SCHED;
      LDB(B1, 0, 1); STAGE(OB(0, 0), A, bcol, t + 2);
      BAR; WAIT_L(0); MMA(0, 1, At, B1); BAR;
      LDA(At, 0, 1); STAGE(OA(0, 0), Bt, brow, t + 2);
      BAR; WAIT_L(0); MMA(1, 0, At, B0); BAR; SCHED;
      STAGE(OB(0, 1), A, bcol + HALF, t + 2);
      WAIT_V(6); BAR; MMA(1, 1, At, B1); BAR;
      LDB(B0, 1, 0); SCHED; LDA(At, 1, 0); STAGE(OA(0, 1), Bt, brow + HALF, t + 2);
      WAIT_L(8); BAR; WAIT_L(0); MMA(0, 0, At, B0); BAR; SCHED;
      LDB(B1, 1, 1); STAGE(OB(1, 0), A, bcol, t + 3);
      BAR; WAIT_L(0); MMA(0, 1, At, B1); BAR;
      LDA(At, 1, 1); STAGE(OA(1, 0), Bt, brow, t + 3);
      BAR; WAIT_L(0); MMA(1, 0, At, B0); BAR; SCHED;
      STAGE(OB(1, 1), A, bcol + HALF, t + 3);
      WAIT_V(6); BAR; MMA(1, 1, At, B1); BAR;
    }
    { LDB(B0, 0, 0); LDA(At, 0, 0); STAGE(OA(1, 1), Bt, brow + HALF, nt - 1);
      BAR; WAIT_L(0); MMA(0, 0, At, B0); BAR;
      LDB(B1, 0, 1); BAR; WAIT_L(0); MMA(0, 1, At, B1); BAR;
      LDA(At, 0, 1); WAIT_V(4); BAR; WAIT_L(0); MMA(1, 0, At, B0); MMA(1, 1, At, B1); BAR; }
    { LDB(B0, 1, 0); LDA(At, 1, 0); WAIT_V(2); BAR; WAIT_L(0); MMA(0, 0, At, B0); BAR;
      LDB(B1, 1, 1); WAIT_V(0); BAR; WAIT_L(0); MMA(0, 1, At, B1); BAR;
      LDA(At, 1, 1); BAR; WAIT_L(0); MMA(1, 0, At, B0); MMA(1, 1, At, B1); BAR; }
    if (wr == 0) BAR;
    const int erow = brow, ecol = bcol;
    if (wgid + gdim < nwg) {
      TILE_RC(wgid + gdim, brow, bcol);
      STAGE(OB(0, 0), A, bcol, 0); STAGE(OA(0, 0), Bt, brow, 0);
      STAGE(OB(0, 1), A, bcol + HALF, 0); STAGE(OA(0, 1), Bt, brow + HALF, 0);
    }
    if (EPI == 1) {
      u16* proj = (u16*)(p.ws + OFF_PROJ);
      const float* sumsq = (const float*)(p.ws + OFF_SUMSQ) + (long)layer * ROWSP;
#pragma unroll
      for (int bj = 0; bj < 2; ++bj)
#pragma unroll
        for (int n = 0; n < 2; ++n) {
          const int tok = ecol + bj * HALF + wc * 32 + n * 16 + fr;
          if (tok < ROWS) {
            const float rs = rsqrtf(sumsq[tok] * (1.f / DM) + EPS);
            u16* prow = proj + (long)tok * NP;
            if (erow < 4096) {
#pragma unroll
              for (int ai = 0; ai < 2; ++ai) {
                const int c0 = ((erow >> 6) + ai * 2 + wr) * 16 + fq * 4;
                float uu[4], gg[4];
#pragma unroll
                for (int j = 0; j < 4; ++j) {
                  uu[j] = (acc[ai][bj][1][n][j] * rs) * (acc[ai][bj][2][n][j] * rs);
                  gg[j] = (acc[ai][bj][0][n][j] * rs) * silu_f(acc[ai][bj][3][n][j] * rs);
                }
                *reinterpret_cast<uint2*>(prow + 1024 + c0) = pack4(uu[0], uu[1], uu[2], uu[3]);
                *reinterpret_cast<uint2*>(prow + c0) = pack4(gg[0], gg[1], gg[2], gg[3]);
              }
            } else
#pragma unroll
            for (int ai = 0; ai < 2; ++ai)
#pragma unroll
              for (int m = 0; m < 4; ++m) {
                const int n0 = erow + ai * HALF + wr * 64 + m * 16 + fq * 4;
                if (n0 < NP)
                  *reinterpret_cast<uint2*>(prow + n0) = pack4(acc[ai][bj][m][n][0] * rs, acc[ai][bj][m][n][1] * rs,
                                                                acc[ai][bj][m][n][2] * rs, acc[ai][bj][m][n][3] * rs);
              }
          }
        }
    } else {
      u16* hb = (u16*)(p.ws + OFF_HB);
      float* sumsq = (float*)(p.ws + OFF_SUMSQ) + (long)(EPI == 2 ? 1 : 2) * ROWSP;
#pragma unroll
      for (int bj = 0; bj < 2; ++bj)
#pragma unroll
        for (int n = 0; n < 2; ++n) {
          const int tok = ecol + bj * HALF + wc * 32 + n * 16 + fr;
          float* dst = nullptr;
          if (EPI == 3) {
            if (tok < ROWS_P) {
              const int b = tok / TP, t = tok - b * TP;
              if (t >= 16) dst = p.out + ((long)b * 8192 + (t - 16)) * DM;
            } else if (tok < ROWS) {
              dst = p.out + YS_OFF + (long)(tok - ROWS_P) * DM;
            }
          }
          u16* hrow = hb + (long)tok * DM;
          float rsum = 0.f;
#pragma unroll
          for (int ai = 0; ai < 2; ++ai)
#pragma unroll
            for (int m = 0; m < 4; ++m) {
              const int n0 = erow + ai * HALF + wr * 64 + m * 16 + fq * 4;
              float r4[4];
              unpack4(*reinterpret_cast<const uint2*>(hrow + n0), r4);
              float v[4];
#pragma unroll
              for (int j = 0; j < 4; ++j) { v[j] = acc[ai][bj][m][n][j] + r4[j]; rsum += v[j] * v[j]; }
              if (EPI == 2) *reinterpret_cast<uint2*>(hrow + n0) = pack4(v[0], v[1], v[2], v[3]);
              else if (dst) *reinterpret_cast<float4*>(dst + n0) = make_float4(v[0], v[1], v[2], v[3]);
            }
          rsum += __shfl_xor(rsum, 16); rsum += __shfl_xor(rsum, 32);
          if (fq == 0) atomicAdd(&sumsq[tok], rsum);
        }
    }
  }
  __syncthreads();
  if (EPI == 2) {
    const int rem = nwg % gdim;
    const int widx = (vb >= rem) ? vb - rem : -1, wcnt = gdim - rem;
    if (wcnt <= 0) {
      transpose_tiles(p.win + (long)DM * NP, (u16*)(p.ws + OFF_WTIN) + (long)NPP * DM, p.normw + DM, NP, NPP / 64, smem, vb, gdim, true);
      transpose_tiles(p.wout + (long)DM * DM, (u16*)(p.ws + OFF_WTOUT) + (long)DM * DM, nullptr, DM, DM / 64, smem, vb, gdim, false);
    } else if (widx >= 0) {
      transpose_tiles(p.win + (long)DM * NP, (u16*)(p.ws + OFF_WTIN) + (long)NPP * DM, p.normw + DM, NP, NPP / 64, smem, widx, wcnt, true);
      transpose_tiles(p.wout + (long)DM * DM, (u16*)(p.ws + OFF_WTOUT) + (long)DM * DM, nullptr, DM, DM / 64, smem, widx, wcnt, false);
    }
  }
#undef TILE_RC
#undef SA
#undef SB
#undef OA
#undef OB
#undef STAGE
#undef LDA
#undef LDB
#undef MMA
}

#define XB_TMO      128
#define XB_XCNT(j)  (256  + 64 * (j))
#define XB_XSUB(j)  (1280 + 64 * (j))
#define XB_XGEN(j)  (2304 + 64 * (j))
#define XB_TOP      3328
#define XB_TOPGEN   3392
#define XCD_BAR_WORDS 3456
#define XB_SPIN_CAP (1u << 18)
#define LAS __attribute__((address_space(3)))
__device__ __forceinline__ unsigned xb_ld(unsigned* p)              { return __hip_atomic_load(p, __ATOMIC_RELAXED, __HIP_MEMORY_SCOPE_AGENT); }
__device__ __forceinline__ unsigned xb_add(unsigned* p, unsigned v) { return __hip_atomic_fetch_add(p, v, __ATOMIC_RELAXED, __HIP_MEMORY_SCOPE_AGENT); }
__device__ __forceinline__ unsigned xb_xcc_id() { return (unsigned)__builtin_amdgcn_s_getreg((3 << 11) | 20) & 0xFu; }
#define XB_SPIN(cond, bar) do { unsigned _sp = 0; while (cond) { __builtin_amdgcn_s_sleep(1); \
    if ((++_sp & 255u) == 0u) { if (xb_ld(&(bar)[XB_TMO])) break; if (_sp > XB_SPIN_CAP) { atomicAdd(&(bar)[XB_TMO], 1u); break; } } } } while (0)
struct XcdBarrier { unsigned* bar; unsigned x; volatile LAS unsigned* st; };
__device__ __forceinline__ XcdBarrier xcd_barrier_post(unsigned* bar, volatile LAS unsigned* st) {
  XcdBarrier b; b.bar = bar; b.x = xb_xcc_id(); b.st = st;
  if (threadIdx.x == 0) (void)xb_add(&bar[XB_XCNT(b.x)], 1u);
  return b;
}
__device__ __forceinline__ void xcd_barrier_complete(unsigned* bar, unsigned x, unsigned& nloc, unsigned& nx) {
  const unsigned G = gridDim.x * gridDim.y * gridDim.z;
  unsigned sum, cnt, mine, sp = 0u;
  for (;;) {
    sum = 0u; cnt = 0u; mine = 0u;
#pragma unroll
    for (unsigned j = 0; j < 16; ++j) { const unsigned c = xb_ld(&bar[XB_XCNT(j)]); sum += c; cnt += (c > 0u) ? 1u : 0u; mine = (j == x) ? c : mine; }
    if (sum == G) break;
    __builtin_amdgcn_s_sleep(1);
    if ((++sp & 255u) == 0u) { if (xb_ld(&bar[XB_TMO])) break; if (sp > XB_SPIN_CAP) { atomicAdd(&bar[XB_TMO], 1u); break; } }
  }
  nloc = mine > 0u ? mine : 1u; nx = cnt > 0u ? cnt : 1u;
}
__device__ __forceinline__ void xcd_barrier(const XcdBarrier& b) {
  asm volatile("s_waitcnt vmcnt(0)" ::: "memory");
  __syncthreads();
  if (threadIdx.x == 0) {
    unsigned* bar = b.bar;
    __builtin_amdgcn_s_waitcnt(0);
    unsigned nloc = b.st[0], nx = b.st[1];
    if (nloc == 0u) { xcd_barrier_complete(bar, b.x, nloc, nx); b.st[0] = nloc; b.st[1] = nx; }
    const unsigned old = xb_add(&bar[XB_XSUB(b.x)], 1u);
    const unsigned gen = old / nloc;
    if (old + 1u == (gen + 1u) * nloc) {
      __builtin_amdgcn_fence(__ATOMIC_RELEASE, "agent");
      asm volatile("s_waitcnt vmcnt(0)" ::: "memory");
      const unsigned og = xb_add(&bar[XB_TOP], 1u);
      const unsigned tg = og / nx;
      if (og + 1u == (tg + 1u) * nx) xb_add(&bar[XB_TOPGEN], 1u);
      else XB_SPIN(xb_ld(&bar[XB_TOPGEN]) == tg, bar);
      __builtin_amdgcn_fence(__ATOMIC_ACQUIRE, "agent");
      xb_add(&bar[XB_XGEN(b.x)], 1u);
      asm volatile("s_waitcnt vmcnt(0)" ::: "memory");
    } else {
      XB_SPIN(xb_ld(&bar[XB_XGEN(b.x)]) == gen, bar);
      __builtin_amdgcn_fence(__ATOMIC_ACQUIRE, "agent");
      asm volatile("s_waitcnt vmcnt(0)" ::: "memory");
    }
  }
  __syncthreads();
}

__device__ __forceinline__ void chunk_geom(int cid, int& row0, int& nvalid, int& prevmode, int& sidx, bool& lastc) {
  if (cid < 516) {
    const int s = cid / 129, c = cid - s * 129;
    sidx = s; lastc = (c == 128);
    if (c == 0) { row0 = s * TP; nvalid = 16; prevmode = 0; }
    else { row0 = s * TP + 16 + (c - 1) * 64; nvalid = 64; prevmode = 1; }
  } else {
    sidx = cid - 516; row0 = ROWS_P + sidx * 64; nvalid = 64; prevmode = 2; lastc = true;
  }
}

__device__ __forceinline__ long item_slot(int cid, int h) {
  if (cid < 516) { const int s = cid / 129, c = cid - s * 129; return (long)((s * 8 + h) * 129 + c); }
  return (long)(4128 + (cid - 516) * 8 + h);
}

__device__ __forceinline__ void chunk_prep(const Params& p, int layer, int item, int nitem, unsigned char* smem) {
  const int tid = opaque_tid() & 511, wv = __builtin_amdgcn_readfirstlane(tid >> 6), lane = tid & 63, fr = lane & 15, fq = lane >> 4;
  const int cid = item >> 3, h = item & 7;
  int row0, nvalid, prevmode, sidx; bool lastc;
  chunk_geom(cid, row0, nvalid, prevmode, sidx, lastc);
  u16* sKB = (u16*)smem;
  u16* sK = sKB + 64 * 136;
  u16* sQ = sK + 64 * 136;
  u16* sVBT = sQ + 64 * 136;
  u16* sKBGT = sVBT + 128 * 72;
  u16* sT = sKBGT + 128 * 72;
  float* sA = (float*)(sT + 64 * 72);
  float* sBeta = sA + 64 * 68;
  float* sGc = sBeta + 64;
  u16* sKPT = (u16*)(sGc + 64);
  float* sTf = (float*)smem;
  float* sY = sTf + 64 * 68;
  int zoff;
  asm volatile("v_mov_b32 %0, 0" : "=v"(zoff));
  const u16* proj = (const u16*)(p.ws + OFF_PROJ);
  const long slot = item_slot(cid, h);
  u16* Wd = (u16*)((unsigned char*)p.out) + slot * 24576;
  u16* QG = Wd + 8192;
  u16* KPT = Wd + 16384;
  u16* UTd = (u16*)(p.ws + OFF_QK) + slot * 12288;
  u16* QKd = UTd + 8192;
  float* EGL = (float*)(p.ws + OFF_EGL);

  unsigned tch = 0;
  {
    if (nitem >= 0) {
      int nrow0, nnv, npm, nsi; bool nl;
      chunk_geom(nitem >> 3, nrow0, nnv, npm, nsi, nl);
      const int nh = nitem & 7;
      if (tid < 402) {
        const int r = tid / 6, m6 = tid - r * 6;
        tch = touch_ld(proj + (long)(nrow0 - 3 + r) * NP + 4096 + (m6 >> 1) * 1024 + nh * 128 + (m6 & 1) * 64);
      } else if (tid >= 448) {
        tch = touch_ld(proj + (long)(nrow0 + (tid - 448)) * NP + 8192 + nh);
      }
    }
  }
  if (wv == 0) {
    float beta = 0.f, g = 0.f;
    if (lane < nvalid) {
      const long rb = (long)(row0 + lane) * NP;
      const float bl = bf2f(proj[rb + 8192 + h]);
      const float al = bf2f(proj[rb + 8200 + h]) + p.dtb[layer * 8 + h];
      beta = 1.f / (1.f + expf(-bl));
      const float sp = (al > 20.f) ? al : log1pf(expf(al));
      g = -expf(p.alog[layer * 8 + h]) * sp;
    }
    float gc = g;
#pragma unroll
    for (int o = 1; o < 64; o <<= 1) { const float t = __shfl_up(gc, o); if (lane >= o) gc += t; }
    sBeta[lane] = beta; sGc[lane] = gc;
  }

  const int rg = tid >> 5, cg = tid & 31, i0 = rg * 4, d0 = cg * 4;
  float qv[4][4], kv[4][4], vv[4][4];
#pragma unroll
  for (int mat = 0; mat < 3; ++mat) {
    const int ch = mat * 1024 + h * 128 + d0;
    const int colbase = 4096 + ch;
    float xr[7][4];
#pragma unroll
    for (int a = 0; a < 7; ++a) {
      const int ri = i0 - 3 + a;
      if (ri >= 0 || prevmode == 1) {
        uint2 raw = *reinterpret_cast<const uint2*>(proj + (long)(row0 + ri) * NP + colbase);
        unpack4(raw, xr[a]);
      } else if (prevmode == 2) {
        const float4 v = *reinterpret_cast<const float4*>(p.scq + ((long)(layer * 8 + sidx) * 3 + (3 + ri)) * 3072 + ch);
        xr[a][0] = v.x; xr[a][1] = v.y; xr[a][2] = v.z; xr[a][3] = v.w;
      } else {
        xr[a][0] = xr[a][1] = xr[a][2] = xr[a][3] = 0.f;
      }
    }
    if (lastc && rg == 15) {
      float* dst = p.out + (prevmode == 2 ? SCQ_OFF + (long)(layer * 8 + sidx) * 3 * 3072 : PCQ_OFF + (long)(layer * 4 + sidx) * 3 * 3072) + ch;
#pragma unroll
      for (int a = 4; a < 7; ++a)
        *reinterpret_cast<float4*>(dst + (a - 4) * 3072) = make_float4(xr[a][0], xr[a][1], xr[a][2], xr[a][3]);
    }
    float cw[4][4];
#pragma unroll
    for (int j = 0; j < 4; ++j) {
      const float4 v = *reinterpret_cast<const float4*>(p.cvqw + (long)(layer * 4 + j) * 3072 + ch);
      cw[j][0] = v.x; cw[j][1] = v.y; cw[j][2] = v.z; cw[j][3] = v.w;
    }
#pragma unroll
    for (int ii = 0; ii < 4; ++ii)
#pragma unroll
      for (int e = 0; e < 4; ++e) {
        float o = 0.f;
#pragma unroll
        for (int j = 0; j < 4; ++j) o += cw[j][e] * xr[ii + j][e];
        o = silu_f(o);
        if (mat == 0) qv[ii][e] = o; else if (mat == 1) kv[ii][e] = o; else vv[ii][e] = o;
      }
  }
#pragma unroll
  for (int ii = 0; ii < 4; ++ii) {
    float sq = 0.f, sk = 0.f;
#pragma unroll
    for (int e = 0; e < 4; ++e) { sq += qv[ii][e] * qv[ii][e]; sk += kv[ii][e] * kv[ii][e]; }
#pragma unroll
    for (int o = 1; o < 32; o <<= 1) { sq += __shfl_xor(sq, o); sk += __shfl_xor(sk, o); }
    const float rq = rsqrtf(sq + EPS) * 0.08838834764831845f, rk = rsqrtf(sk + EPS);
    const bool valid = (i0 + ii) < nvalid;
#pragma unroll
    for (int e = 0; e < 4; ++e) {
      qv[ii][e] = valid ? qv[ii][e] * rq : 0.f;
      kv[ii][e] = valid ? kv[ii][e] * rk : 0.f;
      vv[ii][e] = valid ? vv[ii][e] : 0.f;
    }
  }
  __syncthreads();
  float beta[4], gcv[4];
#pragma unroll
  for (int ii = 0; ii < 4; ++ii) { beta[ii] = sBeta[i0 + ii]; gcv[ii] = sGc[i0 + ii]; }
  const float glast = sGc[63];
  if (tid == 0) EGL[slot] = expf(glast);

#pragma unroll
  for (int ii = 0; ii < 4; ++ii) {
    const int i = i0 + ii;
    const float b = beta[ii];
    *reinterpret_cast<uint2*>(sKB + i * 136 + d0) = pack4(kv[ii][0] * b, kv[ii][1] * b, kv[ii][2] * b, kv[ii][3] * b);
    *reinterpret_cast<uint2*>(sK + i * 136 + d0) = pack4(kv[ii][0], kv[ii][1], kv[ii][2], kv[ii][3]);
    *reinterpret_cast<uint2*>(sQ + i * 136 + d0) = pack4(qv[ii][0], qv[ii][1], qv[ii][2], qv[ii][3]);

  }
  {
    float bg[4], kd[4];
#pragma unroll
    for (int ii = 0; ii < 4; ++ii) { bg[ii] = beta[ii] * __expf(gcv[ii]); kd[ii] = __expf(glast - gcv[ii]); }
#pragma unroll
    for (int e = 0; e < 4; ++e) {
      const int d = d0 + e;
      *reinterpret_cast<uint2*>(sVBT + d * 72 + i0) = pack4(vv[0][e] * beta[0], vv[1][e] * beta[1], vv[2][e] * beta[2], vv[3][e] * beta[3]);
      *reinterpret_cast<uint2*>(sKBGT + d * 72 + i0) = pack4(kv[0][e] * bg[0], kv[1][e] * bg[1], kv[2][e] * bg[2], kv[3][e] * bg[3]);
      *reinterpret_cast<uint2*>(sKPT + d * 72 + i0) = pack4(kv[0][e] * kd[0], kv[1][e] * kd[1], kv[2][e] * kd[2], kv[3][e] * kd[3]);
    }
  }
  __syncthreads();
#pragma unroll
  for (int t2 = 0; t2 < 2; ++t2) {
    {
      const int qib = wv >> 1, qkk = (wv & 1) * 2 + t2;
      const bf16x8 qf = ldfrag(sQ, 136, qib * 16 + fr, qkk * 32 + fq * 8);
      const float eg = __expf(sGc[qib * 16 + fr]);
      float qx[8];
      unpack8(__builtin_bit_cast(uint4, qf), qx);
      uint4 o;
      o.x = pack2(qx[0] * eg, qx[1] * eg); o.y = pack2(qx[2] * eg, qx[3] * eg);
      o.z = pack2(qx[4] * eg, qx[5] * eg); o.w = pack2(qx[6] * eg, qx[7] * eg);
      *reinterpret_cast<uint4*>(QG + (((qib * 4 + qkk) * 64 + lane) << 3)) = o;
    }
    *reinterpret_cast<bf16x8*>(KPT + (((wv * 2 + t2) * 64 + lane) << 3)) = ldfrag(sKPT, 72, wv * 16 + fr, t2 * 32 + fq * 8);
  }
  {
    const int ib = wv >> 1;
#pragma unroll
    for (int jj = 0; jj < 2; ++jj) {
      const int jb = (wv & 1) * 2 + jj;
      f32x4 c = {0.f, 0.f, 0.f, 0.f}, c2 = {0.f, 0.f, 0.f, 0.f};
#pragma unroll
      for (int kk = 0; kk < 4; ++kk) {
        const bf16x8 a = ldfrag(sKB, 136, ib * 16 + fr, kk * 32 + fq * 8);
        const bf16x8 b = ldfrag(sK, 136, jb * 16 + fr, kk * 32 + fq * 8);
        c = mfma16(a, b, c);
        const bf16x8 b2 = ldfrag(sQ, 136, ib * 16 + fr, kk * 32 + fq * 8);
        c2 = mfma16(b, b2, c2);
      }
      {
        const int j = jb * 16 + fr;
        const float gj = sGc[j];
#pragma unroll
        for (int r = 0; r < 4; ++r) {
          const int i = ib * 16 + fq * 4 + r;
          sA[i * 68 + j] = (i > j) ? c[r] * __expf(sGc[i] - gj) : 0.f;
        }
      }
      {
        const int i = ib * 16 + fr;
        const float gi = sGc[i];
        float o[4];
#pragma unroll
        for (int r = 0; r < 4; ++r) {
          const int j = jb * 16 + fq * 4 + r;
          o[r] = (i >= j) ? c2[r] * __expf(gi - sGc[j]) : 0.f;
        }
        *reinterpret_cast<uint2*>(QKd + ((((ib * 2 + (jb >> 1)) * 64) + ((jb & 1) * 2 + (fq >> 1)) * 16 + fr) << 3) + (fq & 1) * 4) = pack4(o[0], o[1], o[2], o[3]);
      }
    }
  }
  __syncthreads();
  {
    for (int e = tid; e < 64 * 68; e += 512) sTf[e] = 0.f;
    __syncthreads();
    if (wv < 4 && lane < 16) {
      const float* Ab = sA + (wv * 16) * 68 + wv * 16 + zoff;
      float t[16], ac[16], an[16];
      t[0] = (lane == 0) ? 1.f : 0.f;
      sTf[(wv * 16) * 68 + wv * 16 + lane] = t[0];
      ac[0] = Ab[68];
#pragma unroll
      for (int i = 1; i < 16; ++i) {
        if (i + 1 < 16) {
#pragma unroll
          for (int j = 0; j <= i; ++j) an[j] = Ab[(i + 1) * 68 + j];
        }
        float a = (lane == i) ? 1.f : 0.f;
#pragma unroll
        for (int j = 0; j < i; ++j) a -= ac[j] * t[j];
        t[i] = a;
        sTf[(wv * 16 + i) * 68 + wv * 16 + lane] = a;
        if (i + 1 < 16) {
#pragma unroll
          for (int j = 0; j <= i; ++j) ac[j] = an[j];
        }
        __builtin_amdgcn_sched_barrier(0);
      }
    }
    __syncthreads();
    if (wv < 2) {
      const int o = wv * 32;
      const f32x4 c = mm16(sA, o + 16, o, sTf, o, o, 16, fr, fq);
#pragma unroll
      for (int r = 0; r < 4; ++r) sY[(o + 16 + fq * 4 + r) * 68 + o + fr] = c[r];
    }
    __syncthreads();
    if (wv < 2) {
      const int o = wv * 32;
      const f32x4 c = mm16(sTf, o + 16, o + 16, sY, o + 16, o, 16, fr, fq);
#pragma unroll
      for (int r = 0; r < 4; ++r) sTf[(o + 16 + fq * 4 + r) * 68 + o + fr] = -c[r];
    }
    __syncthreads();
    if (wv < 4) {
      const int bi = wv >> 1, bj = wv & 1;
      const f32x4 c = mm16(sA, 32 + bi * 16, 0, sTf, 0, bj * 16, 32, fr, fq);
#pragma unroll
      for (int r = 0; r < 4; ++r) sY[(32 + bi * 16 + fq * 4 + r) * 68 + bj * 16 + fr] = c[r];
    }
    __syncthreads();
    if (wv < 4) {
      const int bi = wv >> 1, bj = wv & 1;
      const f32x4 c = mm16(sTf, 32 + bi * 16, 32, sY, 32, bj * 16, 32, fr, fq);
#pragma unroll
      for (int r = 0; r < 4; ++r) sTf[(32 + bi * 16 + fq * 4 + r) * 68 + bj * 16 + fr] = -c[r];
    }
    __syncthreads();
    {
      const int i = tid >> 3, j0 = (tid & 7) * 8;
      float v[8];
#pragma unroll
      for (int e = 0; e < 8; ++e) v[e] = sTf[i * 68 + j0 + e];
      uint4 o;
      o.x = pack2(v[0], v[1]); o.y = pack2(v[2], v[3]); o.z = pack2(v[4], v[5]); o.w = pack2(v[6], v[7]);
      *reinterpret_cast<uint4*>(sT + i * 72 + j0) = o;
    }
  }
  __syncthreads();
  {
    const int ib = wv >> 1;
#pragma unroll
    for (int x = 0; x < 4; ++x) {
      const int dvb = (wv & 1) * 4 + x;
      f32x4 c = {0.f, 0.f, 0.f, 0.f};
#pragma unroll
      for (int kk = 0; kk < 2; ++kk)
        c = mfma16(ldfrag(sT, 72, ib * 16 + fr, kk * 32 + fq * 8), ldfrag(sVBT, 72, dvb * 16 + fr, kk * 32 + fq * 8), c);
      *reinterpret_cast<uint2*>(UTd + (((dvb * 4 + ib) * 64 + lane) << 2)) = pack4(c[0], c[1], c[2], c[3]);
    }
#pragma unroll
    for (int ib2 = 0; ib2 < 4; ++ib2) {
      f32x4 c = {0.f, 0.f, 0.f, 0.f};
#pragma unroll
      for (int kk = 0; kk < 2; ++kk)
        c = mfma16(ldfrag(sKBGT, 72, wv * 16 + fr, kk * 32 + fq * 8), ldfrag(sT, 72, ib2 * 16 + fr, kk * 32 + fq * 8), c);
      *reinterpret_cast<uint2*>(Wd + ((((ib2 * 4 + (wv >> 1)) * 64) + ((wv & 1) * 2 + (fq >> 1)) * 16 + fr) << 3) + (fq & 1) * 4) = pack4(c[0], c[1], c[2], c[3]);
    }
  }
  __syncthreads();
  {
    unsigned tacc = 0;
    touch_use(tacc, tch);
    if (tacc == 0x9e3779b9u) ((volatile float*)EGL)[NITEM + 9] = 1.f;
  }
}

__device__ __forceinline__ void gdn_scan(const Params& p, int layer, int widx, unsigned char* smem, const XcdBarrier* xbp, int csplit) {
  const int tid = opaque_tid() & 511, wv = __builtin_amdgcn_readfirstlane(tid >> 6), lane = tid & 63, fr = lane & 15, fq = lane >> 4;
  const bool is_prompt = widx < 128;
  int s, h, sl, nsteps, cid0;
  if (is_prompt) { s = widx >> 5; h = (widx >> 2) & 7; sl = widx & 3; nsteps = 129; cid0 = s * 129; }
  else { const int j = widx - 128; s = j >> 5; h = (j >> 2) & 7; sl = j & 3; nsteps = 1; cid0 = 516 + s; }
  const int dv0 = sl * 32;
  u16* sST = (u16*)smem;
  u16* sVT = sST + 32 * 136;
  u16* sO = sVT + 32 * 72;
  const u16* R1g = (const u16*)((const unsigned char*)p.out);
  const u16* R2g = (const u16*)(p.ws + OFF_QK);
  const float* EGL = (const float*)(p.ws + OFF_EGL);
  const long slot0 = item_slot(cid0, h);
  const int rowbase = is_prompt ? s * TP : ROWS_P + s * 64;
  u16* ymix = (u16*)(p.ws + OFF_YMIX);

  f32x4 accS[2];
#pragma unroll
  for (int nb = 0; nb < 2; ++nb) {
    if (is_prompt) { accS[nb][0] = 0.f; accS[nb][1] = 0.f; accS[nb][2] = 0.f; accS[nb][3] = 0.f; }
    else {
      const float4 v = *reinterpret_cast<const float4*>(p.sdel + ((long)(layer * 8 + s) * 8 + h) * 16384 + (wv * 16 + fr) * 128 + dv0 + nb * 16 + fq * 4);
      accS[nb][0] = v.x; accS[nb][1] = v.y; accS[nb][2] = v.z; accS[nb][3] = v.w;
    }
#pragma unroll
    for (int r = 0; r < 4; ++r) sST[(nb * 16 + fq * 4 + r) * 136 + wv * 16 + fr] = f2bf(accS[nb][r]);
  }
  __syncthreads();
  const int part = wv >> 2;
  const int ib = wv & 3;
  int zoff;
  asm volatile("v_mov_b32 %0, 0" : "=v"(zoff));
#define LDS_BAR() asm volatile("s_waitcnt lgkmcnt(0)\n\ts_barrier" ::: "memory")
#define SCAN_LOAD(IT, F, G, KPF, UU0, UU1, EG) do { \
    const u16* R1p = R1g + (IT) * 24576; const u16* R2p = R2g + (IT) * 12288; \
    _Pragma("unroll") for (int kk = 0; kk < 2; ++kk) \
      KPF[kk] = *reinterpret_cast<const bf16x8*>(R1p + 16384 + (((wv * 2 + kk) * 64 + lane) << 3)); \
    EG = EGL[(IT) + zoff]; \
    { const u16* Fp = R1p + part * 8192;     \
      _Pragma("unroll") for (int kk = 0; kk < 4; ++kk) \
        F[kk] = *reinterpret_cast<const bf16x8*>(Fp + (((ib * 4 + kk) * 64 + lane) << 3)); } \
    if (part == 0) { \
      UU0 = *reinterpret_cast<const uint2*>(R2p + ((((sl * 2) * 4 + ib) * 64 + lane) << 2)); \
      UU1 = *reinterpret_cast<const uint2*>(R2p + ((((sl * 2 + 1) * 4 + ib) * 64 + lane) << 2)); \
    } else { \
      _Pragma("unroll") for (int kk = 0; kk < 2; ++kk) \
        G[kk] = *reinterpret_cast<const bf16x8*>(R2p + 8192 + (((ib * 2 + kk) * 64 + lane) << 3)); } } while (0)
#define SCAN_FLUSH(PROW0, PNV) do { \
    if (tid < 256) { const int i_ = tid >> 2, sg_ = tid & 3; \
      if (i_ < (PNV)) *reinterpret_cast<uint4*>(ymix + (long)((PROW0) + i_) * DM + 1024 + h * 128 + dv0 + sg_ * 8) = \
          *reinterpret_cast<const uint4*>(sO + i_ * 40 + sg_ * 8); } } while (0)
#define SCAN_STEP(STEP, F, G, KPF, UU0, UU1, EGLV, FN, GN, KPFN, UU0N, UU1N, EGLN) do { \
    const int row0 = (is_prompt && (STEP) > 0) ? rowbase + 16 + ((STEP) - 1) * 64 : rowbase; \
    const int nvalid = (is_prompt && (STEP) == 0) ? 16 : 64; \
    { const long itn = slot0 + min((STEP) + 2, nsteps - 1); \
      SCAN_LOAD(itn, FN, GN, KPFN, UU0N, UU1N, EGLN); } \
    if ((STEP) > 0) SCAN_FLUSH(prow0, pnv); \
    f32x4 c0 = {0.f, 0.f, 0.f, 0.f}, c1 = {0.f, 0.f, 0.f, 0.f}; \
    _Pragma("unroll") for (int kk = 0; kk < 4; ++kk) { \
      c0 = mfma16(F[kk], ldfrag(sST, 136, fr, kk * 32 + fq * 8), c0); \
      c1 = mfma16(F[kk], ldfrag(sST, 136, 16 + fr, kk * 32 + fq * 8), c1); } \
    if (part == 0) { \
      float u0[4], u1[4]; \
      unpack4(UU0, u0); unpack4(UU1, u1); \
      *reinterpret_cast<uint2*>(sVT + fr * 72 + ib * 16 + fq * 4) = pack4(u0[0] - c0[0], u0[1] - c0[1], u0[2] - c0[2], u0[3] - c0[3]); \
      *reinterpret_cast<uint2*>(sVT + (16 + fr) * 72 + ib * 16 + fq * 4) = pack4(u1[0] - c1[0], u1[1] - c1[1], u1[2] - c1[2], u1[3] - c1[3]); } \
    LDS_BAR(); \
    _Pragma("unroll") for (int nb = 0; nb < 2; ++nb) { \
      f32x4 c = accS[nb]; \
      c[0] *= EGLV; c[1] *= EGLV; c[2] *= EGLV; c[3] *= EGLV; \
      _Pragma("unroll") for (int kk = 0; kk < 2; ++kk) \
        c = mfma16(ldfrag(sVT, 72, nb * 16 + fr, kk * 32 + fq * 8), KPF[kk], c); \
      accS[nb] = c; \
      _Pragma("unroll") for (int r = 0; r < 4; ++r) sST[(nb * 16 + fq * 4 + r) * 136 + wv * 16 + fr] = f2bf(c[r]); } \
    if (part == 1) { \
      _Pragma("unroll") for (int kk = 0; kk < 2; ++kk) { \
        c0 = mfma16(G[kk], ldfrag(sVT, 72, fr, kk * 32 + fq * 8), c0); \
        c1 = mfma16(G[kk], ldfrag(sVT, 72, 16 + fr, kk * 32 + fq * 8), c1); } \
      _Pragma("unroll") for (int r = 0; r < 4; ++r) { \
        sO[(ib * 16 + fq * 4 + r) * 40 + fr] = f2bf(c0[r]); \
        sO[(ib * 16 + fq * 4 + r) * 40 + 16 + fr] = f2bf(c1[r]); } } \
    LDS_BAR(); \
    prow0 = row0; pnv = nvalid; } while (0)
  bf16x8 fA[4], gA[2], kpfA[2]; uint2 u0A, u1A; float eglA;
  bf16x8 fB[4], gB[2], kpfB[2]; uint2 u0B, u1B; float eglB;
  bf16x8 fC[4], gC[2], kpfC[2]; uint2 u0C, u1C; float eglC;
  int prow0 = 0, pnv = 0;
  SCAN_LOAD(slot0, fA, gA, kpfA, u0A, u1A, eglA);
  SCAN_LOAD(slot0 + min(1, nsteps - 1), fB, gB, kpfB, u0B, u1B, eglB);
  for (int step = 0; step < nsteps; step += 3) {
    if (xbp && step == csplit) xcd_barrier(*xbp);
    SCAN_STEP(step, fA, gA, kpfA, u0A, u1A, eglA, fC, gC, kpfC, u0C, u1C, eglC);
    if (step + 1 < nsteps) SCAN_STEP(step + 1, fB, gB, kpfB, u0B, u1B, eglB, fA, gA, kpfA, u0A, u1A, eglA);
    if (step + 2 < nsteps) SCAN_STEP(step + 2, fC, gC, kpfC, u0C, u1C, eglC, fB, gB, kpfB, u0B, u1B, eglB);
  }
  SCAN_FLUSH(prow0, pnv);
#undef SCAN_STEP
#undef SCAN_FLUSH
#undef SCAN_LOAD
  float* dst = p.out + (is_prompt ? PD_OFF + ((long)(layer * 4 + s) * 8 + h) * 16384 : SD_OFF + ((long)(layer * 8 + s) * 8 + h) * 16384);
#pragma unroll
  for (int nb = 0; nb < 2; ++nb)
    *reinterpret_cast<float4*>(dst + (wv * 16 + fr) * 128 + dv0 + nb * 16 + fq * 4) = make_float4(accS[nb][0], accS[nb][1], accS[nb][2], accS[nb][3]);
  __syncthreads();
}

constexpr int NUNIT = 4 * 513 + 32;
__device__ __forceinline__ void mixer_a_group(const Params& p, int layer, int ug) {
  const int tid = opaque_tid() & 511;
  const int uid = ug * 4 + (tid >> 7);
  if (uid >= NUNIT) return;
  const int c0 = (tid & 127) * 8;
  int row0, sidx; bool first, last, samp;
  if (uid < 2052) { sidx = uid / 513; const int k = uid - sidx * 513; row0 = sidx * TP + 16 * k; first = (k == 0); last = (k == 512); samp = false; }
  else { const int v = uid - 2052; sidx = v >> 2; const int k = v & 3; row0 = ROWS_P + sidx * 64 + 16 * k; first = (k == 0); last = (k == 3); samp = true; }
  const u16* proj = (const u16*)(p.ws + OFF_PROJ);
  u16* ymix = (u16*)(p.ws + OFF_YMIX);
  float w0[8], w1[8], w2[8], um2[8], um1[8];
  {
    const float* cw = p.cvaw + (long)layer * 3 * 1024 + c0;
#pragma unroll
    for (int e = 0; e < 8; ++e) { w0[e] = cw[e]; w1[e] = cw[1024 + e]; w2[e] = cw[2048 + e]; }
  }
  if (first) {
    if (samp) {
      const float* st = p.sca + (long)(layer * 8 + sidx) * 2 * 1024 + c0;
#pragma unroll
      for (int e = 0; e < 8; ++e) { um2[e] = st[e]; um1[e] = st[1024 + e]; }
    } else {
#pragma unroll
      for (int e = 0; e < 8; ++e) { um2[e] = 0.f; um1[e] = 0.f; }
    }
  } else {
    unpack8(*reinterpret_cast<const uint4*>(proj + (long)(row0 - 2) * NP + 1024 + c0), um2);
    unpack8(*reinterpret_cast<const uint4*>(proj + (long)(row0 - 1) * NP + 1024 + c0), um1);
  }
  for (int t0 = 0; t0 < 16; t0 += 4) {
    uint4 rgv[4], ruv[4];
#pragma unroll
    for (int q = 0; q < 4; ++q) {
      const long rb = (long)(row0 + t0 + q) * NP + c0;
      rgv[q] = *reinterpret_cast<const uint4*>(proj + rb);
      ruv[q] = *reinterpret_cast<const uint4*>(proj + rb + 1024);
    }
#pragma unroll
    for (int q = 0; q < 4; ++q) {
      float g[8], u[8], y[8];
      unpack8(rgv[q], g); unpack8(ruv[q], u);
#pragma unroll
      for (int e = 0; e < 8; ++e) {
        y[e] = g[e] * (w0[e] * um2[e] + w1[e] * um1[e] + w2[e] * u[e]);
        um2[e] = um1[e]; um1[e] = u[e];
      }
      uint4 o;
      o.x = pack2(y[0], y[1]); o.y = pack2(y[2], y[3]); o.z = pack2(y[4], y[5]); o.w = pack2(y[6], y[7]);
      *reinterpret_cast<uint4*>(ymix + (long)(row0 + t0 + q) * DM + c0) = o;
    }
  }
  if (last) {
    float* dst = p.out + (samp ? SCA_OFF + (long)(layer * 8 + sidx) * 2 * 1024 : PCA_OFF + (long)(layer * 4 + sidx) * 2 * 1024) + c0;
#pragma unroll
    for (int e = 0; e < 8; ++e) { dst[e] = um2[e]; dst[1024 + e] = um1[e]; }
  }
}

__device__ __forceinline__ void phase_post(const Params& p, int layer) {
  const int tid = opaque_tid() & 511;
  const u16* proj = (const u16*)(p.ws + OFF_PROJ);
  u16* ymix = (u16*)(p.ws + OFF_YMIX);
  const int hh = (tid >> 4) & 7, d = (tid & 15) * 8;
  float w[8];
#pragma unroll
  for (int e = 0; e < 8; ++e) w[e] = p.onw[layer * 128 + d + e];
  for (int g = blockIdx.x; g < ROWS / 4; g += gridDim.x) {
    const int row = g * 4 + (tid >> 7);
    u16* op = ymix + (long)row * DM + 1024 + hh * 128 + d;
    float o[8], z[8];
    unpack8(*reinterpret_cast<const uint4*>(op), o);
    unpack8(*reinterpret_cast<const uint4*>(proj + (long)row * NP + 7168 + hh * 128 + d), z);
    float ss = 0.f;
#pragma unroll
    for (int e = 0; e < 8; ++e) ss += o[e] * o[e];
    ss += __shfl_xor(ss, 1); ss += __shfl_xor(ss, 2); ss += __shfl_xor(ss, 4); ss += __shfl_xor(ss, 8);
    const float rs = rsqrtf(ss * (1.f / 128.f) + EPS);
    float y[8];
#pragma unroll
    for (int e = 0; e < 8; ++e) y[e] = o[e] * rs * w[e] * silu_f(z[e]);
    uint4 ov;
    ov.x = pack2(y[0], y[1]); ov.y = pack2(y[2], y[3]); ov.z = pack2(y[4], y[5]); ov.w = pack2(y[6], y[7]);
    *reinterpret_cast<uint4*>(op) = ov;
  }
}

__device__ __forceinline__ void phase_final(const Params& p) {
  const int tid = opaque_tid() & 511, wv = tid >> 6, lane = tid & 63;
  const float* sumsq = (const float*)(p.ws + OFF_SUMSQ) + 2L * ROWSP;
  for (int r = blockIdx.x * 8 + wv; r < ROWS; r += gridDim.x * 8) {
    float* dst;
    if (r < ROWS_P) {
      const int b = r / TP, t = r - b * TP;
      if (t < 16) continue;
      dst = p.out + ((long)b * 8192 + (t - 16)) * DM;
    } else {
      dst = p.out + YS_OFF + (long)(r - ROWS_P) * DM;
    }
    const float rs = rsqrtf(sumsq[r] * (1.f / DM) + EPS);
#pragma unroll
    for (int i = 0; i < 8; ++i) {
      const int c = (i * 64 + lane) * 4;
      float4 v = *reinterpret_cast<const float4*>(dst + c);
      const float4 w = *reinterpret_cast<const float4*>(p.fnw + c);
      v.x *= rs * w.x; v.y *= rs * w.y; v.z *= rs * w.z; v.w *= rs * w.w;
      *reinterpret_cast<float4*>(dst + c) = v;
    }
  }
}

typedef const __attribute__((address_space(4))) Params* CParamsPtr;
__device__ __forceinline__ Params ldparams(CParamsPtr q) {
#if defined(__HIP_DEVICE_COMPILE__)
  asm volatile("" : "+s"(q));
  Params r;
  r.xp = q->xp; r.xs = q->xs; r.sca = q->sca; r.scq = q->scq; r.sdel = q->sdel; r.meta = q->meta; r.normw = q->normw; r.win = q->win;
  r.cvaw = q->cvaw; r.cvqw = q->cvqw; r.alog = q->alog; r.dtb = q->dtb; r.onw = q->onw; r.wout = q->wout; r.fnw = q->fnw;
  r.out = q->out; r.ws = q->ws;
  return r;
#else
  return Params{};
#endif
}

__global__ void __launch_bounds__(512) mega(Params p_unused) {
  extern __shared__ __attribute__((aligned(16))) unsigned char smem[];
  cg::grid_group grid = cg::this_grid();
  CParamsPtr kp = (CParamsPtr)__builtin_amdgcn_kernarg_segment_ptr();
  volatile LAS unsigned* xst = (volatile LAS unsigned*)(smem + 147440);
  if (threadIdx.x < 2) xst[threadIdx.x] = 0u;
  __syncthreads();
  XcdBarrier xb;
  { const Params p = ldparams(kp); xb = xcd_barrier_post((unsigned*)(p.ws + OFF_BAR), xst); }
  { const Params p = ldparams(kp); phase_prep(p, smem); }
  if (gridDim.x < 256) grid.sync(); else xcd_barrier(xb);
  for (int layer = 0; layer < 2; ++layer) {
    { const Params p = ldparams(kp); gemm_phase<1>(p, layer, smem); }
    xcd_barrier(xb);
    const bool split = gridDim.x >= 256;
    const int cprep = split ? 110 : 129, csplit = 108;
    {
      const Params p = ldparams(kp);
      const int per_s = cprep * 8, na = 4 * per_s + 64;
      for (int idx = blockIdx.x; idx < na; idx += gridDim.x) {
        int it[2];
#pragma unroll
        for (int q = 0; q < 2; ++q) {
          const int ix = idx + q * (int)gridDim.x;
          if (ix >= na) it[q] = -1;
          else if (ix < 4 * per_s) { const int s_ = ix / per_s, r_ = ix - s_ * per_s; it[q] = (s_ * 129 + (r_ >> 3)) * 8 + (r_ & 7); }
          else { const int r_ = ix - 4 * per_s; it[q] = (516 + (r_ >> 3)) * 8 + (r_ & 7); }
        }
        chunk_prep(p, layer, it[0], it[1], smem);
      }
    }
    xcd_barrier(xb);
    {
      const Params p = ldparams(kp);
      const int G = gridDim.x, b = blockIdx.x;
      if (split) {
        if (b < 128) gdn_scan(p, layer, (((b & 7) + 8 * (b >> 5)) << 2) + ((b >> 3) & 3), smem, &xb, csplit);
        else {
          if (b < 256) { gdn_scan(p, layer, b, smem, nullptr, 0); gdn_scan(p, layer, b + 128, smem, nullptr, 0); }
          const int per_b = (129 - cprep) * 8, nb = 4 * per_b, W = G - 128;
          for (int idx = b - 128; idx < nb; idx += W) {
            int it[2];
#pragma unroll
            for (int q = 0; q < 2; ++q) {
              const int ix = idx + q * W;
              if (ix >= nb) it[q] = -1;
              else { const int s_ = ix / per_b, r_ = ix - s_ * per_b; it[q] = (s_ * 129 + cprep + (r_ >> 3)) * 8 + (r_ & 7); }
            }
            chunk_prep(p, layer, it[0], it[1], smem);
          }
          constexpr int UGT = (NUNIT + 3) / 4, UG1 = (UGT * 9) / 20;
          for (int ug = b - 128; ug < UG1; ug += W) mixer_a_group(p, layer, ug);
          xcd_barrier(xb);
          for (int ug = UG1 + b - 128; ug < UGT; ug += W) mixer_a_group(p, layer, ug);
        }
      } else {
        for (int w = b; w < 384; w += G) gdn_scan(p, layer, w, smem, nullptr, 0);
        for (int ug = b; ug < (NUNIT + 3) / 4; ug += G) mixer_a_group(p, layer, ug);
      }
    }
    xcd_barrier(xb);
    { const Params p = ldparams(kp); phase_post(p, layer); }
    xcd_barrier(xb);
    { const Params p = ldparams(kp); if (layer == 0) gemm_phase<2>(p, layer, smem); else gemm_phase<3>(p, layer, smem); }
    xcd_barrier(xb);
  }
  { const Params p = ldparams(kp); phase_final(p); }
}

extern "C" void kernel_launch(void* const* d_in, const int* in_sizes, int n_in,
                              void* d_out, int out_size, void* d_ws, size_t ws_size,
                              hipStream_t stream) {
  constexpr size_t kLds = 147456;
  static int grid_blocks = 0;
  if (!grid_blocks) {
    int dev = 0, cus = 0, per_cu = 0;
    (void)hipGetDevice(&dev);
    (void)hipDeviceGetAttribute(&cus, hipDeviceAttributeMultiprocessorCount, dev);
    (void)hipFuncSetAttribute((const void*)mega, hipFuncAttributeMaxDynamicSharedMemorySize, (int)kLds);
    (void)hipOccupancyMaxActiveBlocksPerMultiprocessor(&per_cu, (const void*)mega, 512, kLds);
    if (per_cu < 1) per_cu = 1;
    grid_blocks = cus * per_cu;
    if (ws_size < (size_t)WS_END) fprintf(stderr, "workspace too small: %zu < %ld\n", ws_size, WS_END);
  }
  Params p{};
  p.xp = (const float*)d_in[0]; p.xs = (const float*)d_in[1]; p.sca = (const float*)d_in[2]; p.scq = (const float*)d_in[3];
  p.sdel = (const float*)d_in[4]; p.meta = (const float*)d_in[5]; p.normw = (const float*)d_in[6]; p.win = (const float*)d_in[7];
  p.cvaw = (const float*)d_in[8]; p.cvqw = (const float*)d_in[9]; p.alog = (const float*)d_in[10]; p.dtb = (const float*)d_in[11];
  p.onw = (const float*)d_in[12]; p.wout = (const float*)d_in[13]; p.fnw = (const float*)d_in[14];
  p.out = (float*)d_out; p.ws = (unsigned char*)d_ws;
  (void)hipMemsetAsync((unsigned char*)d_ws + OFF_BAR, 0, XCD_BAR_WORDS * sizeof(unsigned), stream);
  void* args[] = {&p};
  hipError_t e = hipLaunchCooperativeKernel((void*)mega, dim3(grid_blocks), dim3(512), args, kLds, stream);
  if (e != hipSuccess) fprintf(stderr, "cooperative launch failed: %s (grid %d)\n", hipGetErrorString(e), grid_blocks);
}
```
